# Optimizing an MI355X kernel written in HIP

```python
import jax, jax.numpy as jnp
from jax import lax
import numpy as np

D_MODEL = 2048
BATCH = 2
SEQ = 8192
DEPTH = 4

CTX_LEN = 256
GRID_W = 64
CHUNK = 128
EPS = 1e-6

A_HEADS = 4
A_DIM = 128
A_WIDTH = A_HEADS * A_DIM
B_HEADS = 8
B_KV_HEADS = 2
HEAD_DIM = 128
B_GROUP = B_HEADS // B_KV_HEADS
B_WIDTH = B_HEADS * HEAD_DIM
B_KV_WIDTH = B_KV_HEADS * HEAD_DIM
WINDOW = 128
ROPE_THETA = 10000.0
ROPE_FREQS = HEAD_DIM // 4
C_GROUPS = 4
C_DIM = 128
C_WIDTH = C_GROUPS * C_DIM

MIX_WIDTH = A_WIDTH + B_WIDTH + C_WIDTH
SPLIT_SIZES = (A_WIDTH, A_WIDTH, A_WIDTH, B_WIDTH, B_KV_WIDTH, B_KV_WIDTH, B_WIDTH, C_WIDTH, C_WIDTH)
IN_COLS = 3 * A_WIDTH + 2 * B_WIDTH + 2 * B_KV_WIDTH + 2 * C_WIDTH
NEG_INF = -1e30

kernel_name = "hybrid_gmlp_swa_fnet_diffusion_trunk"


def rmsnorm(x, g):
    xf = x.astype(jnp.float32)
    y = xf * lax.rsqrt(jnp.mean(xf * xf, axis=-1, keepdims=True) + EPS)
    return (y * g.astype(jnp.float32)).astype(x.dtype)


def split_cols(proj):
    idx, acc = [], 0
    for s in SPLIT_SIZES[:-1]:
        acc += s
        idx.append(acc)
    return jnp.split(proj, idx, axis=-1)


def rope_tables(row, col):
    freqs = ROPE_THETA ** (-jnp.arange(ROPE_FREQS, dtype=jnp.float32) / ROPE_FREQS)
    ang = jnp.stack([row.astype(jnp.float32)[:, None] * freqs,
                     col.astype(jnp.float32)[:, None] * freqs], axis=1)
    ang = jnp.broadcast_to(ang[:, :, None, :], (ang.shape[0], 2, 2, ROPE_FREQS))
    ang = ang.reshape(ang.shape[0], HEAD_DIM)
    return jnp.cos(ang), jnp.sin(ang)


def rope_2d(x, cos, sin):
    shp = x.shape
    xf = x.astype(jnp.float32).reshape(*shp[:-1], 2, 2, ROPE_FREQS)
    rot = jnp.stack([-xf[..., 1, :], xf[..., 0, :]], axis=-2).reshape(shp)
    out = xf.reshape(shp) * cos[None, :, None, :] + rot * sin[None, :, None, :]
    return out.astype(x.dtype)


def chunk_gmlp(u, v, g_sgu, w_s, b_s):
    bsz, t, _ = v.shape
    nc = t // CHUNK
    vn = rmsnorm(v, g_sgu).reshape(bsz, nc, CHUNK, A_HEADS, A_DIM)
    mixed = jnp.einsum('hpq,bcqhd->bcphd', w_s, vn) + b_s.T[None, None, :, :, None]
    return u * mixed.reshape(bsz, t, A_WIDTH)


def fourier_mix(xc, w_f, b_f):
    bsz, t, _ = xc.shape
    xg = xc.reshape(bsz, t, C_GROUPS, C_DIM).astype(jnp.float32)
    y = jnp.fft.fft2(xg, axes=(1, 3), norm='ortho').real.astype(xc.dtype)
    y = jnp.einsum('btgc,gcd->btgd', y, w_f) + b_f
    return y.reshape(bsz, t, C_WIDTH)


def sink_column(sink, shape_prefix):
    s = sink.astype(jnp.float32).reshape(B_KV_HEADS, B_GROUP)
    return jnp.broadcast_to(s[:, :, None, None], shape_prefix + (1,))


def window_attention(q, k, v, k_ctx, v_ctx, sink):
    bsz, s, _, dh = q.shape
    nb = s // CHUNK
    scale = dh ** -0.5
    pad = ((0, 0), (CHUNK, CHUNK), (0, 0), (0, 0))
    kp = jnp.pad(k, pad).reshape(bsz, nb + 2, CHUNK, B_KV_HEADS, dh)
    vp = jnp.pad(v, pad).reshape(bsz, nb + 2, CHUNK, B_KV_HEADS, dh)
    kw = jnp.concatenate([kp[:, :-2], kp[:, 1:-1], kp[:, 2:]], axis=2)
    vw = jnp.concatenate([vp[:, :-2], vp[:, 1:-1], vp[:, 2:]], axis=2)
    qb = q.reshape(bsz, nb, CHUNK, B_KV_HEADS, B_GROUP, dh)
    s_loc = jnp.einsum('bnqkgd,bnjkd->bnkgqj', qb, kw).astype(jnp.float32) * scale
    s_ctx = jnp.einsum('bnqkgd,bmkd->bnkgqm', qb, k_ctx).astype(jnp.float32) * scale
    a = jnp.arange(CHUNK)[:, None]
    j = jnp.arange(3 * CHUNK)[None, :]
    blk = jnp.arange(nb)[:, None, None]
    key_pos = blk * CHUNK - CHUNK + j
    mask = (jnp.abs(j - CHUNK - a) <= WINDOW)[None] & (key_pos >= 0) & (key_pos < s)
    s_loc = jnp.where(mask[None, :, None, None], s_loc, NEG_INF)
    sk = sink_column(sink, (bsz, nb, B_KV_HEADS, B_GROUP, CHUNK))
    n_ctx = k_ctx.shape[1]
    p = jax.nn.softmax(jnp.concatenate([sk, s_ctx, s_loc], axis=-1), axis=-1)
    p_ctx = p[..., 1:1 + n_ctx].astype(v.dtype)
    p_loc = p[..., 1 + n_ctx:].astype(v.dtype)
    o = (jnp.einsum('bnkgqm,bmkd->bnqkgd', p_ctx, v_ctx)
         + jnp.einsum('bnkgqj,bnjkd->bnqkgd', p_loc, vw))
    return o.reshape(bsz, s, B_WIDTH)


def context_attention(q, k, v, sink):
    bsz, n, _, dh = q.shape
    qg = q.reshape(bsz, n, B_KV_HEADS, B_GROUP, dh)
    s = jnp.einsum('blkgd,bmkd->bkglm', qg, k).astype(jnp.float32) * (dh ** -0.5)
    sk = sink_column(sink, (bsz, B_KV_HEADS, B_GROUP, n))
    p = jax.nn.softmax(jnp.concatenate([sk, s], axis=-1), axis=-1)[..., 1:].astype(v.dtype)
    o = jnp.einsum('bkglm,bmkd->blkgd', p, v)
    return o.reshape(bsz, n, B_WIDTH)


def mixer_branches(proj, attn_fn, g_sgu, w_s, b_s, w_f, b_f):
    a_u, a_v, a_g, b_q, b_k, b_v, b_g, c_x, c_g = split_cols(proj)
    y_a = chunk_gmlp(jax.nn.gelu(a_u), jax.nn.gelu(a_v), g_sgu, w_s, b_s) * jax.nn.silu(a_g)
    y_b = attn_fn(b_q, b_k, b_v) * jax.nn.silu(b_g)
    y_c = fourier_mix(c_x, w_f, b_f) * jax.nn.silu(c_g)
    return jnp.concatenate([y_a, y_b, y_c], axis=-1)


def heads(t, n_heads):
    return t.reshape(t.shape[0], t.shape[1], n_heads, HEAD_DIM)


def setup_inputs(seed: int = 0) -> dict:
    key = jax.random.key(seed)
    ks = jax.random.split(key, 20)
    nrm = jax.random.normal
    f32 = jnp.float32
    return {
        "x": nrm(ks[0], (BATCH, SEQ, D_MODEL), f32),
        "c": nrm(ks[1], (BATCH, D_MODEL), f32),
        "ctx": nrm(ks[2], (BATCH, CTX_LEN, D_MODEL), f32),
        "c_ctx": nrm(ks[3], (D_MODEL,), f32),
        "w_mod": nrm(ks[4], (DEPTH, D_MODEL, 3 * D_MODEL), f32) * D_MODEL ** -0.5,
        "b_mod": nrm(ks[5], (DEPTH, 3 * D_MODEL), f32) * 0.01,
        "g_pre": 1.0 + 0.01 * nrm(ks[6], (DEPTH, D_MODEL), f32),
        "g_post": 1.0 + 0.01 * nrm(ks[7], (DEPTH, D_MODEL), f32),
        "w_in": nrm(ks[8], (DEPTH, D_MODEL, IN_COLS), f32) * D_MODEL ** -0.5,
        "w_out": nrm(ks[9], (DEPTH, MIX_WIDTH, D_MODEL), f32) * MIX_WIDTH ** -0.5,
        "g_sgu": 1.0 + 0.01 * nrm(ks[10], (DEPTH, A_WIDTH), f32),
        "w_sgu": nrm(ks[11], (DEPTH, A_HEADS, CHUNK, CHUNK), f32) * CHUNK ** -0.5,
        "b_sgu": nrm(ks[12], (DEPTH, A_HEADS, CHUNK), f32) * 0.01,
        "sink": nrm(ks[13], (DEPTH, B_HEADS), f32) * 0.5,
        "w_fourier": nrm(ks[14], (DEPTH, C_GROUPS, C_DIM, C_DIM), f32) * C_DIM ** -0.5,
        "b_fourier": nrm(ks[15], (DEPTH, C_GROUPS, C_DIM), f32) * 0.01,
    }


def reference(x, c, ctx, c_ctx, w_mod, b_mod, g_pre, g_post, w_in, w_out,
              g_sgu, w_sgu, b_sgu, sink, w_fourier, b_fourier):
    s = x.shape[1]
    rows = s // GRID_W
    row = jnp.repeat(jnp.arange(rows), GRID_W)
    col = jnp.tile(jnp.arange(GRID_W), rows)
    cos, sin = rope_tables(row, col)
    silu_c = jax.nn.silu(c)
    silu_cc = jax.nn.silu(c_ctx)

    for l in range(DEPTH):
        last = l == DEPTH - 1
        shift, scale, gate = jnp.split(silu_c @ w_mod[l] + b_mod[l], 3, axis=-1)
        shift_c, scale_c, gate_c = jnp.split(silu_cc @ w_mod[l] + b_mod[l], 3, axis=-1)

        h = rmsnorm(x, g_pre[l]) * (1.0 + scale[:, None]) + shift[:, None]
        h_c = rmsnorm(ctx, g_pre[l]) * (1.0 + scale_c) + shift_c
        proj = h @ w_in[l]
        proj_c = h_c @ w_in[l]

        pc = split_cols(proj_c)
        k_ctx = heads(pc[4], B_KV_HEADS)
        v_ctx = heads(pc[5], B_KV_HEADS)
        sink_l = sink[l]

        def latent_attn(bq, bk, bv):
            q = rope_2d(heads(bq, B_HEADS), cos, sin)
            k = rope_2d(heads(bk, B_KV_HEADS), cos, sin)
            return window_attention(q, k, heads(bv, B_KV_HEADS), k_ctx, v_ctx, sink_l)

        y = mixer_branches(proj, latent_attn, g_sgu[l], w_sgu[l], b_sgu[l],
                           w_fourier[l], b_fourier[l])
        y = rmsnorm(y @ w_out[l], g_post[l])
        x_new = x + gate[:, None] * y

        if not last:
            def ctx_attn(bq, bk, bv):
                return context_attention(heads(bq, B_HEADS), heads(bk, B_KV_HEADS),
                                         heads(bv, B_KV_HEADS), sink_l)

            y_c = mixer_branches(proj_c, ctx_attn, g_sgu[l], w_sgu[l], b_sgu[l],
                                 w_fourier[l], b_fourier[l])
            y_c = rmsnorm(y_c @ w_out[l], g_post[l])
            ctx = ctx + gate_c * y_c
        x = x_new
    return x
```

```cpp
#include <hip/hip_runtime.h>
#include <hip/hip_cooperative_groups.h>
#include <cstdio>
#include <cstdint>
namespace cg = cooperative_groups;

#define LAS __attribute__((address_space(3)))
typedef unsigned short bf16_t;
typedef short bf16x8 __attribute__((ext_vector_type(8)));
typedef short bf16x4 __attribute__((ext_vector_type(4)));
typedef float f32x4 __attribute__((ext_vector_type(4)));
typedef unsigned u32x2 __attribute__((ext_vector_type(2)));
typedef unsigned u32x4 __attribute__((ext_vector_type(4)));

constexpr int DM = 2048, SEQ = 8192, NB = 2, DEPTH = 4, CTXL = 256;
constexpr int MLAT = NB * SEQ;
constexpr int MROWS = MLAT + NB * CTXL;
constexpr int NCOL = 5632;
constexpr int C_AU = 0, C_AV = 512, C_AG = 1024, C_Q = 1536, C_K = 2560, C_V = 2816, C_BG = 3072, C_ZR = 4096, C_CG = 5120;
constexpr float EPS = 1e-6f;
constexpr float QSCALE = 0.08838834764831845f * 1.4426950408889634f;
constexpr float LOG2E = 1.4426950408889634f;

constexpr size_t AL(size_t x) { return (x + 255) & ~(size_t)255; }
constexpr size_t O_WINT = 0;
constexpr size_t O_WOUTT = O_WINT + AL((size_t)DEPTH * NCOL * DM * 2);
constexpr size_t O_WCX = O_WOUTT + AL((size_t)DEPTH * DM * DM * 2);
constexpr size_t O_MTF = O_WCX + AL((size_t)DEPTH * DM * 512 * 2);
constexpr size_t O_MODP = O_MTF + AL((size_t)DEPTH * 1024 * 512 * 2);
constexpr size_t O_MOD = O_MODP + AL((size_t)DEPTH * 32 * 3 * 6144 * 4);
constexpr size_t O_ROPE = O_MOD + AL((size_t)DEPTH * 3 * 6144 * 4);
constexpr size_t O_TWID = O_ROPE + AL((size_t)128 * 32 * 8);
constexpr size_t O_F128 = O_TWID + AL((size_t)8192 * 8);
constexpr size_t O_F64 = O_F128 + AL((size_t)256 * 256 * 2);
constexpr size_t O_DCTX = O_F64 + AL((size_t)64 * 128 * 2);
constexpr size_t O_XC = O_DCTX + AL((size_t)256 * 512 * 2);
constexpr size_t O_HMIX = O_XC + AL((size_t)512 * DM * 4);
constexpr size_t O_PROJ = O_HMIX + AL((size_t)MROWS * DM * 2);
constexpr size_t O_AVT = O_PROJ + AL((size_t)MROWS * NCOL * 2);
constexpr size_t O_VT = O_AVT + AL((size_t)132 * 512 * 128 * 2);
constexpr size_t O_VTC = O_VT + AL((size_t)NB * 2 * 128 * SEQ * 2);
constexpr size_t O_ZT = O_VTC + AL((size_t)NB * 2 * 128 * CTXL * 2);
constexpr size_t O_ZTC = O_ZT + AL((size_t)NB * 512 * 64 * 256 * 2);
constexpr size_t O_BINT = O_ZTC + AL((size_t)NB * 512 * 512 * 2);
constexpr size_t O_YC = O_BINT + AL((size_t)NB * 128 * 512 * 128 * 2);
constexpr size_t O_BAR = O_YC + AL((size_t)512 * DM * 2);
constexpr size_t WS_END = O_BAR + 16384;

struct Params {
    const float *x, *c, *ctx, *c_ctx, *w_mod, *b_mod, *g_pre, *g_post, *w_in, *w_out, *g_sgu, *w_sgu, *b_sgu, *sink, *w_f, *b_f;
    float* out;
    unsigned char* ws;
};

__device__ __forceinline__ Params load_params() {
#if defined(__HIP_DEVICE_COMPILE__)
    auto p = __builtin_amdgcn_kernarg_segment_ptr(); asm volatile("" : "+s"(p));
    return *(const __attribute__((address_space(4))) Params*)p;
#else
    return Params{};
#endif
}
__device__ __forceinline__ int lv(int x) { asm volatile("" : "+v"(x)); return x; }
template <class T> __device__ __forceinline__ T* ls(T* p) { asm volatile("" : "+s"(p)); return p; }
__device__ __forceinline__ unsigned cvt_pk_bf16(float lo, float hi) { unsigned r; asm volatile("v_cvt_pk_bf16_f32 %0, %1, %2" : "=v"(r) : "v"(lo), "v"(hi)); return r; }
__device__ __forceinline__ bf16_t f2bf(float v) { return (bf16_t)(cvt_pk_bf16(v, 0.f) & 0xffffu); }
__device__ __forceinline__ float bf2f(unsigned b) { return __uint_as_float(b << 16); }
__device__ __forceinline__ float bflo(unsigned w) { return __uint_as_float(w << 16); }
__device__ __forceinline__ float bfhi(unsigned w) { return __uint_as_float(w & 0xffff0000u); }
__device__ __forceinline__ float gelu_t(float x) { const float u2 = x * (x * x * (-2.f * 0.7978845608028654f * 0.044715f * 1.4426950408889634f) + (-2.f * 0.7978845608028654f * 1.4426950408889634f)); return x * __builtin_amdgcn_rcpf(1.f + __builtin_amdgcn_exp2f(u2)); }
__device__ __forceinline__ float silu_f(float x) { return x * __builtin_amdgcn_rcpf(1.f + __builtin_amdgcn_exp2f(x * -1.4426950408889634f)); }
__device__ __forceinline__ float wave_sum(float v) {
#pragma unroll
    for (int o = 1; o < 64; o <<= 1) v += __shfl_xor(v, o);
    return v;
}
__device__ __forceinline__ float xor16_max(float x) { auto r = __builtin_amdgcn_permlane16_swap(__float_as_uint(x), __float_as_uint(x), false, false); return fmaxf(__uint_as_float(r[0]), __uint_as_float(r[1])); }
__device__ __forceinline__ float xor32_max(float x) { auto r = __builtin_amdgcn_permlane32_swap(__float_as_uint(x), __float_as_uint(x), false, false); return fmaxf(__uint_as_float(r[0]), __uint_as_float(r[1])); }
__device__ __forceinline__ float xor16_sum(float x) { auto r = __builtin_amdgcn_permlane16_swap(__float_as_uint(x), __float_as_uint(x), false, false); return __uint_as_float(r[0]) + __uint_as_float(r[1]); }
__device__ __forceinline__ float xor32_sum(float x) { auto r = __builtin_amdgcn_permlane32_swap(__float_as_uint(x), __float_as_uint(x), false, false); return __uint_as_float(r[0]) + __uint_as_float(r[1]); }
__device__ __forceinline__ u32x2 pack4(float a, float b, float c, float d) { u32x2 r; r.x = cvt_pk_bf16(a, b); r.y = cvt_pk_bf16(c, d); return r; }

namespace pg8 {
constexpr int BM = 256, BK = 64, HALF = 128, HTB = HALF * BK * 2, STAGE_BYTES = 8 * HTB, NXCD = 8, WGM = 8;
__host__ __device__ __forceinline__ int lds_byte(int r, int c) { const int st = (r >> 4) * 2 + (c >> 5), rr = r & 15, cc = c & 31, ob = rr * 64 + cc * 2; return st * 1024 + (ob ^ (((ob >> 9) & 1) << 5)); }
__host__ __device__ __forceinline__ void stage_rc(int b, int& R, int& C) { const int st = b / 1024, sb = b % 1024, swz = sb ^ (((sb >> 9) & 1) << 5); R = (st >> 1) * 16 + swz / 64; C = (st & 1) * 32 + (swz % 64) / 2; }
__host__ __device__ __forceinline__ int perm32(int rho) { const int n = rho >> 4, i = rho & 15; return 8 * (i >> 2) + 4 * n + (i & 3); }
struct Unit { int pm, pn; };
struct Gemm { const bf16_t* A; const bf16_t* Bt; int K; };

struct SchedBase {
    __device__ __forceinline__ void amap(const Unit& u, const Gemm& g, const char*& base, unsigned& rs, unsigned& hs) const {
        rs = (unsigned)g.K * 2u; hs = (unsigned)HALF * g.K * 2u; base = (const char*)g.A + (size_t)u.pm * BM * g.K * 2;
    }
    __device__ __forceinline__ void bmap(const Unit& u, const Gemm& g, const char*& base, unsigned& rs, unsigned& hs) const {
        rs = (unsigned)g.K * 2u; hs = (unsigned)HALF * g.K * 2u; base = (const char*)g.Bt + (size_t)u.pn * BM * g.K * 2;
    }
};
struct StaticOrder : SchedBase {
    int nM, nN, nwg, G, c;
    __device__ void init(int nM_, int nN_, int G_, int c_) { nM = nM_; nN = nN_; nwg = nM * nN; G = G_; c = c_; }
    __device__ bool next(int i, Unit& u) const {
        const long L = (long)i * G + c; if (L >= nwg) return false;
        int wgid = (int)L; { const int q = nwg / NXCD, r = nwg % NXCD, xcd = wgid % NXCD, off = wgid / NXCD; wgid = (xcd < r ? xcd * (q + 1) : r * (q + 1) + (xcd - r) * q) + off; }
        const int nig = WGM * nN, gid = wgid / nig, fm = gid * WGM, gsz = (nM - fm) < WGM ? (nM - fm) : WGM;
        u.pm = fm + ((wgid % nig) % gsz); u.pn = (wgid % nig) / gsz; return true;
    }
};

template <class Epi, class Sched>
__device__ __forceinline__ void gemm_phase(LAS unsigned char* lds, const Gemm g, const Sched& S, const Epi& E) {
    const int tid = lv(threadIdx.x), wid = __builtin_amdgcn_readfirstlane(tid >> 6), lane = tid & 63, wr = wid >> 2, wc = wid & 3, fr = lane & 15, fq = lane >> 4;
    int K = g.K; asm volatile("" : "+s"(K));
    const int nt = K / BK;
#define PG8_VOFFB(dst, rs) do { const int _t = lv(tid); _Pragma("unroll") for (int _i = 0; _i < 2; ++_i) { int _R, _C; stage_rc(_t * 16 + _i * 8192, _R, _C); const int _Rb = (_R & ~31) + perm32(_R & 31); dst[_i] = (unsigned)_Rb * (rs) + (unsigned)_C * 2u; } } while (0)
#define PG8_VOFFA(dst, rs) do { const int _t = lv(tid); _Pragma("unroll") for (int _i = 0; _i < 2; ++_i) { int _R, _C; stage_rc(_t * 16 + _i * 8192, _R, _C); dst[_i] = (unsigned)_R * (rs) + (unsigned)_C * 2u; } } while (0)
    const size_t kstep = (size_t)(BK * 2);
    const unsigned ldsw = (unsigned)wid * 1024u;
    const int aoff = lds_byte(wr * 64 + fr, fq * 8), boff = lds_byte(wc * 32 + fr, fq * 8);
#define PG8_SA(b, h) (((b) * 2 + (h)) * HTB)
#define PG8_SB(b, h) ((4 + (b) * 2 + (h)) * HTB)
#define PG8_STAGE(bufoff, gbase, voff) do { _Pragma("unroll") for (int _i = 0; _i < 2; ++_i) \
        __builtin_amdgcn_global_load_lds((const unsigned*)((const char*)(gbase) + (voff)[_i]), (LAS unsigned*)(lds + (bufoff) + ldsw + _i * 8192), 16, 0, 0); } while (0)
#define PG8_LDA(dst, b, h) do { _Pragma("unroll") for (int m = 0; m < 4; ++m) _Pragma("unroll") for (int k = 0; k < 2; ++k) dst[m][k] = *(const LAS bf16x8*)(lds + PG8_SA(b, h) + aoff + m * 2048 + k * 1024); } while (0)
#define PG8_LDB(dst, b, h) do { _Pragma("unroll") for (int n = 0; n < 2; ++n) _Pragma("unroll") for (int k = 0; k < 2; ++k) dst[n][k] = *(const LAS bf16x8*)(lds + PG8_SB(b, h) + boff + n * 2048 + k * 1024); } while (0)
#define PG8_MMA(ai, bj, At, Bt) do { __builtin_amdgcn_s_setprio(1); _Pragma("unroll") for (int m = 0; m < 4; ++m) _Pragma("unroll") for (int n = 0; n < 2; ++n) _Pragma("unroll") for (int k = 0; k < 2; ++k) \
        acc[ai][bj][m][n] = __builtin_amdgcn_mfma_f32_16x16x32_bf16(Bt[n][k], At[m][k], acc[ai][bj][m][n], 0, 0, 0); __builtin_amdgcn_s_setprio(0); } while (0)
#define PG8_WAIT_V(n) asm volatile("s_waitcnt vmcnt(" #n ")" ::: "memory")
#define PG8_WAIT_L(n) asm volatile("s_waitcnt lgkmcnt(" #n ")" ::: "memory")
#define PG8_BAR __builtin_amdgcn_s_barrier()
#define PG8_SCHED __builtin_amdgcn_sched_barrier(0)
    Unit cur, nxt; int ui = 0;
    if (!S.next(0, cur)) return;
    f32x4 acc[2][2][4][2];
#pragma unroll
    for (int a = 0; a < 2; ++a)
#pragma unroll
        for (int b = 0; b < 2; ++b)
#pragma unroll
            for (int m = 0; m < 4; ++m)
#pragma unroll
                for (int n = 0; n < 2; ++n) acc[a][b][m][n] = (f32x4){0.f, 0.f, 0.f, 0.f};
    bf16x8 At[4][2], B0[2][2], B1[2][2];
    const char* cA; unsigned cRS, cHS; S.amap(cur, g, cA, cRS, cHS);
    unsigned vAc[2]; PG8_VOFFA(vAc, cRS);
    const char* cB; unsigned cRSB, cHSB; S.bmap(cur, g, cB, cRSB, cHSB);
    unsigned vBc[2]; PG8_VOFFB(vBc, cRSB);
    PG8_STAGE(PG8_SB(0, 0), cB, vBc); PG8_STAGE(PG8_SA(0, 0), cA, vAc); PG8_STAGE(PG8_SB(0, 1), cB + cHSB, vBc); PG8_STAGE(PG8_SA(0, 1), cA + cHS, vAc);
    if (wr == 1) PG8_BAR;
    PG8_WAIT_V(4); PG8_BAR;
    PG8_STAGE(PG8_SB(1, 0), cB + kstep, vBc); PG8_STAGE(PG8_SA(1, 0), cA + kstep, vAc); PG8_STAGE(PG8_SB(1, 1), cB + cHSB + kstep, vBc);
    PG8_WAIT_V(6); PG8_BAR;
    for (;;) {
        const bool has_next = S.next(ui + 1, nxt);
        const char* nA = cA; unsigned nRS = cRS, nHS = cHS; const char* nB = cB; unsigned nRSB = cRSB, nHSB = cHSB;
        if (has_next) { S.amap(nxt, g, nA, nRS, nHS); S.bmap(nxt, g, nB, nRSB, nHSB); }
        for (int t = 0; t < nt; t += 2) {
            const bool last = (t == nt - 2);
            const char* a1 = cA + (size_t)(t + 1) * kstep;
            const char* a2 = last ? nA : cA + (size_t)(t + 2) * kstep; const char* b2 = last ? nB : cB + (size_t)(t + 2) * kstep;
            const char* a3 = a2 + kstep; const char* b3 = b2 + kstep;
            const unsigned hs2 = last ? nHS : cHS;
            unsigned v2[2] = {vAc[0], vAc[1]}; if (last) PG8_VOFFA(v2, nRS);
            const unsigned hsB2 = last ? nHSB : cHSB;
            unsigned vB2[2] = {vBc[0], vBc[1]}; if (last) PG8_VOFFB(vB2, nRSB);
            PG8_LDB(B0, 0, 0); PG8_SCHED; PG8_LDA(At, 0, 0); PG8_STAGE(PG8_SA(1, 1), a1 + cHS, vAc);
            PG8_WAIT_L(8); PG8_BAR; PG8_WAIT_L(0); PG8_MMA(0, 0, At, B0); PG8_BAR; PG8_SCHED;
            PG8_LDB(B1, 0, 1); PG8_STAGE(PG8_SB(0, 0), b2, vB2);
            PG8_BAR; PG8_WAIT_L(0); PG8_MMA(0, 1, At, B1); PG8_BAR;
            PG8_LDA(At, 0, 1); PG8_STAGE(PG8_SA(0, 0), a2, v2);
            PG8_BAR; PG8_WAIT_L(0); PG8_MMA(1, 0, At, B0); PG8_BAR; PG8_SCHED;
            PG8_STAGE(PG8_SB(0, 1), b2 + hsB2, vB2);
            PG8_WAIT_V(6); PG8_BAR; PG8_MMA(1, 1, At, B1); PG8_BAR;
            PG8_LDB(B0, 1, 0); PG8_SCHED; PG8_LDA(At, 1, 0); PG8_STAGE(PG8_SA(0, 1), a2 + hs2, v2);
            PG8_WAIT_L(8); PG8_BAR; PG8_WAIT_L(0); PG8_MMA(0, 0, At, B0); PG8_BAR; PG8_SCHED;
            PG8_LDB(B1, 1, 1); PG8_STAGE(PG8_SB(1, 0), b3, vB2);
            PG8_BAR; PG8_WAIT_L(0); PG8_MMA(0, 1, At, B1); PG8_BAR;
            PG8_LDA(At, 1, 1); PG8_STAGE(PG8_SA(1, 0), a3, v2);
            PG8_BAR; PG8_WAIT_L(0); PG8_MMA(1, 0, At, B0); PG8_BAR; PG8_SCHED;
            PG8_STAGE(PG8_SB(1, 1), b3 + hsB2, vB2);
            PG8_WAIT_V(6); PG8_BAR; PG8_MMA(1, 1, At, B1); PG8_BAR;
        }
        { const int l2 = lv(threadIdx.x) & 63; E(acc, cur, wr, wc, l2 & 15, l2 >> 4); }
        if (!has_next) break;
#pragma unroll
        for (int a = 0; a < 2; ++a)
#pragma unroll
            for (int b = 0; b < 2; ++b)
#pragma unroll
                for (int m = 0; m < 4; ++m)
#pragma unroll
                    for (int n = 0; n < 2; ++n) acc[a][b][m][n] = (f32x4){0.f, 0.f, 0.f, 0.f};
        cur = nxt; cA = nA; cRS = nRS; cHS = nHS; PG8_VOFFA(vAc, cRS); cB = nB; cRSB = nRSB; cHSB = nHSB; PG8_VOFFB(vBc, cRSB); ++ui;
    }
    PG8_WAIT_V(0);
    if (wr == 0) PG8_BAR;
    PG8_BAR;
#undef PG8_VOFFA
#undef PG8_VOFFB
#undef PG8_SA
#undef PG8_SB
#undef PG8_STAGE
#undef PG8_LDA
#undef PG8_LDB
#undef PG8_MMA
#undef PG8_WAIT_V
#undef PG8_WAIT_L
#undef PG8_BAR
#undef PG8_SCHED
}
}
using pg8::Unit;
using pg8::Gemm;

__device__ __forceinline__ bool in_swapped(int pn) { return pn == 2 || pn == 3 || pn == 11 || (pn >= 16 && pn < 20); }
struct SchedIn : pg8::StaticOrder {
    __device__ __forceinline__ void tokmap(const Unit& u, bool gather, const Gemm& g, const char*& base, unsigned& rs, unsigned& hs) const {
        if (gather && u.pm < 64) { const int b = u.pm >> 5, t20 = 2 * (u.pm & 31); rs = 64u * DM * 2u; hs = DM * 2u; base = (const char*)g.A + ((size_t)b * SEQ + t20) * DM * 2; }
        else { rs = DM * 2u; hs = 128u * DM * 2u; base = (const char*)g.A + (size_t)u.pm * 256 * DM * 2; }
    }
    __device__ __forceinline__ void wmap(const Unit& u, const Gemm& g, const char*& base, unsigned& rs, unsigned& hs) const {
        rs = DM * 2u; hs = 128u * DM * 2u; base = (const char*)g.Bt + (size_t)u.pn * 256 * DM * 2;
    }
    __device__ __forceinline__ void amap(const Unit& u, const Gemm& g, const char*& base, unsigned& rs, unsigned& hs) const {
        if (in_swapped(u.pn)) wmap(u, g, base, rs, hs); else tokmap(u, false, g, base, rs, hs);
    }
    __device__ __forceinline__ void bmap(const Unit& u, const Gemm& g, const char*& base, unsigned& rs, unsigned& hs) const {
        if (in_swapped(u.pn)) tokmap(u, u.pn >= 16, g, base, rs, hs); else wmap(u, g, base, rs, hs);
    }
};
struct SchedFold : pg8::SchedBase {
    int G, c;
    __device__ bool next(int i, Unit& u) const { const int L = i * G + c; if (L >= 128) return false; const int l = L >> 5, r = L & 31; u.pm = l * 4 + (r >> 3); u.pn = l * 8 + (r & 7); return true; }
};
struct SchedFew : pg8::SchedBase {
    int n, G, c;
    __device__ bool next(int i, Unit& u) const { const int L = i * G + c; if (c < 0 || L >= n) return false; u.pm = 0; u.pn = L; return true; }
};

struct EpiIn {
    bf16_t *PROJ, *avT, *VT, *VTc, *ZT, *ZTc; const float2* rope;
    __device__ __forceinline__ void operator()(const f32x4 (&acc)[2][2][4][2], const Unit& u, int wr, int wc, int fr, int fq) const {
        if (in_swapped(u.pn)) {
#pragma unroll
            for (int ai = 0; ai < 2; ++ai) {
                const int nt = 2 * u.pn + ai;
#pragma unroll
                for (int m = 0; m < 4; ++m) {
                    const int ch = wr * 64 + m * 16 + lv(fr);
#pragma unroll
                    for (int bj = 0; bj < 2; ++bj) {
                        const f32x4 v0 = acc[ai][bj][m][0], v1 = acc[ai][bj][m][1];
                        const int tk = 32 * wc + 8 * fq;
                        bf16_t* dst;
                        u32x4 pk;
                        if (nt < 8) {
                            const int chunk = u.pm * 2 + bj;
                            dst = avT + ((size_t)chunk * 512 + (nt - 4) * 128 + ch) * 128 + tk;
                            pk.x = cvt_pk_bf16(gelu_t(v0[0]), gelu_t(v0[1])); pk.y = cvt_pk_bf16(gelu_t(v0[2]), gelu_t(v0[3])); pk.z = cvt_pk_bf16(gelu_t(v1[0]), gelu_t(v1[1])); pk.w = cvt_pk_bf16(gelu_t(v1[2]), gelu_t(v1[3]));
                        } else {
                            pk.x = cvt_pk_bf16(v0[0], v0[1]); pk.y = cvt_pk_bf16(v0[2], v0[3]); pk.z = cvt_pk_bf16(v1[0], v1[1]); pk.w = cvt_pk_bf16(v1[2], v1[3]);
                            if (nt < 24) {
                                const int kvh = nt - 22, row = u.pm * 256 + bj * 128 + tk;
                                if (row < MLAT) dst = VT + ((size_t)((row >> 13) * 2 + kvh) * 128 + ch) * SEQ + (row & 8191);
                                else { const int rc = row - MLAT; dst = VTc + ((size_t)((rc >> 8) * 2 + kvh) * 128 + ch) * CTXL + (rc & 255); }
                            } else {
                                const int ri = (nt - 32) >> 2, j = ((nt - 32) & 3) * 128 + ch;
                                if (u.pm < 64) { const int b = u.pm >> 5, t2 = 2 * (u.pm & 31) + bj; dst = ZT + (((size_t)(b * 512 + j) * 64 + t2) * 256) + ri * 128 + tk; }
                                else { const int rc = (u.pm - 64) * 256 + bj * 128 + tk; dst = ZTc + ((size_t)((rc >> 8) * 512 + j) * 512) + ri * 256 + (rc & 255); }
                            }
                        }
                        *(u32x4*)dst = pk;
                    }
                    asm volatile("" ::: "memory");
                }
            }
            return;
        }
#pragma unroll
        for (int bj = 0; bj < 2; ++bj) {
            const int nt = 2 * u.pn + bj;
            const int colt = nt * 128 + 32 * wc + 8 * fq;
            if (nt < 4 || (nt >= 8 && nt < 12) || (nt >= 24 && nt < 32) || nt >= 40) {
                const bool is_gelu = nt < 4;
#pragma unroll
                for (int ai = 0; ai < 2; ++ai)
#pragma unroll
                    for (int m = 0; m < 4; ++m) {
                        const size_t row = (size_t)u.pm * 256 + ai * 128 + wr * 64 + m * 16 + lv(fr);
                        const f32x4 v0 = acc[ai][bj][m][0], v1 = acc[ai][bj][m][1]; float o[8];
#pragma unroll
                        for (int i = 0; i < 4; ++i) { o[i] = is_gelu ? gelu_t(v0[i]) : silu_f(v0[i]); o[4 + i] = is_gelu ? gelu_t(v1[i]) : silu_f(v1[i]); }
                        u32x4 pk; pk.x = cvt_pk_bf16(o[0], o[1]); pk.y = cvt_pk_bf16(o[2], o[3]); pk.z = cvt_pk_bf16(o[4], o[5]); pk.w = cvt_pk_bf16(o[6], o[7]);
                        *(u32x4*)(PROJ + row * NCOL + colt) = pk;
                        asm volatile("" ::: "memory");
                    }
            } else if (nt < 8) {
#pragma unroll
                for (int ai = 0; ai < 2; ++ai)
#pragma unroll
                    for (int m = 0; m < 4; ++m) {
                        const int row = u.pm * 256 + ai * 128 + wr * 64 + m * 16 + lv(fr);
                        const int chunk = row >> 7, q = row & 127;
#pragma unroll
                        for (int n = 0; n < 2; ++n) {
                            f32x4 v = acc[ai][bj][m][n];
                            const int c0 = (nt - 4) * 128 + 32 * wc + 8 * fq + 4 * n;
#pragma unroll
                            for (int i = 0; i < 4; ++i) avT[((size_t)chunk * 512 + c0 + i) * 128 + q] = f2bf(gelu_t(v[i]));
                            asm volatile("" ::: "memory");
                        }
                    }
            } else if (nt < 22) {
                const bool isq = nt < 20; const float sc = isq ? QSCALE : 1.f;
                const bool lat = u.pm < 64;
                float frev[4];
#pragma unroll
                for (int i = 0; i < 4; ++i) frev[i] = __builtin_amdgcn_exp2f(-(float)((wc & 1) * 16 + fq * 4 + i) * (13.287712379549449f / 32.f)) * 0.15915494309189535f;
#pragma unroll
                for (int ai = 0; ai < 2; ++ai)
#pragma unroll
                    for (int m = 0; m < 4; ++m) {
                        const size_t row = (size_t)u.pm * 256 + ai * 128 + wr * 64 + m * 16 + lv(fr);
                        const int tpos = (int)(row & 8191);
                        const int pos = (wc < 2) ? (tpos >> 6) : (tpos & 63);
                        const f32x4 x0 = acc[ai][bj][m][0], x1 = acc[ai][bj][m][1];
                        float o0[4], o1[4];
                        if (lat) {
#pragma unroll
                            for (int i = 0; i < 4; ++i) { const float rev = (float)pos * frev[i]; const float cx = __builtin_amdgcn_cosf(rev), sx = __builtin_amdgcn_sinf(rev);
                                o0[i] = (x0[i] * cx - x1[i] * sx) * sc; o1[i] = (x1[i] * cx + x0[i] * sx) * sc; }
                        } else {
#pragma unroll
                            for (int i = 0; i < 4; ++i) { o0[i] = x0[i] * sc; o1[i] = x1[i] * sc; }
                        }
                        u32x4 pk; pk.x = cvt_pk_bf16(o0[0], o0[1]); pk.y = cvt_pk_bf16(o0[2], o0[3]); pk.z = cvt_pk_bf16(o1[0], o1[1]); pk.w = cvt_pk_bf16(o1[2], o1[3]);
                        *(u32x4*)(PROJ + row * NCOL + colt) = pk;
                        asm volatile("" ::: "memory");
                    }
            } else if (nt < 24) {
                const int kvh = nt - 22;
#pragma unroll
                for (int ai = 0; ai < 2; ++ai)
#pragma unroll
                    for (int m = 0; m < 4; ++m) {
                        const int row = u.pm * 256 + ai * 128 + wr * 64 + m * 16 + lv(fr);
#pragma unroll
                        for (int n = 0; n < 2; ++n) {
                            f32x4 v = acc[ai][bj][m][n];
                            const int d0 = 32 * wc + 8 * fq + 4 * n;
                            if (row < MLAT) { const int b = row >> 13, t = row & 8191;
#pragma unroll
                                for (int i = 0; i < 4; ++i) VT[((size_t)(b * 2 + kvh) * 128 + d0 + i) * SEQ + t] = f2bf(v[i]);
                            } else { const int rc = row - MLAT, b = rc >> 8, t = rc & 255;
#pragma unroll
                                for (int i = 0; i < 4; ++i) VTc[((size_t)(b * 2 + kvh) * 128 + d0 + i) * CTXL + t] = f2bf(v[i]);
                            }
                            asm volatile("" ::: "memory");
                        }
                    }
            } else {
                const int ri = (nt - 32) >> 2, jt = ((nt - 32) & 3) * 128;
#pragma unroll
                for (int ai = 0; ai < 2; ++ai)
#pragma unroll
                    for (int m = 0; m < 4; ++m) {
                        const int R = wr * 64 + m * 16 + lv(fr);
#pragma unroll
                        for (int n = 0; n < 2; ++n) {
                            f32x4 v = acc[ai][bj][m][n];
                            const int j0 = jt + 32 * wc + 8 * fq + 4 * n;
                            if (u.pm < 64) { const int b = u.pm >> 5, t2 = 2 * (u.pm & 31) + ai;
#pragma unroll
                                for (int i = 0; i < 4; ++i) ZT[(((size_t)(b * 512 + j0 + i) * 64 + t2) * 256) + ri * 128 + R] = f2bf(v[i]);
                            } else { const int rc = (u.pm - 64) * 256 + ai * 128 + R, b = rc >> 8, t = rc & 255;
#pragma unroll
                                for (int i = 0; i < 4; ++i) ZTc[((size_t)(b * 512 + j0 + i) * 512) + ri * 256 + t] = f2bf(v[i]);
                            }
                            asm volatile("" ::: "memory");
                        }
                    }
            }
        }
    }
};
struct EpiOut {
    bf16_t* Y;
    __device__ __forceinline__ void operator()(const f32x4 (&acc)[2][2][4][2], const Unit& u, int wr, int wc, int fr, int fq) const {
#pragma unroll
        for (int ai = 0; ai < 2; ++ai)
#pragma unroll
            for (int m = 0; m < 4; ++m) {
                const size_t row = (size_t)u.pm * 256 + ai * 128 + wr * 64 + m * 16 + fr;
#pragma unroll
                for (int bj = 0; bj < 2; ++bj) { const f32x4 v0 = acc[ai][bj][m][0], v1 = acc[ai][bj][m][1];
                    u32x4 pk; pk.x = cvt_pk_bf16(v0[0], v0[1]); pk.y = cvt_pk_bf16(v0[2], v0[3]); pk.z = cvt_pk_bf16(v1[0], v1[1]); pk.w = cvt_pk_bf16(v1[2], v1[3]);
                    *(u32x4*)(Y + row * DM + u.pn * 256 + bj * 128 + 32 * wc + 8 * fq) = pk; }
            }
    }
};
struct EpiFold {
    bf16_t* WinT;
    __device__ __forceinline__ void operator()(const f32x4 (&acc)[2][2][4][2], const Unit& u, int wr, int wc, int fr, int fq) const {
        const int l = u.pm >> 2;
#pragma unroll
        for (int ai = 0; ai < 2; ++ai)
#pragma unroll
            for (int m = 0; m < 4; ++m) {
                const size_t r = (size_t)(u.pm & 3) * 256 + ai * 128 + wr * 64 + m * 16 + fr;
#pragma unroll
                for (int bj = 0; bj < 2; ++bj) { const f32x4 v0 = acc[ai][bj][m][0], v1 = acc[ai][bj][m][1];
                    u32x4 pk; pk.x = cvt_pk_bf16(v0[0], v0[1]); pk.y = cvt_pk_bf16(v0[2], v0[3]); pk.z = cvt_pk_bf16(v1[0], v1[1]); pk.w = cvt_pk_bf16(v1[2], v1[3]);
                    *(u32x4*)(WinT + ((size_t)l * NCOL + C_ZR + r) * DM + (u.pn & 7) * 256 + bj * 128 + 32 * wc + 8 * fq) = pk; }
            }
    }
};
struct EpiS1 {
    bf16_t* Bint;
    __device__ __forceinline__ void operator()(const f32x4 (&acc)[2][2][4][2], const Unit& u, int wr, int wc, int fr, int fq) const {
#pragma unroll
        for (int m = 0; m < 4; ++m) {
            const int k1 = lv(wr * 64 + m * 16 + fr);
#pragma unroll
            for (int bj = 0; bj < 2; ++bj) {
                const int c = u.pn * 256 + bj * 128 + 32 * wc + 8 * fq;
                const int t2 = c & 63, bjx = c >> 6, b = bjx >> 9, j = bjx & 511;
                float br[8], bi[8];
#pragma unroll
                for (int n = 0; n < 2; ++n) {
                    const f32x4 ar = acc[0][bj][m][n], aim = acc[1][bj][m][n];
#pragma unroll
                    for (int i = 0; i < 4; ++i) { const float rev = (float)(k1 * (t2 + 4 * n + i)) * (1.f / 8192.f); const float cw = __builtin_amdgcn_cosf(rev), sw = __builtin_amdgcn_sinf(rev);
                        br[4 * n + i] = ar[i] * cw - aim[i] * sw; bi[4 * n + i] = ar[i] * sw + aim[i] * cw; }
                }
                const unsigned off = (unsigned)(((b * 128 + k1) * 512 + j) * 128 + t2);
                u32x4 p0, p1; p0.x = cvt_pk_bf16(br[0], br[1]); p0.y = cvt_pk_bf16(br[2], br[3]); p0.z = cvt_pk_bf16(br[4], br[5]); p0.w = cvt_pk_bf16(br[6], br[7]);
                p1.x = cvt_pk_bf16(bi[0], bi[1]); p1.y = cvt_pk_bf16(bi[2], bi[3]); p1.z = cvt_pk_bf16(bi[4], bi[5]); p1.w = cvt_pk_bf16(bi[6], bi[7]);
                *(u32x4*)(Bint + off) = p0; *(u32x4*)(Bint + off + 64) = p1;
            }
            asm volatile("" ::: "memory");
        }
    }
};
struct EpiCtxF {
    bf16_t* MIX; const bf16_t* PROJ; const float* bf;
    __device__ __forceinline__ void operator()(const f32x4 (&acc)[2][2][4][2], const Unit& u, int wr, int wc, int fr, int fq) const {
#pragma unroll
        for (int ai = 0; ai < 2; ++ai) {
            u32x4 gg[4][2];
#pragma unroll
            for (int m = 0; m < 4; ++m)
#pragma unroll
                for (int bj = 0; bj < 2; ++bj) { const int k = ai * 128 + wr * 64 + m * 16 + fr, col = u.pn * 256 + bj * 128 + 32 * wc + 8 * fq, b = col >> 9, j = col & 511;
                    gg[m][bj] = *(const u32x4*)(PROJ + ((size_t)MLAT + b * 256 + k) * NCOL + C_CG + j); }
#pragma unroll
            for (int m = 0; m < 4; ++m)
#pragma unroll
                for (int bj = 0; bj < 2; ++bj) { const int k = ai * 128 + wr * 64 + m * 16 + fr, col = u.pn * 256 + bj * 128 + 32 * wc + 8 * fq, b = col >> 9, j = col & 511;
                    const f32x4 v0 = acc[ai][bj][m][0], v1 = acc[ai][bj][m][1]; const f32x4 b0 = *(const f32x4*)(bf + j), b1 = *(const f32x4*)(bf + j + 4); const u32x4 g2 = gg[m][bj];
                    u32x4 pk; pk.x = cvt_pk_bf16((v0[0] + b0[0]) * bflo(g2.x), (v0[1] + b0[1]) * bfhi(g2.x)); pk.y = cvt_pk_bf16((v0[2] + b0[2]) * bflo(g2.y), (v0[3] + b0[3]) * bfhi(g2.y));
                    pk.z = cvt_pk_bf16((v1[0] + b1[0]) * bflo(g2.z), (v1[1] + b1[1]) * bfhi(g2.z)); pk.w = cvt_pk_bf16((v1[2] + b1[2]) * bflo(g2.w), (v1[3] + b1[3]) * bfhi(g2.w));
                    *(u32x4*)(MIX + ((size_t)MLAT + b * 256 + k) * DM + 1536 + j) = pk; }
            asm volatile("" ::: "memory");
        }
    }
};

__device__ __forceinline__ int qk_dperm(int p) {
    const int wc = p >> 5, fq = (p >> 3) & 3, n = (p >> 2) & 1, i = p & 3;
    return (wc >> 1) * 64 + n * 32 + (wc & 1) * 16 + fq * 4 + i;
}
__device__ __forceinline__ void transpose_blk(const float* src, int sp, int scol0, bf16_t* dst, int k0, int nd0, bool perm, LAS float* scr) {
    const int tid = lv(threadIdx.x);
    f32x4 v[8];
#pragma unroll
    for (int i = 0; i < 8; ++i) { const int k = (tid >> 6) + 8 * i, c4 = (tid & 63) * 4; v[i] = *(const f32x4*)(src + (size_t)(k0 + k) * sp + scol0 + c4); }
#pragma unroll
    for (int i = 0; i < 8; ++i) { const int k = (tid >> 6) + 8 * i, c4 = (tid & 63) * 4; LAS float* s = scr + k * 257 + c4; s[0] = v[i][0]; s[1] = v[i][1]; s[2] = v[i][2]; s[3] = v[i][3]; }
    __syncthreads();
#pragma unroll
    for (int i = 0; i < 4; ++i) { const int n = (tid >> 3) + 64 * i, kc = tid & 7;
      int sc = n;
      if (perm) { const int p = (nd0 + n) & 127; sc = (n & ~63) + (qk_dperm(p) & 63); }
      const LAS float* s = scr + (kc * 8) * 257 + sc;
      u32x4 o; o.x = cvt_pk_bf16(s[0], s[257]); o.y = cvt_pk_bf16(s[2 * 257], s[3 * 257]); o.z = cvt_pk_bf16(s[4 * 257], s[5 * 257]); o.w = cvt_pk_bf16(s[6 * 257], s[7 * 257]);
      *(u32x4*)(dst + (size_t)(nd0 + n) * DM + k0 + kc * 8) = o; }
    __syncthreads();
}

__device__ __forceinline__ void phase0a(const Params& P_unused, LAS unsigned char* lds, int G) {
    const Params P = load_params(); (void)P_unused;
    unsigned char* ws = ls(P.ws);
    bf16_t* WinT = (bf16_t*)(ws + O_WINT); bf16_t* WoutT = (bf16_t*)(ws + O_WOUTT); bf16_t* Wcx = (bf16_t*)(ws + O_WCX); bf16_t* MTf = (bf16_t*)(ws + O_MTF);
    float* modp = (float*)(ws + O_MODP); float2* rope = (float2*)(ws + O_ROPE); float2* twid = (float2*)(ws + O_TWID);
    bf16_t* F128 = (bf16_t*)(ws + O_F128); bf16_t* F64 = (bf16_t*)(ws + O_F64); bf16_t* Dctx = (bf16_t*)(ws + O_DCTX);
    LAS float* scr = (LAS float*)lds;
    const int tid = lv(threadIdx.x), bid = blockIdx.x;
    for (int task = bid; task < 384; task += G) {
        const int l = task / 96, s = (task / 3) & 31, nc = task % 3;
        __syncthreads();
        if (tid < 192) { const int r = tid >> 6, kk = tid & 63; const float v = (r < 2) ? P.c[r * DM + s * 64 + kk] : P.c_ctx[s * 64 + kk]; scr[r * 64 + kk] = silu_f(v); }
        __syncthreads();
        const int n = nc * 2048 + tid * 4;
        f32x4 a0 = {0, 0, 0, 0}, a1 = {0, 0, 0, 0}, a2 = {0, 0, 0, 0};
        const float* wp = P.w_mod + ((size_t)l * DM + s * 64) * 6144 + n;
#pragma unroll 16
        for (int kk = 0; kk < 64; ++kk) { const f32x4 w = *(const f32x4*)(wp + (size_t)kk * 6144); a0 += w * scr[kk]; a1 += w * scr[64 + kk]; a2 += w * scr[128 + kk]; }
        float* op = modp + ((size_t)(l * 32 + s) * 3) * 6144 + n;
        *(f32x4*)(op) = a0; *(f32x4*)(op + 6144) = a1; *(f32x4*)(op + 2 * 6144) = a2;
    }
    __syncthreads();
    for (int task = bid; task < DEPTH * 18 * 32; task += G) {
        const int l = task / (18 * 32), r = task % (18 * 32), nb = r >> 5, kt = r & 31;
        const int nd0 = nb < 16 ? nb * 256 : (5120 + (nb - 16) * 256);
        const int scol0 = nb < 16 ? nd0 : nd0 - 512;
        const bool perm = (nd0 >= C_Q && nd0 < C_V);
        transpose_blk(P.w_in + (size_t)l * DM * 5120, 5120, scol0, WinT + (size_t)l * NCOL * DM, kt * 64, nd0, perm, scr);
    }
    for (int task = bid; task < DEPTH * 8 * 32; task += G) {
        const int l = task >> 8, r = task & 255, nb = r >> 5, kt = r & 31;
        transpose_blk(P.w_out + (size_t)l * DM * DM, DM, nb * 256, WoutT + (size_t)l * DM * DM, kt * 64, nb * 256, false, scr);
    }
    if (tid < 128) { const float a = (float)tid * (1.f / 64.f); scr[tid] = cospif(a); scr[128 + tid] = sinpif(a); }
    __syncthreads();
    const size_t gt = (size_t)bid * 512 + tid, GT = (size_t)G * 512;
    for (size_t e = gt; e < (size_t)DEPTH * DM * 128; e += GT) {
        const size_t lk = e >> 7; const int j4 = (int)(e & 127) * 4;
        const f32x4 v = *(const f32x4*)(P.w_in + lk * 5120 + 4096 + j4);
        *(u32x2*)(Wcx + lk * 512 + j4) = pack4(v[0], v[1], v[2], v[3]);
    }
    for (size_t e = gt; e < (size_t)DEPTH * 1024 * 512; e += GT) {
        const int col = (int)(e & 511), row = (int)((e >> 9) & 1023), l = (int)(e >> 19);
        const int ri = row >> 9, g = (row >> 7) & 3, d = row & 127, g2 = col >> 7, c = col & 127;
        float v = 0.f;
        if (g == g2) {
            const float* wf = P.w_f + ((size_t)(l * 4 + g) * 128) * 128 + d;
            float s = 0.f;
            const LAS float* tb = scr + ri * 128;
#pragma unroll 8
            for (int c2 = 0; c2 < 128; ++c2) s += tb[(c * c2) & 127] * wf[(size_t)c2 * 128];
            v = s * (1.f / 1024.f);
        }
        MTf[e] = f2bf(v);
    }
    for (size_t e = gt; e < 128 * 32; e += GT) { const int pos = (int)(e >> 5), f = (int)(e & 31);
        const float fr = powf(10000.f, -(float)f / 32.f); const float ang = (float)pos * fr; float sn, cs; sincosf(ang, &sn, &cs); rope[e] = make_float2(cs, sn); }
    for (size_t e = gt; e < 8192; e += GT) { const float a = (float)e * (1.f / 4096.f); twid[e] = make_float2(cospif(a), sinpif(a)); }
    for (size_t e = gt; e < 256 * 256; e += GT) { const int n = (int)(e >> 8), kk = (int)(e & 255); const int ro = n >> 7, k1 = n & 127, rin = kk >> 7, t1 = kk & 127;
        const float a = (float)((k1 * t1) & 127) * (1.f / 64.f); const float cs = cospif(a), sn = sinpif(a);
        const float v = ro == 0 ? (rin == 0 ? cs : -sn) : (rin == 0 ? sn : cs); F128[e] = f2bf(v); }
    for (size_t e = gt; e < 64 * 128; e += GT) { const int k2 = (int)(e >> 7), kk = (int)(e & 127); const int rin = kk >> 6, t2 = kk & 63;
        const float a = (float)((k2 * t2) & 63) * (1.f / 32.f); F64[e] = f2bf(rin == 0 ? cospif(a) : -sinpif(a)); }
    for (size_t e = gt; e < 256 * 512; e += GT) { const int k = (int)(e >> 9), kk = (int)(e & 511); const int rin = kk >> 8, t = kk & 255;
        const float a = (float)((k * t) & 255) * (1.f / 128.f); Dctx[e] = f2bf((rin == 0 ? cospif(a) : -sinpif(a)) * 5.656854249492381f); }
}

__device__ __forceinline__ void row_phase(const Params& P_unused, int layer, int G) {
    const Params P = load_params(); (void)P_unused;
    unsigned char* ws = ls(P.ws);
    const float* mod = (const float*)(ws + O_MOD);
    float* XC = (float*)(ws + O_XC);
    bf16_t* H = (bf16_t*)(ws + O_HMIX);
    const bf16_t* Y = (const bf16_t*)(ws + O_PROJ); const bf16_t* Yc = (const bf16_t*)(ws + O_YC);
    const int tid = lv(threadIdx.x);
    const int lane = tid & 63, gw = blockIdx.x * 8 + (tid >> 6), NGW = G * 8;
    const int nrows = layer == DEPTH ? MLAT : MROWS;
    const float* xlat = layer <= 1 ? P.x : P.out; const float* xctx = layer <= 1 ? P.ctx : XC;
    f32x4 vn[8]; u32x2 yn[8];
    if (gw < nrows) {
        const float* xin = gw < MLAT ? xlat + (size_t)gw * DM : xctx + (size_t)(gw - MLAT) * DM;
#pragma unroll
        for (int j = 0; j < 8; ++j) vn[j] = *(const f32x4*)(xin + lane * 4 + 256 * j);
        if (layer >= 1) {
            { const bf16_t* yr = gw < MLAT ? Y + (size_t)gw * DM : Yc + (size_t)(gw - MLAT) * DM;
#pragma unroll
            for (int j = 0; j < 8; ++j) yn[j] = *(const u32x2*)(yr + lane * 4 + 256 * j); }
        }
    }
    for (int row = gw; row < nrows; row += NGW) {
        const bool lat = row < MLAT; const int mr = lat ? (row >> 13) : 2;
        float* xout = lat ? P.out + (size_t)row * DM : XC + (size_t)(row - MLAT) * DM;
        f32x4 v[8]; u32x2 yw[8];
#pragma unroll
        for (int j = 0; j < 8; ++j) { v[j] = vn[j]; yw[j] = yn[j]; }
        const int nr = row + NGW;
        if (nr < nrows) {
            const float* xin = nr < MLAT ? xlat + (size_t)nr * DM : xctx + (size_t)(nr - MLAT) * DM;
#pragma unroll
            for (int j = 0; j < 8; ++j) vn[j] = *(const f32x4*)(xin + lane * 4 + 256 * j);
            if (layer >= 1) {
                { const bf16_t* yr = nr < MLAT ? Y + (size_t)nr * DM : Yc + (size_t)(nr - MLAT) * DM;
#pragma unroll
                for (int j = 0; j < 8; ++j) yn[j] = *(const u32x2*)(yr + lane * 4 + 256 * j); }
            }
        }
        if (layer >= 1) {
            const float* mg = mod + ((size_t)(layer - 1) * 3 + mr) * 6144 + 4096;
            const float* gp = P.g_post + (size_t)(layer - 1) * DM;
            f32x4 y[8]; float ss = 0.f;
#pragma unroll
            for (int j = 0; j < 8; ++j) { const u32x2 w = yw[j];
                y[j] = (f32x4){bflo(w.x), bfhi(w.x), bflo(w.y), bfhi(w.y)}; ss += y[j][0] * y[j][0] + y[j][1] * y[j][1] + y[j][2] * y[j][2] + y[j][3] * y[j][3]; }
            const float rinv = rsqrtf(wave_sum(ss) * (1.f / DM) + EPS);
#pragma unroll
            for (int j = 0; j < 8; ++j) { const f32x4 g4 = *(const f32x4*)(mg + lane * 4 + 256 * j), p4 = *(const f32x4*)(gp + lane * 4 + 256 * j);
                v[j] = v[j] + g4 * (y[j] * rinv * p4);
                *(f32x4*)(xout + lane * 4 + 256 * j) = v[j]; }
        }
        if (layer < DEPTH) {
            float ss = 0.f;
#pragma unroll
            for (int j = 0; j < 8; ++j) ss += v[j][0] * v[j][0] + v[j][1] * v[j][1] + v[j][2] * v[j][2] + v[j][3] * v[j][3];
            const float rinv = rsqrtf(wave_sum(ss) * (1.f / DM) + EPS);
            const float* msh = mod + ((size_t)layer * 3 + mr) * 6144; const float* msc = msh + 2048;
            const float* gp = P.g_pre + (size_t)layer * DM;
#pragma unroll
            for (int j = 0; j < 8; ++j) { const f32x4 sh = *(const f32x4*)(msh + lane * 4 + 256 * j), sc = *(const f32x4*)(msc + lane * 4 + 256 * j), g4 = *(const f32x4*)(gp + lane * 4 + 256 * j);
                const f32x4 h = (v[j] * rinv * g4) * (sc + 1.f) + sh;
                *(u32x2*)(H + (size_t)row * DM + lane * 4 + 256 * j) = pack4(h[0], h[1], h[2], h[3]); }
        }
    }
}

__device__ __forceinline__ void attn_task(const Params& P_unused, int layer, int task, LAS unsigned char* lds) {
    const Params P = load_params(); (void)P_unused;
    unsigned char* ws = ls(P.ws);
    const bf16_t* PROJ = (const bf16_t*)(ws + O_PROJ);
    const bf16_t* VT = (const bf16_t*)(ws + O_VT); const bf16_t* VTc = (const bf16_t*)(ws + O_VTC);
    bf16_t* MIX = (bf16_t*)(ws + O_HMIX);
    const int tid = lv(threadIdx.x);
    const int lane = tid & 63, w = __builtin_amdgcn_readfirstlane(tid >> 6), fr = lane & 15, fq = lane >> 4;
    int b, blk, kvh, pair; bool isctx;
    if (task < 512) { isctx = false; b = task >> 8; const int rem = task & 255; blk = rem >> 2; kvh = (rem >> 1) & 1; pair = rem & 1; }
    else { isctx = true; const int t = task - 512; b = t >> 3; blk = (t >> 2) & 1; kvh = (t >> 1) & 1; pair = t & 1; }
    const int head = kvh * 4 + pair * 2 + (w >> 2);
    const int a0 = (w & 3) * 32;
    const size_t qrow0 = (isctx ? (size_t)MLAT + b * CTXL : (size_t)b * SEQ) + blk * 128 + a0;
    bf16x8 qf[2][4];
#pragma unroll
    for (int u = 0; u < 2; ++u)
#pragma unroll
        for (int c = 0; c < 4; ++c) qf[u][c] = *(const bf16x8*)(PROJ + (qrow0 + u * 16 + fr) * NCOL + C_Q + head * 128 + c * 32 + fq * 8);
    u32x2 gws[2][8];
#pragma unroll
    for (int u = 0; u < 2; ++u)
#pragma unroll
        for (int dt = 0; dt < 8; ++dt) gws[u][dt] = *(const u32x2*)(PROJ + (qrow0 + u * 16 + fr) * NCOL + C_BG + head * 128 + dt * 16 + 4 * fq);
    float mrun[2], lrun[2];
    const float sk = P.sink[layer * 8 + head] * LOG2E;
    mrun[0] = mrun[1] = sk; lrun[0] = lrun[1] = 1.f;
    f32x4 o[8][2];
#pragma unroll
    for (int dt = 0; dt < 8; ++dt) { o[dt][0] = (f32x4){0, 0, 0, 0}; o[dt][1] = (f32x4){0, 0, 0, 0}; }
    const int nprev = (!isctx && blk > 0) ? 4 : 0, nnext = (!isctx && blk < 63) ? 4 : 0;
    const int T = isctx ? 8 : 12 + nprev + nnext;
    const int lkey = tid >> 4, lkc = (tid & 15) ^ (((lkey >> 3) << 2) | (lkey & 3));
    const unsigned koff = (unsigned)(lkey * NCOL + lkc * 8) * 2u;
    const int ld = tid >> 2, lvc = (tid & 3) ^ ((ld >> 2) & 3);
    const unsigned voff_c = (unsigned)(ld * CTXL + lvc * 8) * 2u, voff_s = (unsigned)(ld * SEQ + lvc * 8) * 2u;
    const char* kctx = (const char*)(PROJ + ((size_t)MLAT + b * CTXL) * NCOL + C_K + kvh * 128);
    const char* klat = (const char*)(PROJ + ((size_t)b * SEQ) * NCOL + C_K + kvh * 128);
    const char* vctx = (const char*)(VTc + (size_t)(b * 2 + kvh) * 128 * CTXL);
    const char* vlat = (const char*)(VT + (size_t)(b * 2 + kvh) * 128 * SEQ);
#define ATT_ISSUE(tt) do { int _t = (tt) < T ? (tt) : T - 1; const char* _kp; const char* _vp; unsigned _vo; \
        if (_t < 8) { _kp = kctx + (size_t)(_t * 32) * NCOL * 2; _vp = vctx + _t * 64; _vo = voff_c; } \
        else { const int _r = _t - 8, _seg = _r < nprev ? 0 : (_r < nprev + 4 ? 1 : 2), _st = _seg == 0 ? _r : (_seg == 1 ? _r - nprev : _r - nprev - 4); \
               const int _kb = (blk - 1 + _seg) * 128 + _st * 32; _kp = klat + (size_t)_kb * NCOL * 2; _vp = vlat + _kb * 2; _vo = voff_s; } \
        LAS unsigned char* _dst = lds + ((tt) & 7) * 16384 + w * 1024; \
        __builtin_amdgcn_global_load_lds((const unsigned*)(_kp + koff), (LAS unsigned*)(_dst), 16, 0, 0); \
        __builtin_amdgcn_global_load_lds((const unsigned*)(_vp + _vo), (LAS unsigned*)(_dst + 8192), 16, 0, 0); } while (0)
    ATT_ISSUE(0); ATT_ISSUE(1); ATT_ISSUE(2); ATT_ISSUE(3); ATT_ISSUE(4); ATT_ISSUE(5); ATT_ISSUE(6);
    const int kfo = (8 * (fr >> 2) + (fr & 3)) * 256, vfo = fr * 64 + ((fq ^ ((fr >> 2) & 3)) * 16);
    for (int t = 0; t < T; ++t) {
        asm volatile("s_waitcnt vmcnt(12) lgkmcnt(0)" ::: "memory");
        __builtin_amdgcn_s_barrier();
        asm volatile("" ::: "memory");
        ATT_ISSUE(t + 7);
        int mtype = 0, st = 0;
        if (t >= 8) { const int r = t - 8; if (r < nprev) { mtype = 1; st = r; } else if (r >= nprev + 4) { mtype = 2; st = r - nprev - 4; } }
        const int k0 = st * 32;
        if (mtype == 1 && k0 + 31 < a0) continue;
        if (mtype == 2 && k0 > a0 + 31) continue;
        const LAS unsigned char* kb = lds + (t & 7) * 16384; const LAS unsigned char* vb = kb + 8192;
        f32x4 s[2][2];
#pragma unroll
        for (int u = 0; u < 2; ++u) { s[u][0] = (f32x4){0, 0, 0, 0}; s[u][1] = (f32x4){0, 0, 0, 0}; }
#pragma unroll
        for (int v = 0; v < 2; ++v)
#pragma unroll
            for (int c = 0; c < 4; ++c) {
                const bf16x8 ka = *(const LAS bf16x8*)(kb + kfo + v * 1024 + (((c * 4 + fq) ^ fr) * 16));
                s[0][v] = __builtin_amdgcn_mfma_f32_16x16x32_bf16(ka, qf[0][c], s[0][v], 0, 0, 0);
                s[1][v] = __builtin_amdgcn_mfma_f32_16x16x32_bf16(ka, qf[1][c], s[1][v], 0, 0, 0);
            }
        bf16x8 pb[2];
#pragma unroll
        for (int u = 0; u < 2; ++u) {
            if (mtype == 1) {
                asm volatile("" ::: "memory");
                const int a = a0 + u * 16 + fr - k0 - 8 * fq;
#pragma unroll
                for (int v = 0; v < 2; ++v)
#pragma unroll
                    for (int r = 0; r < 4; ++r) { if (4 * v + r < a) s[u][v][r] = -1e30f; }
            } else if (mtype == 2) {
                asm volatile("" ::: "memory");
                const int a = a0 + u * 16 + fr - k0 - 8 * fq;
#pragma unroll
                for (int v = 0; v < 2; ++v)
#pragma unroll
                    for (int r = 0; r < 4; ++r) { if (4 * v + r > a) s[u][v][r] = -1e30f; }
            }
            float mx = fmaxf(fmaxf(fmaxf(s[u][0][0], s[u][0][1]), fmaxf(s[u][0][2], s[u][0][3])), fmaxf(fmaxf(s[u][1][0], s[u][1][1]), fmaxf(s[u][1][2], s[u][1][3])));
            mx = xor16_max(mx); mx = xor32_max(mx);
            const float mn = fmaxf(mrun[u], mx);
            const float alpha = __builtin_amdgcn_exp2f(mrun[u] - mn);
            float p[8]; float ps = 0.f;
#pragma unroll
            for (int v = 0; v < 2; ++v)
#pragma unroll
                for (int r = 0; r < 4; ++r) { p[v * 4 + r] = __builtin_amdgcn_exp2f(s[u][v][r] - mn); ps += p[v * 4 + r]; }
            ps = xor16_sum(ps); ps = xor32_sum(ps);
            lrun[u] = lrun[u] * alpha + ps;
            if (__any(mn > mrun[u])) {
#pragma unroll
                for (int dt = 0; dt < 8; ++dt) o[dt][u] = o[dt][u] * alpha;
            }
            mrun[u] = mn;
            u32x4 pk; pk.x = cvt_pk_bf16(p[0], p[1]); pk.y = cvt_pk_bf16(p[2], p[3]); pk.z = cvt_pk_bf16(p[4], p[5]); pk.w = cvt_pk_bf16(p[6], p[7]);
            pb[u] = __builtin_bit_cast(bf16x8, pk);
        }
#pragma unroll
        for (int dt = 0; dt < 8; ++dt) {
            const bf16x8 va = *(const LAS bf16x8*)(vb + dt * 1024 + vfo);
            o[dt][0] = __builtin_amdgcn_mfma_f32_16x16x32_bf16(va, pb[0], o[dt][0], 0, 0, 0);
            o[dt][1] = __builtin_amdgcn_mfma_f32_16x16x32_bf16(va, pb[1], o[dt][1], 0, 0, 0);
        }
    }
    asm volatile("s_waitcnt vmcnt(0) lgkmcnt(0)" ::: "memory");
    __builtin_amdgcn_s_barrier();
    asm volatile("" ::: "memory");
#undef ATT_ISSUE
#pragma unroll
    for (int u = 0; u < 2; ++u) {
        const float inv = 1.f / lrun[u];
        const size_t row = qrow0 + u * 16 + fr;
#pragma unroll
        for (int dt = 0; dt < 8; ++dt) {
            const int d0 = head * 128 + dt * 16 + 4 * fq;
            const u32x2 gw = gws[u][dt];
            const f32x4 ov = o[dt][u] * inv;
            *(u32x2*)(MIX + row * DM + 512 + d0) = pack4(ov[0] * bflo(gw.x), ov[1] * bfhi(gw.x), ov[2] * bflo(gw.y), ov[3] * bfhi(gw.y));
        }
    }
}

constexpr int GM_PART = 131072, GM_RQ = GM_PART + 32 * 128 * 4, LDS_TOTAL = GM_RQ + 512;
__device__ __forceinline__ void gmlp_task(const Params& P_unused, int layer, int chunk, LAS unsigned char* lds) {
    const Params P = load_params(); (void)P_unused;
    unsigned char* ws = ls(P.ws);
    const bf16_t* PROJ = (const bf16_t*)(ws + O_PROJ); const bf16_t* avT = (const bf16_t*)(ws + O_AVT) + (size_t)chunk * 512 * 128;
    bf16_t* MIX = (bf16_t*)(ws + O_HMIX);
    LAS float* part = (LAS float*)(lds + GM_PART);
    LAS float* rq = (LAS float*)(lds + GM_RQ);
    const int tid = lv(threadIdx.x), lane = tid & 63, w = __builtin_amdgcn_readfirstlane(tid >> 6), fr = lane & 15, fq = lane >> 4;
    __syncthreads();
    const int myc = (tid & 15) ^ ((tid >> 4) & 15);
    { const char* src = (const char*)avT + (size_t)(tid >> 4) * 256 + myc * 16;
#pragma unroll
      for (int i = 0; i < 16; ++i) __builtin_amdgcn_global_load_lds((const unsigned*)(src + (size_t)i * 32 * 256), (LAS unsigned*)(lds + i * 8192 + w * 1024), 16, 0, 0); }
    const int p = 16 * w + fr; const size_t row = (size_t)chunk * 128 + p;
    f32x4 wsn[8]; u32x2 uun[8], ggn[8];
#define GM_LOAD(h) do { const float* _wsr = P.w_sgu + (((size_t)layer * 4 + (h)) * 128 + p) * 128; \
        _Pragma("unroll") for (int c = 0; c < 4; ++c) { wsn[2 * c] = *(const f32x4*)(_wsr + c * 32 + 8 * fq); wsn[2 * c + 1] = *(const f32x4*)(_wsr + c * 32 + 8 * fq + 4); } \
        _Pragma("unroll") for (int dt = 0; dt < 8; ++dt) { const int _col = (h) * 128 + dt * 16 + 4 * fq; uun[dt] = *(const u32x2*)(PROJ + row * NCOL + C_AU + _col); ggn[dt] = *(const u32x2*)(PROJ + row * NCOL + C_AG + _col); } } while (0)
    GM_LOAD(0);
    asm volatile("s_waitcnt vmcnt(0)" ::: "memory");
    __builtin_amdgcn_s_barrier();
    asm volatile("" ::: "memory");
    { float s8[8] = {0, 0, 0, 0, 0, 0, 0, 0};
#pragma unroll
      for (int i = 0; i < 16; ++i) { const u32x4 v = *(const LAS u32x4*)(lds + i * 8192 + tid * 16);
          float f; f = bflo(v.x); s8[0] += f * f; f = bfhi(v.x); s8[1] += f * f; f = bflo(v.y); s8[2] += f * f; f = bfhi(v.y); s8[3] += f * f;
          f = bflo(v.z); s8[4] += f * f; f = bfhi(v.z); s8[5] += f * f; f = bflo(v.w); s8[6] += f * f; f = bfhi(v.w); s8[7] += f * f; }
#pragma unroll
      for (int e = 0; e < 8; ++e) part[(tid >> 4) * 128 + myc * 8 + e] = s8[e]; }
    __syncthreads();
    if (tid < 128) { float s = 0.f; for (int i = 0; i < 32; ++i) s += part[i * 128 + tid]; rq[tid] = rsqrtf(s * (1.f / 512.f) + EPS); }
    __syncthreads();
    for (int h = 0; h < 4; ++h) {
        f32x4 wsc[8]; u32x2 uu[8], gg[8];
#pragma unroll
        for (int i = 0; i < 8; ++i) { wsc[i] = wsn[i]; uu[i] = uun[i]; gg[i] = ggn[i]; }
        if (h < 3) GM_LOAD(h + 1);
        bf16x8 bfr[4];
#pragma unroll
        for (int c = 0; c < 4; ++c) { const int q0 = c * 32 + 8 * fq; const f32x4 w0 = wsc[2 * c], w1 = wsc[2 * c + 1];
            u32x4 pk; pk.x = cvt_pk_bf16(w0[0] * rq[q0], w0[1] * rq[q0 + 1]); pk.y = cvt_pk_bf16(w0[2] * rq[q0 + 2], w0[3] * rq[q0 + 3]);
            pk.z = cvt_pk_bf16(w1[0] * rq[q0 + 4], w1[1] * rq[q0 + 5]); pk.w = cvt_pk_bf16(w1[2] * rq[q0 + 6], w1[3] * rq[q0 + 7]); bfr[c] = __builtin_bit_cast(bf16x8, pk); }
        f32x4 acc[8];
#pragma unroll
        for (int dt = 0; dt < 8; ++dt) { acc[dt] = (f32x4){0, 0, 0, 0};
#pragma unroll
            for (int c = 0; c < 4; ++c) { const bf16x8 a = *(const LAS bf16x8*)(lds + (h * 128 + dt * 16 + fr) * 256 + (((c * 4 + fq) ^ fr) * 16));
                acc[dt] = __builtin_amdgcn_mfma_f32_16x16x32_bf16(a, bfr[c], acc[dt], 0, 0, 0); } }
        const float bs = P.b_sgu[((size_t)layer * 4 + h) * 128 + p];
#pragma unroll
        for (int dt = 0; dt < 8; ++dt) { const int col = h * 128 + dt * 16 + 4 * fq;
            const f32x4 g4 = *(const f32x4*)(P.g_sgu + (size_t)layer * 512 + col);
            const u32x2 u2 = uu[dt], g2 = gg[dt];
            const float y0 = bflo(u2.x) * (acc[dt][0] * g4[0] + bs) * bflo(g2.x), y1 = bfhi(u2.x) * (acc[dt][1] * g4[1] + bs) * bfhi(g2.x);
            const float y2 = bflo(u2.y) * (acc[dt][2] * g4[2] + bs) * bflo(g2.y), y3 = bfhi(u2.y) * (acc[dt][3] * g4[3] + bs) * bfhi(g2.y);
            *(u32x2*)(MIX + row * DM + col) = pack4(y0, y1, y2, y3); }
    }
#undef GM_LOAD
    __syncthreads();
}

__device__ __forceinline__ void stage2_phase(const Params& P_unused, int layer, int G) {
    const Params P = load_params(); (void)P_unused;
    unsigned char* ws = ls(P.ws);
    const bf16_t* Bint = (const bf16_t*)(ws + O_BINT); const bf16_t* F64 = (const bf16_t*)(ws + O_F64); const bf16_t* PROJ = (const bf16_t*)(ws + O_PROJ);
    bf16_t* MIX = (bf16_t*)(ws + O_HMIX);
    const int tid = lv(threadIdx.x);
    const int lane = tid & 63, w = __builtin_amdgcn_readfirstlane(tid >> 6), fr = lane & 15, fq = lane >> 4;
    bf16x8 ff[4][4];
#pragma unroll
    for (int nt = 0; nt < 4; ++nt)
#pragma unroll
        for (int c = 0; c < 4; ++c) ff[nt][c] = *(const bf16x8*)(F64 + (size_t)(nt * 16 + fr) * 128 + c * 32 + fq * 8);
    for (int task = blockIdx.x; task < 256; task += G) {
        const int b = task >> 7, k1 = task & 127;
        bf16x8 af[4][4]; u32x2 gg[4][4]; f32x4 bias[4];
#pragma unroll
        for (int mi = 0; mi < 4; ++mi) {
            const int j0 = (w * 4 + mi) * 16, jc = j0 + 4 * fq;
#pragma unroll
            for (int c = 0; c < 4; ++c) af[mi][c] = *(const bf16x8*)(Bint + (((size_t)(b * 128 + k1) * 512 + j0 + fr) * 128) + c * 32 + fq * 8);
            bias[mi] = *(const f32x4*)(P.b_f + (size_t)layer * 512 + jc);
#pragma unroll
            for (int nt = 0; nt < 4; ++nt) gg[mi][nt] = *(const u32x2*)(PROJ + ((size_t)b * SEQ + k1 + 128 * (nt * 16 + fr)) * NCOL + C_CG + jc);
        }
#pragma unroll
        for (int mi = 0; mi < 4; ++mi) {
            const int jc = (w * 4 + mi) * 16 + 4 * fq;
#pragma unroll
            for (int nt = 0; nt < 4; ++nt) {
                f32x4 acc = {0, 0, 0, 0};
#pragma unroll
                for (int c = 0; c < 4; ++c) acc = __builtin_amdgcn_mfma_f32_16x16x32_bf16(af[mi][c], ff[nt][c], acc, 0, 0, 0);
                const int k2 = nt * 16 + fr; const size_t row = (size_t)b * SEQ + k1 + 128 * k2;
                const u32x2 g2 = gg[mi][nt];
                *(u32x2*)(MIX + row * DM + 1536 + jc) = pack4((acc[0] + bias[mi][0]) * bflo(g2.x), (acc[1] + bias[mi][1]) * bfhi(g2.x), (acc[2] + bias[mi][2]) * bflo(g2.y), (acc[3] + bias[mi][3]) * bfhi(g2.y));
            }
        }
    }
}

__device__ __forceinline__ void ctx_outproj_tile(const Params& P_unused, int layer, int tile, LAS unsigned char* lds) {
    const Params P = load_params(); (void)P_unused;
    unsigned char* ws = ls(P.ws);
    const bf16_t* A = (const bf16_t*)(ws + O_HMIX) + (size_t)MLAT * DM;
    const bf16_t* Bt = (const bf16_t*)(ws + O_WOUTT) + (size_t)layer * DM * DM;
    bf16_t* Yc = (bf16_t*)(ws + O_YC);
    const int tid = lv(threadIdx.x);
    const int lane = tid & 63, w = __builtin_amdgcn_readfirstlane(tid >> 6), fr = lane & 15, fq = lane >> 4;
    const int m0 = (tile >> 5) * 64, n0 = (tile & 31) * 64;
    f32x4 acc[4][4];
#pragma unroll
    for (int i = 0; i < 4; ++i)
#pragma unroll
        for (int j = 0; j < 4; ++j) acc[i][j] = (f32x4){0, 0, 0, 0};
    const bf16_t* ap = A + (size_t)(m0 + fr) * DM + w * 256 + fq * 8;
    const bf16_t* bp = Bt + (size_t)(n0 + fr) * DM + w * 256 + fq * 8;
#pragma unroll 4
    for (int ks = 0; ks < 8; ++ks) {
        bf16x8 af[4], bv[4];
#pragma unroll
        for (int i = 0; i < 4; ++i) { af[i] = *(const bf16x8*)(ap + (size_t)i * 16 * DM + ks * 32); bv[i] = *(const bf16x8*)(bp + (size_t)i * 16 * DM + ks * 32); }
#pragma unroll
        for (int i = 0; i < 4; ++i)
#pragma unroll
            for (int j = 0; j < 4; ++j) acc[i][j] = __builtin_amdgcn_mfma_f32_16x16x32_bf16(af[i], bv[j], acc[i][j], 0, 0, 0);
    }
    __syncthreads();
    LAS float* red = (LAS float*)lds + w * 4096;
#pragma unroll
    for (int i = 0; i < 4; ++i)
#pragma unroll
        for (int j = 0; j < 4; ++j)
#pragma unroll
            for (int r = 0; r < 4; ++r) red[(i * 16 + 4 * fq + r) * 64 + j * 16 + fr] = acc[i][j][r];
    __syncthreads();
    { const int e0 = tid * 8, row = e0 >> 6, col = e0 & 63;
      f32x4 s0 = {0, 0, 0, 0}, s1 = {0, 0, 0, 0};
#pragma unroll
      for (int wv = 0; wv < 8; ++wv) { const LAS f32x4* p = (const LAS f32x4*)((LAS float*)lds + wv * 4096 + e0); s0 += p[0]; s1 += p[1]; }
      u32x4 o; o.x = cvt_pk_bf16(s0[0], s0[1]); o.y = cvt_pk_bf16(s0[2], s0[3]); o.z = cvt_pk_bf16(s1[0], s1[1]); o.w = cvt_pk_bf16(s1[2], s1[3]);
      *(u32x4*)(Yc + (size_t)(m0 + row) * DM + n0 + col) = o; }
    __syncthreads();
}

#define XB_TMO      128
#define XB_XCNT(j)  (256  + 64 * (j))
#define XB_XSUB(j)  (1280 + 64 * (j))
#define XB_XGEN(j)  (2304 + 64 * (j))
#define XB_TOP      3328
#define XB_TOPGEN   3392
#define XCD_BAR_WORDS 3456
#define XB_SPIN_CAP (1u << 18)
__device__ __forceinline__ unsigned xb_ld(unsigned* p)              { return __hip_atomic_load(p, __ATOMIC_RELAXED, __HIP_MEMORY_SCOPE_AGENT); }
__device__ __forceinline__ unsigned xb_add(unsigned* p, unsigned v) { return __hip_atomic_fetch_add(p, v, __ATOMIC_RELAXED, __HIP_MEMORY_SCOPE_AGENT); }
__device__ __forceinline__ unsigned xb_xcc_id() { return (unsigned)__builtin_amdgcn_s_getreg((3 << 11) | 20) & 0xFu; }
#define XB_SPIN(cond, bar) do { unsigned _sp = 0; while (cond) { __builtin_amdgcn_s_sleep(1); \
    if ((++_sp & 255u) == 0u) { if (xb_ld(&(bar)[XB_TMO])) break; if (_sp > XB_SPIN_CAP) { atomicAdd(&(bar)[XB_TMO], 1u); break; } } } } while (0)
struct XcdBarrier { unsigned* bar; unsigned x; volatile LAS unsigned* st; };
__device__ __forceinline__ XcdBarrier xcd_barrier_post(unsigned* bar, volatile LAS unsigned* st) {
    XcdBarrier b; b.bar = bar; b.x = xb_xcc_id(); b.st = st;
    if (threadIdx.x == 0) (void)xb_add(&bar[XB_XCNT(b.x)], 1u);
    return b;
}
__device__ __forceinline__ void xcd_barrier_complete(unsigned* bar, unsigned x, unsigned& nloc, unsigned& nx) {
    const unsigned G = gridDim.x * gridDim.y * gridDim.z;
    unsigned sum, cnt, mine, sp = 0u;
    for (;;) {
        sum = 0u; cnt = 0u; mine = 0u;
#pragma unroll
        for (unsigned j = 0; j < 16; ++j) { const unsigned c = xb_ld(&bar[XB_XCNT(j)]); sum += c; cnt += (c > 0u) ? 1u : 0u; mine = (j == x) ? c : mine; }
        if (sum == G) break;
        __builtin_amdgcn_s_sleep(1);
        if ((++sp & 255u) == 0u) { if (xb_ld(&bar[XB_TMO])) break; if (sp > XB_SPIN_CAP) { atomicAdd(&bar[XB_TMO], 1u); break; } }
    }
    nloc = mine > 0u ? mine : 1u; nx = cnt > 0u ? cnt : 1u;
}
__device__ __forceinline__ void xcd_barrier(const XcdBarrier& b) {
    asm volatile("s_waitcnt vmcnt(0)" ::: "memory");
    __syncthreads();
    if (threadIdx.x == 0) {
        unsigned* bar = b.bar;
        __builtin_amdgcn_s_waitcnt(0);
        unsigned nloc = b.st[0], nx = b.st[1];
        if (nloc == 0u) { xcd_barrier_complete(bar, b.x, nloc, nx); b.st[0] = nloc; b.st[1] = nx; }
        const unsigned old = xb_add(&bar[XB_XSUB(b.x)], 1u);
        const unsigned gen = old / nloc;
        if (old + 1u == (gen + 1u) * nloc) {
            __builtin_amdgcn_fence(__ATOMIC_RELEASE, "agent");
            asm volatile("s_waitcnt vmcnt(0)" ::: "memory");
            const unsigned og = xb_add(&bar[XB_TOP], 1u);
            const unsigned tg = og / nx;
            if (og + 1u == (tg + 1u) * nx) xb_add(&bar[XB_TOPGEN], 1u);
            else XB_SPIN(xb_ld(&bar[XB_TOPGEN]) == tg, bar);
            __builtin_amdgcn_fence(__ATOMIC_ACQUIRE, "agent");
            xb_add(&bar[XB_XGEN(b.x)], 1u);
            asm volatile("s_waitcnt vmcnt(0)" ::: "memory");
        } else {
            XB_SPIN(xb_ld(&bar[XB_XGEN(b.x)]) == gen, bar);
            __builtin_amdgcn_fence(__ATOMIC_ACQUIRE, "agent");
            asm volatile("s_waitcnt vmcnt(0)" ::: "memory");
        }
    }
    __syncthreads();
}

__global__ void __launch_bounds__(512) fwd_megakernel(Params P_arg) {
    const Params& P = P_arg;
    extern __shared__ __attribute__((aligned(16))) unsigned char shm[];
    LAS unsigned char* lds = (LAS unsigned char*)shm;
    cg::grid_group grid = cg::this_grid();
    const int G = gridDim.x, bid = blockIdx.x;
    __shared__ uint4 xb_words;
    if (threadIdx.x == 0) xb_words = make_uint4(0u, 0u, 0u, 0u);
    __syncthreads();
    const XcdBarrier xb = xcd_barrier_post((unsigned*)(P.ws + O_BAR), (volatile LAS unsigned*)&xb_words);
#define WSP() const Params P = load_params(); unsigned char* ws = ls(P.ws); bf16_t* WinT = (bf16_t*)(ws + O_WINT); bf16_t* WoutT = (bf16_t*)(ws + O_WOUTT); bf16_t* HMIX = (bf16_t*)(ws + O_HMIX); bf16_t* PROJ = (bf16_t*)(ws + O_PROJ); (void)WinT; (void)WoutT; (void)HMIX; (void)PROJ

    phase0a(P, lds, G);
    grid.sync();
    {
        WSP();
        SchedFold S; S.G = G; S.c = bid;
        EpiFold E; E.WinT = WinT;
        Gemm g; g.A = (const bf16_t*)(ws + O_MTF); g.Bt = (const bf16_t*)(ws + O_WCX); g.K = 512;
        pg8::gemm_phase(lds, g, S, E);
        const float* modp = (const float*)(ws + O_MODP); float* mod = (float*)(ws + O_MOD);
        for (int e = bid * 512 + threadIdx.x; e < DEPTH * 3 * 1536; e += G * 512) {
            const int n4 = (e % 1536) * 4, lr = e / 1536, l = lr / 3, r = lr % 3;
            f32x4 a = *(const f32x4*)(P.b_mod + (size_t)l * 6144 + n4);
            for (int s = 0; s < 32; ++s) a += *(const f32x4*)(modp + ((size_t)(l * 32 + s) * 3 + r) * 6144 + n4);
            *(f32x4*)(mod + (size_t)lr * 6144 + n4) = a;
        }
    }
    xcd_barrier(xb);
#pragma unroll 1
    for (int layer = 0; layer < DEPTH; ++layer) {
        const bool lastl = layer == DEPTH - 1;
        row_phase(P, layer, G);
        xcd_barrier(xb);
        {
            WSP();
            SchedIn S; S.init(66, 22, G, bid);
            EpiIn E; E.PROJ = PROJ; E.avT = (bf16_t*)(ws + O_AVT); E.VT = (bf16_t*)(ws + O_VT); E.VTc = (bf16_t*)(ws + O_VTC); E.ZT = (bf16_t*)(ws + O_ZT); E.ZTc = (bf16_t*)(ws + O_ZTC); E.rope = (const float2*)(ws + O_ROPE);
            Gemm g; g.A = HMIX; g.Bt = WinT + (size_t)layer * NCOL * DM; g.K = DM;
            pg8::gemm_phase(lds, g, S, E);
        }
        xcd_barrier(xb);
        {
            WSP();
            for (int task = bid; task < 512; task += G) attn_task(P, layer, task, lds);
            {   SchedFew S; S.n = 256; S.G = G; S.c = bid;
                EpiS1 E; E.Bint = (bf16_t*)(ws + O_BINT);
                Gemm g; g.A = (const bf16_t*)(ws + O_F128); g.Bt = (const bf16_t*)(ws + O_ZT); g.K = 256;
                pg8::gemm_phase(lds, g, S, E); }
            const int nch = lastl ? 128 : 132;
            for (int ch = bid; ch < nch; ch += G) gmlp_task(P, layer, ch, lds);
            if (!lastl) {
                const int c2 = (bid - 132 + G) % G;
                for (int t = c2; t < 16; t += G) attn_task(P, layer, 512 + t, lds);
                __syncthreads();
                SchedFew S; S.n = 4; S.G = G; S.c = (bid - 148 + G) % G;
                EpiCtxF E; E.MIX = HMIX; E.PROJ = PROJ; E.bf = P.b_f + (size_t)layer * 512;
                Gemm g; g.A = (const bf16_t*)(ws + O_DCTX); g.Bt = (const bf16_t*)(ws + O_ZTC); g.K = 512;
                pg8::gemm_phase(lds, g, S, E);
            }
        }
        xcd_barrier(xb);
        stage2_phase(P, layer, G);
        if (!lastl) for (int tile = bid; tile < 256; tile += G) ctx_outproj_tile(P, layer, tile, lds);
        xcd_barrier(xb);
        {
            WSP();
            pg8::StaticOrder S; S.init(64, 8, G, bid);
            EpiOut E; E.Y = PROJ;
            Gemm g; g.A = HMIX; g.Bt = WoutT + (size_t)layer * DM * DM; g.K = DM;
            pg8::gemm_phase(lds, g, S, E);
        }
        xcd_barrier(xb);
    }
    row_phase(P, DEPTH, G);
}

extern "C" void kernel_launch(void* const* d_in, const int* in_sizes, int n_in, void* d_out, int out_size, void* d_ws, size_t ws_size, hipStream_t stream) {
    constexpr size_t kDynLds = LDS_TOTAL;
    static int grid_blocks = 0;
    if (!grid_blocks) {
        if (ws_size < WS_END) { fprintf(stderr, "kernel_launch: workspace too small: %zu < %zu\n", ws_size, (size_t)WS_END); grid_blocks = -1; return; }
        int dev = 0, cus = 0, per_cu = 0;
        hipGetDevice(&dev);
        hipDeviceGetAttribute(&cus, hipDeviceAttributeMultiprocessorCount, dev);
        hipFuncSetAttribute((const void*)fwd_megakernel, hipFuncAttributeMaxDynamicSharedMemorySize, (int)kDynLds);
        hipOccupancyMaxActiveBlocksPerMultiprocessor(&per_cu, (const void*)fwd_megakernel, 512, kDynLds);
        if (per_cu < 1) { fprintf(stderr, "kernel_launch: occupancy query says %d blocks/CU\n", per_cu); per_cu = 1; }
        grid_blocks = cus * 1;
    }
    if (grid_blocks < 0) return;
    Params p{};
    p.x = (const float*)d_in[0]; p.c = (const float*)d_in[1]; p.ctx = (const float*)d_in[2]; p.c_ctx = (const float*)d_in[3];
    p.w_mod = (const float*)d_in[4]; p.b_mod = (const float*)d_in[5]; p.g_pre = (const float*)d_in[6]; p.g_post = (const float*)d_in[7];
    p.w_in = (const float*)d_in[8]; p.w_out = (const float*)d_in[9]; p.g_sgu = (const float*)d_in[10]; p.w_sgu = (const float*)d_in[11];
    p.b_sgu = (const float*)d_in[12]; p.sink = (const float*)d_in[13]; p.w_f = (const float*)d_in[14]; p.b_f = (const float*)d_in[15];
    p.out = (float*)d_out; p.ws = (unsigned char*)d_ws;
    (void)hipMemsetAsync((unsigned char*)d_ws + O_BAR, 0, XCD_BAR_WORDS * 4, stream);
    void* args[] = {&p};
    hipError_t e = hipLaunchCooperativeKernel((const void*)fwd_megakernel, dim3(grid_blocks), dim3(512), args, kDynLds, stream);
    if (e != hipSuccess) fprintf(stderr, "cooperative launch failed: %s (grid %d)\n", hipGetErrorString(e), grid_blocks);
}
```

```cpp
#include <hip/hip_runtime.h>
#include <hip/hip_cooperative_groups.h>
#include <cstdio>
#include <cstdint>
namespace cg = cooperative_groups;

#define LAS __attribute__((address_space(3)))
typedef unsigned short bf16_t;
typedef short bf16x8 __attribute__((ext_vector_type(8)));
typedef short bf16x4 __attribute__((ext_vector_type(4)));
typedef float f32x4 __attribute__((ext_vector_type(4)));
typedef unsigned u32x2 __attribute__((ext_vector_type(2)));
typedef unsigned u32x4 __attribute__((ext_vector_type(4)));

constexpr int DM = 2048, SEQ = 8192, NB = 2, DEPTH = 4, CTXL = 256;
constexpr int MLAT = NB * SEQ;
constexpr int MROWS = MLAT + NB * CTXL;
constexpr int NCOL = 5632;
constexpr int C_AU = 0, C_AV = 512, C_AG = 1024, C_Q = 1536, C_K = 2560, C_V = 2816, C_BG = 3072, C_ZR = 4096, C_CG = 5120;
constexpr float EPS = 1e-6f;
constexpr float QSCALE = 0.08838834764831845f * 1.4426950408889634f;
constexpr float LOG2E = 1.4426950408889634f;

constexpr size_t AL(size_t x) { return (x + 255) & ~(size_t)255; }
constexpr size_t O_WINT = 0;
constexpr size_t O_WOUTT = O_WINT + AL((size_t)DEPTH * NCOL * DM * 2);
constexpr size_t O_MOD = O_WOUTT + AL((size_t)DEPTH * DM * DM * 2);
constexpr size_t O_ROPE = O_MOD + AL((size_t)DEPTH * 3 * 6144 * 4);
constexpr size_t O_TWID = O_ROPE + AL((size_t)128 * 32 * 8);
constexpr size_t O_F128 = O_TWID + AL((size_t)8192 * 8);
constexpr size_t O_F64 = O_F128 + AL((size_t)256 * 256 * 2);
constexpr size_t O_DCTX = O_F64 + AL((size_t)64 * 128 * 2);
constexpr size_t O_XC = O_DCTX + AL((size_t)256 * 512 * 2);
constexpr size_t O_HMIX = O_XC + AL((size_t)512 * DM * 4);
constexpr size_t O_PROJ = O_HMIX + AL((size_t)MROWS * DM * 2);
constexpr size_t O_AVT = O_PROJ + AL((size_t)MROWS * NCOL * 2);
constexpr size_t O_VT = O_AVT + AL((size_t)132 * 512 * 128 * 2);
constexpr size_t O_VTC = O_VT + AL((size_t)NB * 2 * 128 * SEQ * 2);
constexpr size_t O_ZT = O_VTC + AL((size_t)NB * 2 * 128 * CTXL * 2);
constexpr size_t O_ZTC = O_ZT + AL((size_t)NB * 512 * 64 * 256 * 2);
constexpr size_t O_BINT = O_ZTC + AL((size_t)NB * 512 * 512 * 2);
constexpr size_t O_YC = O_BINT + AL((size_t)NB * 128 * 512 * 128 * 2);
constexpr size_t O_BAR = O_YC + AL((size_t)512 * DM * 2);
constexpr size_t O_WCX = O_BAR + 16384;
constexpr size_t O_MTF = O_WCX + AL((size_t)DEPTH * DM * 512 * 2);
constexpr size_t O_MODP = O_MTF + AL((size_t)DEPTH * 1024 * 512 * 2);
constexpr size_t O_P0END = O_MODP + AL((size_t)DEPTH * 32 * 3 * 6144 * 4);
constexpr size_t O_XB = O_WCX;
constexpr size_t WS_END = (O_XB + (size_t)MLAT * DM * 2 > O_P0END) ? O_XB + (size_t)MLAT * DM * 2 : O_P0END;

struct Params {
    const float *x, *c, *ctx, *c_ctx, *w_mod, *b_mod, *g_pre, *g_post, *w_in, *w_out, *g_sgu, *w_sgu, *b_sgu, *sink, *w_f, *b_f;
    float* out;
    unsigned char* ws;
};

__device__ __forceinline__ Params load_params() {
#if defined(__HIP_DEVICE_COMPILE__)
    auto p = __builtin_amdgcn_kernarg_segment_ptr(); asm volatile("" : "+s"(p));
    return *(const __attribute__((address_space(4))) Params*)p;
#else
    return Params{};
#endif
}
__device__ __forceinline__ int lv(int x) { asm volatile("" : "+v"(x)); return x; }
template <class T> __device__ __forceinline__ T* ls(T* p) { asm volatile("" : "+s"(p)); return p; }
__device__ __forceinline__ unsigned cvt_pk_bf16(float lo, float hi) { unsigned r; asm volatile("v_cvt_pk_bf16_f32 %0, %1, %2" : "=v"(r) : "v"(lo), "v"(hi)); return r; }
__device__ __forceinline__ bf16_t f2bf(float v) { return (bf16_t)(cvt_pk_bf16(v, 0.f) & 0xffffu); }
__device__ __forceinline__ float bf2f(unsigned b) { return __uint_as_float(b << 16); }
__device__ __forceinline__ float bflo(unsigned w) { return __uint_as_float(w << 16); }
__device__ __forceinline__ float bfhi(unsigned w) { return __uint_as_float(w & 0xffff0000u); }
__device__ __forceinline__ float gelu_t(float x) { const float u2 = x * (x * x * (-2.f * 0.7978845608028654f * 0.044715f * 1.4426950408889634f) + (-2.f * 0.7978845608028654f * 1.4426950408889634f)); return x * __builtin_amdgcn_rcpf(1.f + __builtin_amdgcn_exp2f(u2)); }
__device__ __forceinline__ float silu_f(float x) { return x * __builtin_amdgcn_rcpf(1.f + __builtin_amdgcn_exp2f(x * -1.4426950408889634f)); }
__device__ __forceinline__ float wave_sum(float v) {
#pragma unroll
    for (int o = 1; o < 64; o <<= 1) v += __shfl_xor(v, o);
    return v;
}
__device__ __forceinline__ float xor16_max(float x) { auto r = __builtin_amdgcn_permlane16_swap(__float_as_uint(x), __float_as_uint(x), false, false); return fmaxf(__uint_as_float(r[0]), __uint_as_float(r[1])); }
__device__ __forceinline__ float xor32_max(float x) { auto r = __builtin_amdgcn_permlane32_swap(__float_as_uint(x), __float_as_uint(x), false, false); return fmaxf(__uint_as_float(r[0]), __uint_as_float(r[1])); }
__device__ __forceinline__ float xor16_sum(float x) { auto r = __builtin_amdgcn_permlane16_swap(__float_as_uint(x), __float_as_uint(x), false, false); return __uint_as_float(r[0]) + __uint_as_float(r[1]); }
__device__ __forceinline__ float xor32_sum(float x) { auto r = __builtin_amdgcn_permlane32_swap(__float_as_uint(x), __float_as_uint(x), false, false); return __uint_as_float(r[0]) + __uint_as_float(r[1]); }
__device__ __forceinline__ u32x2 pack4(float a, float b, float c, float d) { u32x2 r; r.x = cvt_pk_bf16(a, b); r.y = cvt_pk_bf16(c, d); return r; }

namespace pg8 {
constexpr int BM = 256, BK = 64, HALF = 128, HTB = HALF * BK * 2, STAGE_BYTES = 8 * HTB, NXCD = 8, WGM = 8;
__host__ __device__ __forceinline__ int lds_byte(int r, int c) { const int st = (r >> 4) * 2 + (c >> 5), rr = r & 15, cc = c & 31, ob = rr * 64 + cc * 2; return st * 1024 + (ob ^ (((ob >> 9) & 1) << 5)); }
__host__ __device__ __forceinline__ void stage_rc(int b, int& R, int& C) { const int st = b / 1024, sb = b % 1024, swz = sb ^ (((sb >> 9) & 1) << 5); R = (st >> 1) * 16 + swz / 64; C = (st & 1) * 32 + (swz % 64) / 2; }
__host__ __device__ __forceinline__ int perm32(int rho) { const int n = rho >> 4, i = rho & 15; return 8 * (i >> 2) + 4 * n + (i & 3); }
struct Unit { int pm, pn; };
struct Gemm { const bf16_t* A; const bf16_t* Bt; int K; };

struct SchedBase {
    __device__ __forceinline__ void amap(const Unit& u, const Gemm& g, const char*& base, unsigned& rs, unsigned& hs) const {
        rs = (unsigned)g.K * 2u; hs = (unsigned)HALF * g.K * 2u; base = (const char*)g.A + (size_t)u.pm * BM * g.K * 2;
    }
    __device__ __forceinline__ void bmap(const Unit& u, const Gemm& g, const char*& base, unsigned& rs, unsigned& hs) const {
        rs = (unsigned)g.K * 2u; hs = (unsigned)HALF * g.K * 2u; base = (const char*)g.Bt + (size_t)u.pn * BM * g.K * 2;
    }
};
struct StaticOrder : SchedBase {
    int nM, nN, nwg, G, c;
    __device__ void init(int nM_, int nN_, int G_, int c_) { nM = nM_; nN = nN_; nwg = nM * nN; G = G_; c = c_; }
    __device__ bool next(int i, Unit& u) const {
        const long L = (long)i * G + c; if (L >= nwg) return false;
        int wgid = (int)L; { const int q = nwg / NXCD, r = nwg % NXCD, xcd = wgid % NXCD, off = wgid / NXCD; wgid = (xcd < r ? xcd * (q + 1) : r * (q + 1) + (xcd - r) * q) + off; }
        const int nig = WGM * nN, gid = wgid / nig, fm = gid * WGM, gsz = (nM - fm) < WGM ? (nM - fm) : WGM;
        u.pm = fm + ((wgid % nig) % gsz); u.pn = (wgid % nig) / gsz; return true;
    }
};

template <class Epi, class Sched>
__device__ __forceinline__ void gemm_phase(LAS unsigned char* lds, const Gemm g, const Sched& S, const Epi& E) {
    const int tid = lv(threadIdx.x), wid = __builtin_amdgcn_readfirstlane(tid >> 6), lane = tid & 63, wr = wid >> 2, wc = wid & 3, fr = lane & 15, fq = lane >> 4;
    int K = g.K; asm volatile("" : "+s"(K));
    const int nt = K / BK;
#define PG8_VOFFB(dst, rs) do { const int _t = lv(tid); _Pragma("unroll") for (int _i = 0; _i < 2; ++_i) { int _R, _C; stage_rc(_t * 16 + _i * 8192, _R, _C); const int _Rb = (_R & ~31) + perm32(_R & 31); dst[_i] = (unsigned)_Rb * (rs) + (unsigned)_C * 2u; } } while (0)
#define PG8_VOFFA(dst, rs) do { const int _t = lv(tid); _Pragma("unroll") for (int _i = 0; _i < 2; ++_i) { int _R, _C; stage_rc(_t * 16 + _i * 8192, _R, _C); dst[_i] = (unsigned)_R * (rs) + (unsigned)_C * 2u; } } while (0)
    const size_t kstep = (size_t)(BK * 2);
    const unsigned ldsw = (unsigned)wid * 1024u;
    const int aoff = lds_byte(wr * 64 + fr, fq * 8), boff = lds_byte(wc * 32 + fr, fq * 8);
#define PG8_SA(b, h) (((b) * 2 + (h)) * HTB)
#define PG8_SB(b, h) ((4 + (b) * 2 + (h)) * HTB)
#define PG8_STAGE(bufoff, gbase, voff) do { _Pragma("unroll") for (int _i = 0; _i < 2; ++_i) \
        __builtin_amdgcn_global_load_lds((const unsigned*)((const char*)(gbase) + (voff)[_i]), (LAS unsigned*)(lds + (bufoff) + ldsw + _i * 8192), 16, 0, 0); } while (0)
#define PG8_LDA(dst, b, h) do { _Pragma("unroll") for (int m = 0; m < 4; ++m) _Pragma("unroll") for (int k = 0; k < 2; ++k) dst[m][k] = *(const LAS bf16x8*)(lds + PG8_SA(b, h) + aoff + m * 2048 + k * 1024); } while (0)
#define PG8_LDB(dst, b, h) do { _Pragma("unroll") for (int n = 0; n < 2; ++n) _Pragma("unroll") for (int k = 0; k < 2; ++k) dst[n][k] = *(const LAS bf16x8*)(lds + PG8_SB(b, h) + boff + n * 2048 + k * 1024); } while (0)
#define PG8_MMA(ai, bj, At, Bt) do { __builtin_amdgcn_s_setprio(1); _Pragma("unroll") for (int m = 0; m < 4; ++m) _Pragma("unroll") for (int n = 0; n < 2; ++n) _Pragma("unroll") for (int k = 0; k < 2; ++k) \
        acc[ai][bj][m][n] = __builtin_amdgcn_mfma_f32_16x16x32_bf16(Bt[n][k], At[m][k], acc[ai][bj][m][n], 0, 0, 0); __builtin_amdgcn_s_setprio(0); } while (0)
#define PG8_WAIT_V(n) asm volatile("s_waitcnt vmcnt(" #n ")" ::: "memory")
#define PG8_WAIT_L(n) asm volatile("s_waitcnt lgkmcnt(" #n ")" ::: "memory")
#define PG8_BAR __builtin_amdgcn_s_barrier()
#define PG8_SCHED __builtin_amdgcn_sched_barrier(0)
    Unit cur, nxt; int ui = 0;
    if (!S.next(0, cur)) return;
    f32x4 acc[2][2][4][2];
#pragma unroll
    for (int a = 0; a < 2; ++a)
#pragma unroll
        for (int b = 0; b < 2; ++b)
#pragma unroll
            for (int m = 0; m < 4; ++m)
#pragma unroll
                for (int n = 0; n < 2; ++n) acc[a][b][m][n] = (f32x4){0.f, 0.f, 0.f, 0.f};
    bf16x8 At[4][2], B0[2][2], B1[2][2];
    const char* cA; unsigned cRS, cHS; S.amap(cur, g, cA, cRS, cHS);
    unsigned vAc[2]; PG8_VOFFA(vAc, cRS);
    const char* cB; unsigned cRSB, cHSB; S.bmap(cur, g, cB, cRSB, cHSB);
    unsigned vBc[2]; PG8_VOFFB(vBc, cRSB);
    PG8_STAGE(PG8_SB(0, 0), cB, vBc); PG8_STAGE(PG8_SA(0, 0), cA, vAc); PG8_STAGE(PG8_SB(0, 1), cB + cHSB, vBc); PG8_STAGE(PG8_SA(0, 1), cA + cHS, vAc);
    if (wr == 1) PG8_BAR;
    PG8_WAIT_V(4); PG8_BAR;
    PG8_STAGE(PG8_SB(1, 0), cB + kstep, vBc); PG8_STAGE(PG8_SA(1, 0), cA + kstep, vAc); PG8_STAGE(PG8_SB(1, 1), cB + cHSB + kstep, vBc);
    PG8_WAIT_V(6); PG8_BAR;
    for (;;) {
        const bool has_next = S.next(ui + 1, nxt);
        const char* nA = cA; unsigned nRS = cRS, nHS = cHS; const char* nB = cB; unsigned nRSB = cRSB, nHSB = cHSB;
        if (has_next) { S.amap(nxt, g, nA, nRS, nHS); S.bmap(nxt, g, nB, nRSB, nHSB); }
        for (int t = 0; t < nt; t += 2) {
            const bool last = (t == nt - 2);
            const char* a1 = cA + (size_t)(t + 1) * kstep;
            const char* a2 = last ? nA : cA + (size_t)(t + 2) * kstep; const char* b2 = last ? nB : cB + (size_t)(t + 2) * kstep;
            const char* a3 = a2 + kstep; const char* b3 = b2 + kstep;
            const unsigned hs2 = last ? nHS : cHS;
            unsigned v2[2] = {vAc[0], vAc[1]}; if (last) PG8_VOFFA(v2, nRS);
            const unsigned hsB2 = last ? nHSB : cHSB;
            unsigned vB2[2] = {vBc[0], vBc[1]}; if (last) PG8_VOFFB(vB2, nRSB);
            PG8_LDB(B0, 0, 0); PG8_SCHED; PG8_LDA(At, 0, 0); PG8_STAGE(PG8_SA(1, 1), a1 + cHS, vAc);
            PG8_WAIT_L(8); PG8_BAR; PG8_WAIT_L(0); PG8_MMA(0, 0, At, B0); PG8_BAR; PG8_SCHED;
            PG8_LDB(B1, 0, 1); PG8_STAGE(PG8_SB(0, 0), b2, vB2);
            PG8_BAR; PG8_WAIT_L(0); PG8_MMA(0, 1, At, B1); PG8_BAR;
            PG8_LDA(At, 0, 1); PG8_STAGE(PG8_SA(0, 0), a2, v2);
            PG8_BAR; PG8_WAIT_L(0); PG8_MMA(1, 0, At, B0); PG8_BAR; PG8_SCHED;
            PG8_STAGE(PG8_SB(0, 1), b2 + hsB2, vB2);
            PG8_WAIT_V(6); PG8_BAR; PG8_MMA(1, 1, At, B1); PG8_BAR;
            PG8_LDB(B0, 1, 0); PG8_SCHED; PG8_LDA(At, 1, 0); PG8_STAGE(PG8_SA(0, 1), a2 + hs2, v2);
            PG8_WAIT_L(8); PG8_BAR; PG8_WAIT_L(0); PG8_MMA(0, 0, At, B0); PG8_BAR; PG8_SCHED;
            PG8_LDB(B1, 1, 1); PG8_STAGE(PG8_SB(1, 0), b3, vB2);
            PG8_BAR; PG8_WAIT_L(0); PG8_MMA(0, 1, At, B1); PG8_BAR;
            PG8_LDA(At, 1, 1); PG8_STAGE(PG8_SA(1, 0), a3, v2);
            PG8_BAR; PG8_WAIT_L(0); PG8_MMA(1, 0, At, B0); PG8_BAR; PG8_SCHED;
            PG8_STAGE(PG8_SB(1, 1), b3 + hsB2, vB2);
            PG8_WAIT_V(6); PG8_BAR; PG8_MMA(1, 1, At, B1); PG8_BAR;
        }
        { const int l2 = lv(threadIdx.x) & 63; E(acc, cur, wr, wc, l2 & 15, l2 >> 4); }
        if (!has_next) break;
#pragma unroll
        for (int a = 0; a < 2; ++a)
#pragma unroll
            for (int b = 0; b < 2; ++b)
#pragma unroll
                for (int m = 0; m < 4; ++m)
#pragma unroll
                    for (int n = 0; n < 2; ++n) acc[a][b][m][n] = (f32x4){0.f, 0.f, 0.f, 0.f};
        cur = nxt; cA = nA; cRS = nRS; cHS = nHS; PG8_VOFFA(vAc, cRS); cB = nB; cRSB = nRSB; cHSB = nHSB; PG8_VOFFB(vBc, cRSB); ++ui;
    }
    PG8_WAIT_V(0);
    if (wr == 0) PG8_BAR;
    PG8_BAR;
#undef PG8_VOFFA
#undef PG8_VOFFB
#undef PG8_SA
#undef PG8_SB
#undef PG8_STAGE
#undef PG8_LDA
#undef PG8_LDB
#undef PG8_MMA
#undef PG8_WAIT_V
#undef PG8_WAIT_L
#undef PG8_BAR
#undef PG8_SCHED
}
}
using pg8::Unit;
using pg8::Gemm;

__device__ __forceinline__ bool in_swapped(int pn) { return pn == 2 || pn == 3 || pn == 11 || (pn >= 16 && pn < 20); }
struct SchedIn : pg8::StaticOrder {
    __device__ __forceinline__ void tokmap(const Unit& u, bool gather, const Gemm& g, const char*& base, unsigned& rs, unsigned& hs) const {
        if (gather && u.pm < 64) { const int b = u.pm >> 5, t20 = 2 * (u.pm & 31); rs = 64u * DM * 2u; hs = DM * 2u; base = (const char*)g.A + ((size_t)b * SEQ + t20) * DM * 2; }
        else { rs = DM * 2u; hs = 128u * DM * 2u; base = (const char*)g.A + (size_t)u.pm * 256 * DM * 2; }
    }
    __device__ __forceinline__ void wmap(const Unit& u, const Gemm& g, const char*& base, unsigned& rs, unsigned& hs) const {
        rs = DM * 2u; hs = 128u * DM * 2u; base = (const char*)g.Bt + (size_t)u.pn * 256 * DM * 2;
    }
    __device__ __forceinline__ void amap(const Unit& u, const Gemm& g, const char*& base, unsigned& rs, unsigned& hs) const {
        if (in_swapped(u.pn)) wmap(u, g, base, rs, hs); else tokmap(u, false, g, base, rs, hs);
    }
    __device__ __forceinline__ void bmap(const Unit& u, const Gemm& g, const char*& base, unsigned& rs, unsigned& hs) const {
        if (in_swapped(u.pn)) tokmap(u, u.pn >= 16, g, base, rs, hs); else wmap(u, g, base, rs, hs);
    }
};
struct SchedFold : pg8::SchedBase {
    int G, c;
    __device__ bool next(int i, Unit& u) const { const int L = i * G + c; if (L >= 128) return false; const int l = L >> 5, r = L & 31; u.pm = l * 4 + (r >> 3); u.pn = l * 8 + (r & 7); return true; }
};
struct SchedFew : pg8::SchedBase {
    int n, G, c;
    __device__ bool next(int i, Unit& u) const { const int L = i * G + c; if (c < 0 || L >= n) return false; u.pm = 0; u.pn = L; return true; }
};

struct EpiIn {
    bf16_t *PROJ, *avT, *VT, *VTc, *ZT, *ZTc; const float2* rope;
    __device__ __forceinline__ void operator()(const f32x4 (&acc)[2][2][4][2], const Unit& u, int wr, int wc, int fr, int fq) const {
        if (in_swapped(u.pn)) {
#pragma unroll
            for (int ai = 0; ai < 2; ++ai) {
                const int nt = 2 * u.pn + ai;
#pragma unroll
                for (int m = 0; m < 4; ++m) {
                    const int ch = wr * 64 + m * 16 + lv(fr);
#pragma unroll
                    for (int bj = 0; bj < 2; ++bj) {
                        const f32x4 v0 = acc[ai][bj][m][0], v1 = acc[ai][bj][m][1];
                        const int tk = 32 * wc + 8 * fq;
                        bf16_t* dst;
                        u32x4 pk;
                        if (nt < 8) {
                            const int chunk = u.pm * 2 + bj;
                            dst = avT + ((size_t)chunk * 512 + (nt - 4) * 128 + ch) * 128 + tk;
                            pk.x = cvt_pk_bf16(gelu_t(v0[0]), gelu_t(v0[1])); pk.y = cvt_pk_bf16(gelu_t(v0[2]), gelu_t(v0[3])); pk.z = cvt_pk_bf16(gelu_t(v1[0]), gelu_t(v1[1])); pk.w = cvt_pk_bf16(gelu_t(v1[2]), gelu_t(v1[3]));
                        } else {
                            pk.x = cvt_pk_bf16(v0[0], v0[1]); pk.y = cvt_pk_bf16(v0[2], v0[3]); pk.z = cvt_pk_bf16(v1[0], v1[1]); pk.w = cvt_pk_bf16(v1[2], v1[3]);
                            if (nt < 24) {
                                const int kvh = nt - 22, row = u.pm * 256 + bj * 128 + tk;
                                if (row < MLAT) dst = VT + ((size_t)((row >> 13) * 2 + kvh) * 128 + ch) * SEQ + (row & 8191);
                                else { const int rc = row - MLAT; dst = VTc + ((size_t)((rc >> 8) * 2 + kvh) * 128 + ch) * CTXL + (rc & 255); }
                            } else {
                                const int ri = (nt - 32) >> 2, j = ((nt - 32) & 3) * 128 + ch;
                                if (u.pm < 64) { const int b = u.pm >> 5, t2 = 2 * (u.pm & 31) + bj; dst = ZT + (((size_t)(b * 512 + j) * 64 + t2) * 256) + ri * 128 + tk; }
                                else { const int rc = (u.pm - 64) * 256 + bj * 128 + tk; dst = ZTc + ((size_t)((rc >> 8) * 512 + j) * 512) + ri * 256 + (rc & 255); }
                            }
                        }
                        *(u32x4*)dst = pk;
                    }
                    asm volatile("" ::: "memory");
                }
            }
            return;
        }
#pragma unroll
        for (int bj = 0; bj < 2; ++bj) {
            const int nt = 2 * u.pn + bj;
            const int colt = nt * 128 + 32 * wc + 8 * fq;
            if (nt < 4 || (nt >= 8 && nt < 12) || (nt >= 24 && nt < 32) || nt >= 40) {
                const bool is_gelu = nt < 4;
#pragma unroll
                for (int ai = 0; ai < 2; ++ai)
#pragma unroll
                    for (int m = 0; m < 4; ++m) {
                        const size_t row = (size_t)u.pm * 256 + ai * 128 + wr * 64 + m * 16 + lv(fr);
                        const f32x4 v0 = acc[ai][bj][m][0], v1 = acc[ai][bj][m][1]; float o[8];
#pragma unroll
                        for (int i = 0; i < 4; ++i) { o[i] = is_gelu ? gelu_t(v0[i]) : silu_f(v0[i]); o[4 + i] = is_gelu ? gelu_t(v1[i]) : silu_f(v1[i]); }
                        u32x4 pk; pk.x = cvt_pk_bf16(o[0], o[1]); pk.y = cvt_pk_bf16(o[2], o[3]); pk.z = cvt_pk_bf16(o[4], o[5]); pk.w = cvt_pk_bf16(o[6], o[7]);
                        *(u32x4*)(PROJ + row * NCOL + colt) = pk;
                        asm volatile("" ::: "memory");
                    }
            } else if (nt < 8) {
#pragma unroll
                for (int ai = 0; ai < 2; ++ai)
#pragma unroll
                    for (int m = 0; m < 4; ++m) {
                        const int row = u.pm * 256 + ai * 128 + wr * 64 + m * 16 + lv(fr);
                        const int chunk = row >> 7, q = row & 127;
#pragma unroll
                        for (int n = 0; n < 2; ++n) {
                            f32x4 v = acc[ai][bj][m][n];
                            const int c0 = (nt - 4) * 128 + 32 * wc + 8 * fq + 4 * n;
#pragma unroll
                            for (int i = 0; i < 4; ++i) avT[((size_t)chunk * 512 + c0 + i) * 128 + q] = f2bf(gelu_t(v[i]));
                            asm volatile("" ::: "memory");
                        }
                    }
            } else if (nt < 22) {
                const bool isq = nt < 20; const float sc = isq ? QSCALE : 1.f;
                const bool lat = u.pm < 64;
                float frev[4];
#pragma unroll
                for (int i = 0; i < 4; ++i) frev[i] = __builtin_amdgcn_exp2f(-(float)((wc & 1) * 16 + fq * 4 + i) * (13.287712379549449f / 32.f)) * 0.15915494309189535f;
#pragma unroll
                for (int ai = 0; ai < 2; ++ai)
#pragma unroll
                    for (int m = 0; m < 4; ++m) {
                        const size_t row = (size_t)u.pm * 256 + ai * 128 + wr * 64 + m * 16 + lv(fr);
                        const int tpos = (int)(row & 8191);
                        const int pos = (wc < 2) ? (tpos >> 6) : (tpos & 63);
                        const f32x4 x0 = acc[ai][bj][m][0], x1 = acc[ai][bj][m][1];
                        float o0[4], o1[4];
                        if (lat) {
#pragma unroll
                            for (int i = 0; i < 4; ++i) { const float rev = (float)pos * frev[i]; const float cx = __builtin_amdgcn_cosf(rev), sx = __builtin_amdgcn_sinf(rev);
                                o0[i] = (x0[i] * cx - x1[i] * sx) * sc; o1[i] = (x1[i] * cx + x0[i] * sx) * sc; }
                        } else {
#pragma unroll
                            for (int i = 0; i < 4; ++i) { o0[i] = x0[i] * sc; o1[i] = x1[i] * sc; }
                        }
                        u32x4 pk; pk.x = cvt_pk_bf16(o0[0], o0[1]); pk.y = cvt_pk_bf16(o0[2], o0[3]); pk.z = cvt_pk_bf16(o1[0], o1[1]); pk.w = cvt_pk_bf16(o1[2], o1[3]);
                        *(u32x4*)(PROJ + row * NCOL + colt) = pk;
                        asm volatile("" ::: "memory");
                    }
            } else if (nt < 24) {
                const int kvh = nt - 22;
#pragma unroll
                for (int ai = 0; ai < 2; ++ai)
#pragma unroll
                    for (int m = 0; m < 4; ++m) {
                        const int row = u.pm * 256 + ai * 128 + wr * 64 + m * 16 + lv(fr);
#pragma unroll
                        for (int n = 0; n < 2; ++n) {
                            f32x4 v = acc[ai][bj][m][n];
                            const int d0 = 32 * wc + 8 * fq + 4 * n;
                            if (row < MLAT) { const int b = row >> 13, t = row & 8191;
#pragma unroll
                                for (int i = 0; i < 4; ++i) VT[((size_t)(b * 2 + kvh) * 128 + d0 + i) * SEQ + t] = f2bf(v[i]);
                            } else { const int rc = row - MLAT, b = rc >> 8, t = rc & 255;
#pragma unroll
                                for (int i = 0; i < 4; ++i) VTc[((size_t)(b * 2 + kvh) * 128 + d0 + i) * CTXL + t] = f2bf(v[i]);
                            }
                            asm volatile("" ::: "memory");
                        }
                    }
            } else {
                const int ri = (nt - 32) >> 2, jt = ((nt - 32) & 3) * 128;
#pragma unroll
                for (int ai = 0; ai < 2; ++ai)
#pragma unroll
                    for (int m = 0; m < 4; ++m) {
                        const int R = wr * 64 + m * 16 + lv(fr);
#pragma unroll
                        for (int n = 0; n < 2; ++n) {
                            f32x4 v = acc[ai][bj][m][n];
                            const int j0 = jt + 32 * wc + 8 * fq + 4 * n;
                            if (u.pm < 64) { const int b = u.pm >> 5, t2 = 2 * (u.pm & 31) + ai;
#pragma unroll
                                for (int i = 0; i < 4; ++i) ZT[(((size_t)(b * 512 + j0 + i) * 64 + t2) * 256) + ri * 128 + R] = f2bf(v[i]);
                            } else { const int rc = (u.pm - 64) * 256 + ai * 128 + R, b = rc >> 8, t = rc & 255;
#pragma unroll
                                for (int i = 0; i < 4; ++i) ZTc[((size_t)(b * 512 + j0 + i) * 512) + ri * 256 + t] = f2bf(v[i]);
                            }
                            asm volatile("" ::: "memory");
                        }
                    }
            }
        }
    }
};
struct EpiOut {
    bf16_t* Y;
    __device__ __forceinline__ void operator()(const f32x4 (&acc)[2][2][4][2], const Unit& u, int wr, int wc, int fr, int fq) const {
#pragma unroll
        for (int ai = 0; ai < 2; ++ai)
#pragma unroll
            for (int m = 0; m < 4; ++m) {
                const size_t row = (size_t)u.pm * 256 + ai * 128 + wr * 64 + m * 16 + fr;
#pragma unroll
                for (int bj = 0; bj < 2; ++bj) { const f32x4 v0 = acc[ai][bj][m][0], v1 = acc[ai][bj][m][1];
                    u32x4 pk; pk.x = cvt_pk_bf16(v0[0], v0[1]); pk.y = cvt_pk_bf16(v0[2], v0[3]); pk.z = cvt_pk_bf16(v1[0], v1[1]); pk.w = cvt_pk_bf16(v1[2], v1[3]);
                    *(u32x4*)(Y + row * DM + u.pn * 256 + bj * 128 + 32 * wc + 8 * fq) = pk; }
            }
    }
};
struct EpiFold {
    bf16_t* WinT;
    __device__ __forceinline__ void operator()(const f32x4 (&acc)[2][2][4][2], const Unit& u, int wr, int wc, int fr, int fq) const {
        const int l = u.pm >> 2;
#pragma unroll
        for (int ai = 0; ai < 2; ++ai)
#pragma unroll
            for (int m = 0; m < 4; ++m) {
                const size_t r = (size_t)(u.pm & 3) * 256 + ai * 128 + wr * 64 + m * 16 + fr;
#pragma unroll
                for (int bj = 0; bj < 2; ++bj) { const f32x4 v0 = acc[ai][bj][m][0], v1 = acc[ai][bj][m][1];
                    u32x4 pk; pk.x = cvt_pk_bf16(v0[0], v0[1]); pk.y = cvt_pk_bf16(v0[2], v0[3]); pk.z = cvt_pk_bf16(v1[0], v1[1]); pk.w = cvt_pk_bf16(v1[2], v1[3]);
                    *(u32x4*)(WinT + ((size_t)l * NCOL + C_ZR + r) * DM + (u.pn & 7) * 256 + bj * 128 + 32 * wc + 8 * fq) = pk; }
            }
    }
};
struct EpiS1 {
    bf16_t* Bint;
    __device__ __forceinline__ void operator()(const f32x4 (&acc)[2][2][4][2], const Unit& u, int wr, int wc, int fr, int fq) const {
#pragma unroll
        for (int m = 0; m < 4; ++m) {
            const int k1 = lv(wr * 64 + m * 16 + fr);
#pragma unroll
            for (int bj = 0; bj < 2; ++bj) {
                const int c = u.pn * 256 + bj * 128 + 32 * wc + 8 * fq;
                const int t2 = c & 63, bjx = c >> 6, b = bjx >> 9, j = bjx & 511;
                float br[8], bi[8];
#pragma unroll
                for (int n = 0; n < 2; ++n) {
                    const f32x4 ar = acc[0][bj][m][n], aim = acc[1][bj][m][n];
#pragma unroll
                    for (int i = 0; i < 4; ++i) { const float rev = (float)(k1 * (t2 + 4 * n + i)) * (1.f / 8192.f); const float cw = __builtin_amdgcn_cosf(rev), sw = __builtin_amdgcn_sinf(rev);
                        br[4 * n + i] = ar[i] * cw - aim[i] * sw; bi[4 * n + i] = ar[i] * sw + aim[i] * cw; }
                }
                const unsigned off = (unsigned)(((b * 128 + k1) * 512 + j) * 128 + t2);
                u32x4 p0, p1; p0.x = cvt_pk_bf16(br[0], br[1]); p0.y = cvt_pk_bf16(br[2], br[3]); p0.z = cvt_pk_bf16(br[4], br[5]); p0.w = cvt_pk_bf16(br[6], br[7]);
                p1.x = cvt_pk_bf16(bi[0], bi[1]); p1.y = cvt_pk_bf16(bi[2], bi[3]); p1.z = cvt_pk_bf16(bi[4], bi[5]); p1.w = cvt_pk_bf16(bi[6], bi[7]);
                *(u32x4*)(Bint + off) = p0; *(u32x4*)(Bint + off + 64) = p1;
            }
            asm volatile("" ::: "memory");
        }
    }
};
struct EpiCtxF {
    bf16_t* MIX; const bf16_t* PROJ; const float* bf;
    __device__ __forceinline__ void operator()(const f32x4 (&acc)[2][2][4][2], const Unit& u, int wr, int wc, int fr, int fq) const {
#pragma unroll
        for (int ai = 0; ai < 2; ++ai) {
            u32x4 gg[4][2];
#pragma unroll
            for (int m = 0; m < 4; ++m)
#pragma unroll
                for (int bj = 0; bj < 2; ++bj) { const int k = ai * 128 + wr * 64 + m * 16 + fr, col = u.pn * 256 + bj * 128 + 32 * wc + 8 * fq, b = col >> 9, j = col & 511;
                    gg[m][bj] = *(const u32x4*)(PROJ + ((size_t)MLAT + b * 256 + k) * NCOL + C_CG + j); }
#pragma unroll
            for (int m = 0; m < 4; ++m)
#pragma unroll
                for (int bj = 0; bj < 2; ++bj) { const int k = ai * 128 + wr * 64 + m * 16 + fr, col = u.pn * 256 + bj * 128 + 32 * wc + 8 * fq, b = col >> 9, j = col & 511;
                    const f32x4 v0 = acc[ai][bj][m][0], v1 = acc[ai][bj][m][1]; const f32x4 b0 = *(const f32x4*)(bf + j), b1 = *(const f32x4*)(bf + j + 4); const u32x4 g2 = gg[m][bj];
                    u32x4 pk; pk.x = cvt_pk_bf16((v0[0] + b0[0]) * bflo(g2.x), (v0[1] + b0[1]) * bfhi(g2.x)); pk.y = cvt_pk_bf16((v0[2] + b0[2]) * bflo(g2.y), (v0[3] + b0[3]) * bfhi(g2.y));
                    pk.z = cvt_pk_bf16((v1[0] + b1[0]) * bflo(g2.z), (v1[1] + b1[1]) * bfhi(g2.z)); pk.w = cvt_pk_bf16((v1[2] + b1[2]) * bflo(g2.w), (v1[3] + b1[3]) * bfhi(g2.w));
                    *(u32x4*)(MIX + ((size_t)MLAT + b * 256 + k) * DM + 1536 + j) = pk; }
            asm volatile("" ::: "memory");
        }
    }
};

__device__ __forceinline__ int qk_dperm(int p) {
    const int wc = p >> 5, fq = (p >> 3) & 3, n = (p >> 2) & 1, i = p & 3;
    return (wc >> 1) * 64 + n * 32 + (wc & 1) * 16 + fq * 4 + i;
}
__device__ __forceinline__ void transpose_blk(const float* src, int sp, int scol0, bf16_t* dst, int k0, int nd0, bool perm, LAS float* scr) {
    const int tid = lv(threadIdx.x);
    f32x4 v[8];
#pragma unroll
    for (int i = 0; i < 8; ++i) { const int k = (tid >> 6) + 8 * i, c4 = (tid & 63) * 4; v[i] = *(const f32x4*)(src + (size_t)(k0 + k) * sp + scol0 + c4); }
#pragma unroll
    for (int i = 0; i < 8; ++i) { const int k = (tid >> 6) + 8 * i, c4 = (tid & 63) * 4; LAS float* s = scr + k * 257 + c4; s[0] = v[i][0]; s[1] = v[i][1]; s[2] = v[i][2]; s[3] = v[i][3]; }
    __syncthreads();
#pragma unroll
    for (int i = 0; i < 4; ++i) { const int n = (tid >> 3) + 64 * i, kc = tid & 7;
      int sc = n;
      if (perm) { const int p = (nd0 + n) & 127; sc = (n & ~63) + (qk_dperm(p) & 63); }
      const LAS float* s = scr + (kc * 8) * 257 + sc;
      u32x4 o; o.x = cvt_pk_bf16(s[0], s[257]); o.y = cvt_pk_bf16(s[2 * 257], s[3 * 257]); o.z = cvt_pk_bf16(s[4 * 257], s[5 * 257]); o.w = cvt_pk_bf16(s[6 * 257], s[7 * 257]);
      *(u32x4*)(dst + (size_t)(nd0 + n) * DM + k0 + kc * 8) = o; }
    __syncthreads();
}

__device__ __forceinline__ void phase0a(const Params& P_unused, LAS unsigned char* lds, int G) {
    const Params P = load_params(); (void)P_unused;
    unsigned char* ws = ls(P.ws);
    bf16_t* WinT = (bf16_t*)(ws + O_WINT); bf16_t* WoutT = (bf16_t*)(ws + O_WOUTT); bf16_t* Wcx = (bf16_t*)(ws + O_WCX); bf16_t* MTf = (bf16_t*)(ws + O_MTF);
    float* modp = (float*)(ws + O_MODP); float2* rope = (float2*)(ws + O_ROPE); float2* twid = (float2*)(ws + O_TWID);
    bf16_t* F128 = (bf16_t*)(ws + O_F128); bf16_t* F64 = (bf16_t*)(ws + O_F64); bf16_t* Dctx = (bf16_t*)(ws + O_DCTX);
    LAS float* scr = (LAS float*)lds;
    const int tid = lv(threadIdx.x), bid = blockIdx.x;
    for (int task = bid; task < 384; task += G) {
        const int l = task / 96, s = (task / 3) & 31, nc = task % 3;
        __syncthreads();
        if (tid < 192) { const int r = tid >> 6, kk = tid & 63; const float v = (r < 2) ? P.c[r * DM + s * 64 + kk] : P.c_ctx[s * 64 + kk]; scr[r * 64 + kk] = silu_f(v); }
        __syncthreads();
        const int n = nc * 2048 + tid * 4;
        f32x4 a0 = {0, 0, 0, 0}, a1 = {0, 0, 0, 0}, a2 = {0, 0, 0, 0};
        const float* wp = P.w_mod + ((size_t)l * DM + s * 64) * 6144 + n;
#pragma unroll 16
        for (int kk = 0; kk < 64; ++kk) { const f32x4 w = *(const f32x4*)(wp + (size_t)kk * 6144); a0 += w * scr[kk]; a1 += w * scr[64 + kk]; a2 += w * scr[128 + kk]; }
        float* op = modp + ((size_t)(l * 32 + s) * 3) * 6144 + n;
        *(f32x4*)(op) = a0; *(f32x4*)(op + 6144) = a1; *(f32x4*)(op + 2 * 6144) = a2;
    }
    __syncthreads();
    for (int task = bid; task < DEPTH * 18 * 32; task += G) {
        const int l = task / (18 * 32), r = task % (18 * 32), nb = r >> 5, kt = r & 31;
        const int nd0 = nb < 16 ? nb * 256 : (5120 + (nb - 16) * 256);
        const int scol0 = nb < 16 ? nd0 : nd0 - 512;
        const bool perm = (nd0 >= C_Q && nd0 < C_V);
        transpose_blk(P.w_in + (size_t)l * DM * 5120, 5120, scol0, WinT + (size_t)l * NCOL * DM, kt * 64, nd0, perm, scr);
    }
    for (int task = bid; task < DEPTH * 8 * 32; task += G) {
        const int l = task >> 8, r = task & 255, nb = r >> 5, kt = r & 31;
        transpose_blk(P.w_out + (size_t)l * DM * DM, DM, nb * 256, WoutT + (size_t)l * DM * DM, kt * 64, nb * 256, false, scr);
    }
    if (tid < 128) { const float a = (float)tid * (1.f / 64.f); scr[tid] = cospif(a); scr[128 + tid] = sinpif(a); }
    __syncthreads();
    const size_t gt = (size_t)bid * 512 + tid, GT = (size_t)G * 512;
    for (size_t e = gt; e < (size_t)DEPTH * DM * 128; e += GT) {
        const size_t lk = e >> 7; const int j4 = (int)(e & 127) * 4;
        const f32x4 v = *(const f32x4*)(P.w_in + lk * 5120 + 4096 + j4);
        *(u32x2*)(Wcx + lk * 512 + j4) = pack4(v[0], v[1], v[2], v[3]);
    }
    for (size_t e = gt; e < (size_t)DEPTH * 1024 * 512; e += GT) {
        const int col = (int)(e & 511), row = (int)((e >> 9) & 1023), l = (int)(e >> 19);
        const int ri = row >> 9, g = (row >> 7) & 3, d = row & 127, g2 = col >> 7, c = col & 127;
        float v = 0.f;
        if (g == g2) {
            const float* wf = P.w_f + ((size_t)(l * 4 + g) * 128) * 128 + d;
            float s = 0.f;
            const LAS float* tb = scr + ri * 128;
#pragma unroll 8
            for (int c2 = 0; c2 < 128; ++c2) s += tb[(c * c2) & 127] * wf[(size_t)c2 * 128];
            v = s * (1.f / 1024.f);
        }
        MTf[e] = f2bf(v);
    }
    for (size_t e = gt; e < 128 * 32; e += GT) { const int pos = (int)(e >> 5), f = (int)(e & 31);
        const float fr = powf(10000.f, -(float)f / 32.f); const float ang = (float)pos * fr; float sn, cs; sincosf(ang, &sn, &cs); rope[e] = make_float2(cs, sn); }
    for (size_t e = gt; e < 8192; e += GT) { const float a = (float)e * (1.f / 4096.f); twid[e] = make_float2(cospif(a), sinpif(a)); }
    for (size_t e = gt; e < 256 * 256; e += GT) { const int n = (int)(e >> 8), kk = (int)(e & 255); const int ro = n >> 7, k1 = n & 127, rin = kk >> 7, t1 = kk & 127;
        const float a = (float)((k1 * t1) & 127) * (1.f / 64.f); const float cs = cospif(a), sn = sinpif(a);
        const float v = ro == 0 ? (rin == 0 ? cs : -sn) : (rin == 0 ? sn : cs); F128[e] = f2bf(v); }
    for (size_t e = gt; e < 64 * 128; e += GT) { const int k2 = (int)(e >> 7), kk = (int)(e & 127); const int rin = kk >> 6, t2 = kk & 63;
        const float a = (float)((k2 * t2) & 63) * (1.f / 32.f); F64[e] = f2bf(rin == 0 ? cospif(a) : -sinpif(a)); }
    for (size_t e = gt; e < 256 * 512; e += GT) { const int k = (int)(e >> 9), kk = (int)(e & 511); const int rin = kk >> 8, t = kk & 255;
        const float a = (float)((k * t) & 255) * (1.f / 128.f); Dctx[e] = f2bf((rin == 0 ? cospif(a) : -sinpif(a)) * 5.656854249492381f); }
}

__device__ __forceinline__ void row_phase(const Params& P_unused, int layer, int G) {
    const Params P = load_params(); (void)P_unused;
    unsigned char* ws = ls(P.ws);
    const float* mod = (const float*)(ws + O_MOD);
    float* XC = (float*)(ws + O_XC);
    bf16_t* XB = (bf16_t*)(ws + O_XB);
    bf16_t* H = (bf16_t*)(ws + O_HMIX);
    const bf16_t* Y = (const bf16_t*)(ws + O_PROJ); const bf16_t* Yc = (const bf16_t*)(ws + O_YC);
    const int tid = lv(threadIdx.x);
    const int lane = tid & 63, gw = blockIdx.x * 8 + (tid >> 6), NGW = G * 8;
    const int nrows = layer == DEPTH ? MLAT : MROWS;
    const bool xb_src = layer >= 2;
    const float* xctx = layer <= 1 ? P.ctx : XC;
    f32x4 vn[8]; u32x2 yn[8], xn[8];
#define ROW_LOAD(r) do { const int _r = (r); \
        if (_r < MLAT && xb_src) { _Pragma("unroll") for (int j = 0; j < 8; ++j) xn[j] = *(const u32x2*)(XB + (size_t)_r * DM + lane * 4 + 256 * j); } \
        else { const float* _x = _r < MLAT ? P.x + (size_t)_r * DM : xctx + (size_t)(_r - MLAT) * DM; _Pragma("unroll") for (int j = 0; j < 8; ++j) vn[j] = *(const f32x4*)(_x + lane * 4 + 256 * j); } \
        if (layer >= 1) { const bf16_t* _y = _r < MLAT ? Y + (size_t)_r * DM : Yc + (size_t)(_r - MLAT) * DM; _Pragma("unroll") for (int j = 0; j < 8; ++j) yn[j] = *(const u32x2*)(_y + lane * 4 + 256 * j); } } while (0)
    if (gw < nrows) ROW_LOAD(gw);
    for (int row = gw; row < nrows; row += NGW) {
        const bool lat = row < MLAT; const int mr = lat ? (row >> 13) : 2;
        f32x4 v[8]; u32x2 yw[8];
        if (lat && xb_src) {
#pragma unroll
            for (int j = 0; j < 8; ++j) v[j] = (f32x4){bflo(xn[j].x), bfhi(xn[j].x), bflo(xn[j].y), bfhi(xn[j].y)};
        } else {
#pragma unroll
            for (int j = 0; j < 8; ++j) v[j] = vn[j];
        }
#pragma unroll
        for (int j = 0; j < 8; ++j) yw[j] = yn[j];
        const int nr = row + NGW;
        if (nr < nrows) ROW_LOAD(nr);
        if (layer >= 1) {
            const float* mg = mod + ((size_t)(layer - 1) * 3 + mr) * 6144 + 4096;
            const float* gp = P.g_post + (size_t)(layer - 1) * DM;
            f32x4 y[8]; float ss = 0.f;
#pragma unroll
            for (int j = 0; j < 8; ++j) { const u32x2 w = yw[j];
                y[j] = (f32x4){bflo(w.x), bfhi(w.x), bflo(w.y), bfhi(w.y)}; ss += y[j][0] * y[j][0] + y[j][1] * y[j][1] + y[j][2] * y[j][2] + y[j][3] * y[j][3]; }
            const float rinv = rsqrtf(wave_sum(ss) * (1.f / DM) + EPS);
#pragma unroll
            for (int j = 0; j < 8; ++j) { const f32x4 g4 = *(const f32x4*)(mg + lane * 4 + 256 * j), p4 = *(const f32x4*)(gp + lane * 4 + 256 * j);
                v[j] = v[j] + g4 * (y[j] * rinv * p4); }
            if (!lat) {
#pragma unroll
                for (int j = 0; j < 8; ++j) *(f32x4*)(XC + (size_t)(row - MLAT) * DM + lane * 4 + 256 * j) = v[j];
            } else if (layer == DEPTH) {
#pragma unroll
                for (int j = 0; j < 8; ++j) *(f32x4*)(P.out + (size_t)row * DM + lane * 4 + 256 * j) = v[j];
            } else {
#pragma unroll
                for (int j = 0; j < 8; ++j) *(u32x2*)(XB + (size_t)row * DM + lane * 4 + 256 * j) = pack4(v[j][0], v[j][1], v[j][2], v[j][3]);
            }
        }
        if (layer < DEPTH) {
            float ss = 0.f;
#pragma unroll
            for (int j = 0; j < 8; ++j) ss += v[j][0] * v[j][0] + v[j][1] * v[j][1] + v[j][2] * v[j][2] + v[j][3] * v[j][3];
            const float rinv = rsqrtf(wave_sum(ss) * (1.f / DM) + EPS);
            const float* msh = mod + ((size_t)layer * 3 + mr) * 6144; const float* msc = msh + 2048;
            const float* gp = P.g_pre + (size_t)layer * DM;
#pragma unroll
            for (int j = 0; j < 8; ++j) { const f32x4 sh = *(const f32x4*)(msh + lane * 4 + 256 * j), sc = *(const f32x4*)(msc + lane * 4 + 256 * j), g4 = *(const f32x4*)(gp + lane * 4 + 256 * j);
                const f32x4 h = (v[j] * rinv * g4) * (sc + 1.f) + sh;
                *(u32x2*)(H + (size_t)row * DM + lane * 4 + 256 * j) = pack4(h[0], h[1], h[2], h[3]); }
        }
    }
#undef ROW_LOAD
}

__device__ __forceinline__ void attn_task(const Params& P_unused, int layer, int task, LAS unsigned char* lds) {
    const Params P = load_params(); (void)P_unused;
    unsigned char* ws = ls(P.ws);
    const bf16_t* PROJ = (const bf16_t*)(ws + O_PROJ);
    const bf16_t* VT = (const bf16_t*)(ws + O_VT); const bf16_t* VTc = (const bf16_t*)(ws + O_VTC);
    bf16_t* MIX = (bf16_t*)(ws + O_HMIX);
    const int tid = lv(threadIdx.x);
    const int lane = tid & 63, w = __builtin_amdgcn_readfirstlane(tid >> 6), fr = lane & 15, fq = lane >> 4;
    int b, blk, kvh, pair; bool isctx;
    if (task < 512) { isctx = false; b = task >> 8; const int rem = task & 255; blk = rem >> 2; kvh = (rem >> 1) & 1; pair = rem & 1; }
    else { isctx = true; const int t = task - 512; b = t >> 3; blk = (t >> 2) & 1; kvh = (t >> 1) & 1; pair = t & 1; }
    const int head = kvh * 4 + pair * 2 + (w >> 2);
    const int a0 = (w & 3) * 32;
    const size_t qrow0 = (isctx ? (size_t)MLAT + b * CTXL : (size_t)b * SEQ) + blk * 128 + a0;
    bf16x8 qf[2][4];
#pragma unroll
    for (int u = 0; u < 2; ++u)
#pragma unroll
        for (int c = 0; c < 4; ++c) qf[u][c] = *(const bf16x8*)(PROJ + (qrow0 + u * 16 + fr) * NCOL + C_Q + head * 128 + c * 32 + fq * 8);
    u32x2 gws[2][8];
#pragma unroll
    for (int u = 0; u < 2; ++u)
#pragma unroll
        for (int dt = 0; dt < 8; ++dt) gws[u][dt] = *(const u32x2*)(PROJ + (qrow0 + u * 16 + fr) * NCOL + C_BG + head * 128 + dt * 16 + 4 * fq);
    float mrun[2], lrun[2];
    const float sk = P.sink[layer * 8 + head] * LOG2E;
    mrun[0] = mrun[1] = sk; lrun[0] = lrun[1] = 1.f;
    f32x4 o[8][2];
#pragma unroll
    for (int dt = 0; dt < 8; ++dt) { o[dt][0] = (f32x4){0, 0, 0, 0}; o[dt][1] = (f32x4){0, 0, 0, 0}; }
    const int nprev = (!isctx && blk > 0) ? 4 : 0, nnext = (!isctx && blk < 63) ? 4 : 0;
    const int T = isctx ? 8 : 12 + nprev + nnext;
    const int lkey = tid >> 4, lkc = (tid & 15) ^ (((lkey >> 3) << 2) | (lkey & 3));
    const unsigned koff = (unsigned)(lkey * NCOL + lkc * 8) * 2u;
    const int ld = tid >> 2, lvc = (tid & 3) ^ ((ld >> 2) & 3);
    const unsigned voff_c = (unsigned)(ld * CTXL + lvc * 8) * 2u, voff_s = (unsigned)(ld * SEQ + lvc * 8) * 2u;
    const char* kctx = (const char*)(PROJ + ((size_t)MLAT + b * CTXL) * NCOL + C_K + kvh * 128);
    const char* klat = (const char*)(PROJ + ((size_t)b * SEQ) * NCOL + C_K + kvh * 128);
    const char* vctx = (const char*)(VTc + (size_t)(b * 2 + kvh) * 128 * CTXL);
    const char* vlat = (const char*)(VT + (size_t)(b * 2 + kvh) * 128 * SEQ);
#define ATT_ISSUE(tt) do { int _t = (tt) < T ? (tt) : T - 1; const char* _kp; const char* _vp; unsigned _vo; \
        if (_t < 8) { _kp = kctx + (size_t)(_t * 32) * NCOL * 2; _vp = vctx + _t * 64; _vo = voff_c; } \
        else { const int _r = _t - 8, _seg = _r < nprev ? 0 : (_r < nprev + 4 ? 1 : 2), _st = _seg == 0 ? _r : (_seg == 1 ? _r - nprev : _r - nprev - 4); \
               const int _kb = (blk - 1 + _seg) * 128 + _st * 32; _kp = klat + (size_t)_kb * NCOL * 2; _vp = vlat + _kb * 2; _vo = voff_s; } \
        LAS unsigned char* _dst = lds + ((tt) & 7) * 16384 + w * 1024; \
        __builtin_amdgcn_global_load_lds((const unsigned*)(_kp + koff), (LAS unsigned*)(_dst), 16, 0, 0); \
        __builtin_amdgcn_global_load_lds((const unsigned*)(_vp + _vo), (LAS unsigned*)(_dst + 8192), 16, 0, 0); } while (0)
    ATT_ISSUE(0); ATT_ISSUE(1); ATT_ISSUE(2); ATT_ISSUE(3); ATT_ISSUE(4); ATT_ISSUE(5); ATT_ISSUE(6);
    const int kfo = (8 * (fr >> 2) + (fr & 3)) * 256, vfo = fr * 64 + ((fq ^ ((fr >> 2) & 3)) * 16);
    int kofs[4];
#pragma unroll
    for (int c = 0; c < 4; ++c) kofs[c] = kfo + (((c * 4 + fq) ^ fr) * 16);
    const f32x4 zero4 = {0.f, 0.f, 0.f, 0.f};
    for (int t = 0; t < T; ++t) {
        asm volatile("s_waitcnt vmcnt(12) lgkmcnt(0)" ::: "memory");
        __builtin_amdgcn_s_barrier();
        asm volatile("" ::: "memory");
        ATT_ISSUE(t + 7);
        int mtype = 0, st = 0;
        if (t >= 8) { const int r = t - 8; if (r < nprev) { mtype = 1; st = r; } else if (r >= nprev + 4) { mtype = 2; st = r - nprev - 4; } }
        const int k0 = st * 32;
        if (mtype == 1 && k0 + 31 < a0) continue;
        if (mtype == 2 && k0 > a0 + 31) continue;
        const LAS unsigned char* kb = lds + (t & 7) * 16384; const LAS unsigned char* vb = kb + 8192;
        f32x4 s[2][2];
#pragma unroll
        for (int v = 0; v < 2; ++v)
#pragma unroll
            for (int c = 0; c < 4; ++c) {
                const bf16x8 ka = *(const LAS bf16x8*)(kb + kofs[c] + v * 1024);
                s[0][v] = __builtin_amdgcn_mfma_f32_16x16x32_bf16(ka, qf[0][c], c == 0 ? zero4 : s[0][v], 0, 0, 0);
                s[1][v] = __builtin_amdgcn_mfma_f32_16x16x32_bf16(ka, qf[1][c], c == 0 ? zero4 : s[1][v], 0, 0, 0);
            }
        bf16x8 pb[2];
#pragma unroll
        for (int u = 0; u < 2; ++u) {
            if (mtype == 1) {
                asm volatile("" ::: "memory");
                const int a = a0 + u * 16 + fr - k0 - 8 * fq;
#pragma unroll
                for (int v = 0; v < 2; ++v)
#pragma unroll
                    for (int r = 0; r < 4; ++r) { if (4 * v + r < a) s[u][v][r] = -1e30f; }
            } else if (mtype == 2) {
                asm volatile("" ::: "memory");
                const int a = a0 + u * 16 + fr - k0 - 8 * fq;
#pragma unroll
                for (int v = 0; v < 2; ++v)
#pragma unroll
                    for (int r = 0; r < 4; ++r) { if (4 * v + r > a) s[u][v][r] = -1e30f; }
            }
            float mx = fmaxf(fmaxf(fmaxf(s[u][0][0], s[u][0][1]), fmaxf(s[u][0][2], s[u][0][3])), fmaxf(fmaxf(s[u][1][0], s[u][1][1]), fmaxf(s[u][1][2], s[u][1][3])));
            mx = xor16_max(mx); mx = xor32_max(mx);
            const float mn = fmaxf(mrun[u], mx);
            const float alpha = __builtin_amdgcn_exp2f(mrun[u] - mn);
            float p[8]; float ps = 0.f;
#pragma unroll
            for (int v = 0; v < 2; ++v)
#pragma unroll
                for (int r = 0; r < 4; ++r) { p[v * 4 + r] = __builtin_amdgcn_exp2f(s[u][v][r] - mn); ps += p[v * 4 + r]; }
            ps = xor16_sum(ps); ps = xor32_sum(ps);
            lrun[u] = lrun[u] * alpha + ps;
            if (__any(mn > mrun[u])) {
#pragma unroll
                for (int dt = 0; dt < 8; ++dt) o[dt][u] = o[dt][u] * alpha;
            }
            mrun[u] = mn;
            u32x4 pk; pk.x = cvt_pk_bf16(p[0], p[1]); pk.y = cvt_pk_bf16(p[2], p[3]); pk.z = cvt_pk_bf16(p[4], p[5]); pk.w = cvt_pk_bf16(p[6], p[7]);
            pb[u] = __builtin_bit_cast(bf16x8, pk);
        }
#pragma unroll
        for (int dt = 0; dt < 8; ++dt) {
            const bf16x8 va = *(const LAS bf16x8*)(vb + dt * 1024 + vfo);
            o[dt][0] = __builtin_amdgcn_mfma_f32_16x16x32_bf16(va, pb[0], o[dt][0], 0, 0, 0);
            o[dt][1] = __builtin_amdgcn_mfma_f32_16x16x32_bf16(va, pb[1], o[dt][1], 0, 0, 0);
        }
    }
    asm volatile("s_waitcnt vmcnt(0) lgkmcnt(0)" ::: "memory");
    __builtin_amdgcn_s_barrier();
    asm volatile("" ::: "memory");
#undef ATT_ISSUE
#pragma unroll
    for (int u = 0; u < 2; ++u) {
        const float inv = 1.f / lrun[u];
        const size_t row = qrow0 + u * 16 + fr;
#pragma unroll
        for (int dt = 0; dt < 8; ++dt) {
            const int d0 = head * 128 + dt * 16 + 4 * fq;
            const u32x2 gw = gws[u][dt];
            const f32x4 ov = o[dt][u] * inv;
            *(u32x2*)(MIX + row * DM + 512 + d0) = pack4(ov[0] * bflo(gw.x), ov[1] * bfhi(gw.x), ov[2] * bflo(gw.y), ov[3] * bfhi(gw.y));
        }
    }
}

constexpr int GM_PART = 131072, GM_RQ = GM_PART + 32 * 128 * 4, LDS_TOTAL = GM_RQ + 512;
__device__ __forceinline__ void gmlp_task(const Params& P_unused, int layer, int chunk, LAS unsigned char* lds) {
    const Params P = load_params(); (void)P_unused;
    unsigned char* ws = ls(P.ws);
    const bf16_t* PROJ = (const bf16_t*)(ws + O_PROJ); const bf16_t* avT = (const bf16_t*)(ws + O_AVT) + (size_t)chunk * 512 * 128;
    bf16_t* MIX = (bf16_t*)(ws + O_HMIX);
    LAS float* part = (LAS float*)(lds + GM_PART);
    LAS float* rq = (LAS float*)(lds + GM_RQ);
    const int tid = lv(threadIdx.x), lane = tid & 63, w = __builtin_amdgcn_readfirstlane(tid >> 6), fr = lane & 15, fq = lane >> 4;
    __syncthreads();
    const int myc = (tid & 15) ^ ((tid >> 4) & 15);
    { const char* src = (const char*)avT + (size_t)(tid >> 4) * 256 + myc * 16;
#pragma unroll
      for (int i = 0; i < 16; ++i) __builtin_amdgcn_global_load_lds((const unsigned*)(src + (size_t)i * 32 * 256), (LAS unsigned*)(lds + i * 8192 + w * 1024), 16, 0, 0); }
    const int p = 16 * w + fr; const size_t row = (size_t)chunk * 128 + p;
    f32x4 wsn[8]; u32x2 uun[8], ggn[8];
#define GM_LOAD(h) do { const float* _wsr = P.w_sgu + (((size_t)layer * 4 + (h)) * 128 + p) * 128; \
        _Pragma("unroll") for (int c = 0; c < 4; ++c) { wsn[2 * c] = *(const f32x4*)(_wsr + c * 32 + 8 * fq); wsn[2 * c + 1] = *(const f32x4*)(_wsr + c * 32 + 8 * fq + 4); } \
        _Pragma("unroll") for (int dt = 0; dt < 8; ++dt) { const int _col = (h) * 128 + dt * 16 + 4 * fq; uun[dt] = *(const u32x2*)(PROJ + row * NCOL + C_AU + _col); ggn[dt] = *(const u32x2*)(PROJ + row * NCOL + C_AG + _col); } } while (0)
    GM_LOAD(0);
    asm volatile("s_waitcnt vmcnt(0)" ::: "memory");
    __builtin_amdgcn_s_barrier();
    asm volatile("" ::: "memory");
    { float s8[8] = {0, 0, 0, 0, 0, 0, 0, 0};
#pragma unroll
      for (int i = 0; i < 16; ++i) { const u32x4 v = *(const LAS u32x4*)(lds + i * 8192 + tid * 16);
          float f; f = bflo(v.x); s8[0] += f * f; f = bfhi(v.x); s8[1] += f * f; f = bflo(v.y); s8[2] += f * f; f = bfhi(v.y); s8[3] += f * f;
          f = bflo(v.z); s8[4] += f * f; f = bfhi(v.z); s8[5] += f * f; f = bflo(v.w); s8[6] += f * f; f = bfhi(v.w); s8[7] += f * f; }
#pragma unroll
      for (int e = 0; e < 8; ++e) part[(tid >> 4) * 128 + myc * 8 + e] = s8[e]; }
    __syncthreads();
    if (tid < 128) { float s = 0.f; for (int i = 0; i < 32; ++i) s += part[i * 128 + tid]; rq[tid] = rsqrtf(s * (1.f / 512.f) + EPS); }
    __syncthreads();
    for (int h = 0; h < 4; ++h) {
        f32x4 wsc[8]; u32x2 uu[8], gg[8];
#pragma unroll
        for (int i = 0; i < 8; ++i) { wsc[i] = wsn[i]; uu[i] = uun[i]; gg[i] = ggn[i]; }
        if (h < 3) GM_LOAD(h + 1);
        bf16x8 bfr[4];
#pragma unroll
        for (int c = 0; c < 4; ++c) { const int q0 = c * 32 + 8 * fq; const f32x4 w0 = wsc[2 * c], w1 = wsc[2 * c + 1];
            u32x4 pk; pk.x = cvt_pk_bf16(w0[0] * rq[q0], w0[1] * rq[q0 + 1]); pk.y = cvt_pk_bf16(w0[2] * rq[q0 + 2], w0[3] * rq[q0 + 3]);
            pk.z = cvt_pk_bf16(w1[0] * rq[q0 + 4], w1[1] * rq[q0 + 5]); pk.w = cvt_pk_bf16(w1[2] * rq[q0 + 6], w1[3] * rq[q0 + 7]); bfr[c] = __builtin_bit_cast(bf16x8, pk); }
        f32x4 acc[8];
#pragma unroll
        for (int dt = 0; dt < 8; ++dt) { acc[dt] = (f32x4){0, 0, 0, 0};
#pragma unroll
            for (int c = 0; c < 4; ++c) { const bf16x8 a = *(const LAS bf16x8*)(lds + (h * 128 + dt * 16 + fr) * 256 + (((c * 4 + fq) ^ fr) * 16));
                acc[dt] = __builtin_amdgcn_mfma_f32_16x16x32_bf16(a, bfr[c], acc[dt], 0, 0, 0); } }
        const float bs = P.b_sgu[((size_t)layer * 4 + h) * 128 + p];
#pragma unroll
        for (int dt = 0; dt < 8; ++dt) { const int col = h * 128 + dt * 16 + 4 * fq;
            const f32x4 g4 = *(const f32x4*)(P.g_sgu + (size_t)layer * 512 + col);
            const u32x2 u2 = uu[dt], g2 = gg[dt];
            const float y0 = bflo(u2.x) * (acc[dt][0] * g4[0] + bs) * bflo(g2.x), y1 = bfhi(u2.x) * (acc[dt][1] * g4[1] + bs) * bfhi(g2.x);
            const float y2 = bflo(u2.y) * (acc[dt][2] * g4[2] + bs) * bflo(g2.y), y3 = bfhi(u2.y) * (acc[dt][3] * g4[3] + bs) * bfhi(g2.y);
            *(u32x2*)(MIX + row * DM + col) = pack4(y0, y1, y2, y3); }
    }
#undef GM_LOAD
    __syncthreads();
}

__device__ __forceinline__ void stage2_phase(const Params& P_unused, int layer, int G) {
    const Params P = load_params(); (void)P_unused;
    unsigned char* ws = ls(P.ws);
    const bf16_t* Bint = (const bf16_t*)(ws + O_BINT); const bf16_t* F64 = (const bf16_t*)(ws + O_F64); const bf16_t* PROJ = (const bf16_t*)(ws + O_PROJ);
    bf16_t* MIX = (bf16_t*)(ws + O_HMIX);
    const int tid = lv(threadIdx.x);
    const int lane = tid & 63, w = __builtin_amdgcn_readfirstlane(tid >> 6), fr = lane & 15, fq = lane >> 4;
    bf16x8 ff[4][4];
#pragma unroll
    for (int nt = 0; nt < 4; ++nt)
#pragma unroll
        for (int c = 0; c < 4; ++c) ff[nt][c] = *(const bf16x8*)(F64 + (size_t)(nt * 16 + fr) * 128 + c * 32 + fq * 8);
    for (int task = blockIdx.x; task < 256; task += G) {
        const int b = task >> 7, k1 = task & 127;
        bf16x8 af[4][4]; u32x2 gg[4][4]; f32x4 bias[4];
#pragma unroll
        for (int mi = 0; mi < 4; ++mi) {
            const int j0 = (w * 4 + mi) * 16, jc = j0 + 4 * fq;
#pragma unroll
            for (int c = 0; c < 4; ++c) af[mi][c] = *(const bf16x8*)(Bint + (((size_t)(b * 128 + k1) * 512 + j0 + fr) * 128) + c * 32 + fq * 8);
            bias[mi] = *(const f32x4*)(P.b_f + (size_t)layer * 512 + jc);
#pragma unroll
            for (int nt = 0; nt < 4; ++nt) gg[mi][nt] = *(const u32x2*)(PROJ + ((size_t)b * SEQ + k1 + 128 * (nt * 16 + fr)) * NCOL + C_CG + jc);
        }
#pragma unroll
        for (int mi = 0; mi < 4; ++mi) {
            const int jc = (w * 4 + mi) * 16 + 4 * fq;
#pragma unroll
            for (int nt = 0; nt < 4; ++nt) {
                f32x4 acc = {0, 0, 0, 0};
#pragma unroll
                for (int c = 0; c < 4; ++c) acc = __builtin_amdgcn_mfma_f32_16x16x32_bf16(af[mi][c], ff[nt][c], acc, 0, 0, 0);
                const int k2 = nt * 16 + fr; const size_t row = (size_t)b * SEQ + k1 + 128 * k2;
                const u32x2 g2 = gg[mi][nt];
                *(u32x2*)(MIX + row * DM + 1536 + jc) = pack4((acc[0] + bias[mi][0]) * bflo(g2.x), (acc[1] + bias[mi][1]) * bfhi(g2.x), (acc[2] + bias[mi][2]) * bflo(g2.y), (acc[3] + bias[mi][3]) * bfhi(g2.y));
            }
        }
    }
}

__device__ __forceinline__ void ctx_outproj_tile(const Params& P_unused, int layer, int tile, LAS unsigned char* lds) {
    const Params P = load_params(); (void)P_unused;
    unsigned char* ws = ls(P.ws);
    const bf16_t* A = (const bf16_t*)(ws + O_HMIX) + (size_t)MLAT * DM;
    const bf16_t* Bt = (const bf16_t*)(ws + O_WOUTT) + (size_t)layer * DM * DM;
    bf16_t* Yc = (bf16_t*)(ws + O_YC);
    const int tid = lv(threadIdx.x);
    const int lane = tid & 63, w = __builtin_amdgcn_readfirstlane(tid >> 6), fr = lane & 15, fq = lane >> 4;
    const int m0 = (tile >> 5) * 64, n0 = (tile & 31) * 64;
    f32x4 acc[4][4];
#pragma unroll
    for (int i = 0; i < 4; ++i)
#pragma unroll
        for (int j = 0; j < 4; ++j) acc[i][j] = (f32x4){0, 0, 0, 0};
    const bf16_t* ap = A + (size_t)(m0 + fr) * DM + w * 256 + fq * 8;
    const bf16_t* bp = Bt + (size_t)(n0 + fr) * DM + w * 256 + fq * 8;
#pragma unroll 4
    for (int ks = 0; ks < 8; ++ks) {
        bf16x8 af[4], bv[4];
#pragma unroll
        for (int i = 0; i < 4; ++i) { af[i] = *(const bf16x8*)(ap + (size_t)i * 16 * DM + ks * 32); bv[i] = *(const bf16x8*)(bp + (size_t)i * 16 * DM + ks * 32); }
#pragma unroll
        for (int i = 0; i < 4; ++i)
#pragma unroll
            for (int j = 0; j < 4; ++j) acc[i][j] = __builtin_amdgcn_mfma_f32_16x16x32_bf16(af[i], bv[j], acc[i][j], 0, 0, 0);
    }
    __syncthreads();
    LAS float* red = (LAS float*)lds + w * 4096;
#pragma unroll
    for (int i = 0; i < 4; ++i)
#pragma unroll
        for (int j = 0; j < 4; ++j)
#pragma unroll
            for (int r = 0; r < 4; ++r) red[(i * 16 + 4 * fq + r) * 64 + j * 16 + fr] = acc[i][j][r];
    __syncthreads();
    { const int e0 = tid * 8, row = e0 >> 6, col = e0 & 63;
      f32x4 s0 = {0, 0, 0, 0}, s1 = {0, 0, 0, 0};
#pragma unroll
      for (int wv = 0; wv < 8; ++wv) { const LAS f32x4* p = (const LAS f32x4*)((LAS float*)lds + wv * 4096 + e0); s0 += p[0]; s1 += p[1]; }
      u32x4 o; o.x = cvt_pk_bf16(s0[0], s0[1]); o.y = cvt_pk_bf16(s0[2], s0[3]); o.z = cvt_pk_bf16(s1[0], s1[1]); o.w = cvt_pk_bf16(s1[2], s1[3]);
      *(u32x4*)(Yc + (size_t)(m0 + row) * DM + n0 + col) = o; }
    __syncthreads();
}

#define XB_TMO      128
#define XB_XCNT(j)  (256  + 64 * (j))
#define XB_XSUB(j)  (1280 + 64 * (j))
#define XB_XGEN(j)  (2304 + 64 * (j))
#define XB_TOP      3328
#define XB_TOPGEN   3392
#define XCD_BAR_WORDS 3456
#define XB_SPIN_CAP (1u << 18)
__device__ __forceinline__ unsigned xb_ld(unsigned* p)              { return __hip_atomic_load(p, __ATOMIC_RELAXED, __HIP_MEMORY_SCOPE_AGENT); }
__device__ __forceinline__ unsigned xb_add(unsigned* p, unsigned v) { return __hip_atomic_fetch_add(p, v, __ATOMIC_RELAXED, __HIP_MEMORY_SCOPE_AGENT); }
__device__ __forceinline__ unsigned xb_xcc_id() { return (unsigned)__builtin_amdgcn_s_getreg((3 << 11) | 20) & 0xFu; }
#define XB_SPIN(cond, bar) do { unsigned _sp = 0; while (cond) { __builtin_amdgcn_s_sleep(1); \
    if ((++_sp & 255u) == 0u) { if (xb_ld(&(bar)[XB_TMO])) break; if (_sp > XB_SPIN_CAP) { atomicAdd(&(bar)[XB_TMO], 1u); break; } } } } while (0)
struct XcdBarrier { unsigned* bar; unsigned x; volatile LAS unsigned* st; };
__device__ __forceinline__ XcdBarrier xcd_barrier_post(unsigned* bar, volatile LAS unsigned* st) {
    XcdBarrier b; b.bar = bar; b.x = xb_xcc_id(); b.st = st;
    if (threadIdx.x == 0) (void)xb_add(&bar[XB_XCNT(b.x)], 1u);
    return b;
}
__device__ __forceinline__ void xcd_barrier_complete(unsigned* bar, unsigned x, unsigned& nloc, unsigned& nx) {
    const unsigned G = gridDim.x * gridDim.y * gridDim.z;
    unsigned sum, cnt, mine, sp = 0u;
    for (;;) {
        sum = 0u; cnt = 0u; mine = 0u;
#pragma unroll
        for (unsigned j = 0; j < 16; ++j) { const unsigned c = xb_ld(&bar[XB_XCNT(j)]); sum += c; cnt += (c > 0u) ? 1u : 0u; mine = (j == x) ? c : mine; }
        if (sum == G) break;
        __builtin_amdgcn_s_sleep(1);
        if ((++sp & 255u) == 0u) { if (xb_ld(&bar[XB_TMO])) break; if (sp > XB_SPIN_CAP) { atomicAdd(&bar[XB_TMO], 1u); break; } }
    }
    nloc = mine > 0u ? mine : 1u; nx = cnt > 0u ? cnt : 1u;
}
__device__ __forceinline__ void xcd_barrier(const XcdBarrier& b) {
    asm volatile("s_waitcnt vmcnt(0)" ::: "memory");
    __syncthreads();
    if (threadIdx.x == 0) {
        unsigned* bar = b.bar;
        __builtin_amdgcn_s_waitcnt(0);
        unsigned nloc = b.st[0], nx = b.st[1];
        if (nloc == 0u) { xcd_barrier_complete(bar, b.x, nloc, nx); b.st[0] = nloc; b.st[1] = nx; }
        const unsigned old = xb_add(&bar[XB_XSUB(b.x)], 1u);
        const unsigned gen = old / nloc;
        if (old + 1u == (gen + 1u) * nloc) {
            __builtin_amdgcn_fence(__ATOMIC_RELEASE, "agent");
            asm volatile("s_waitcnt vmcnt(0)" ::: "memory");
            const unsigned og = xb_add(&bar[XB_TOP], 1u);
            const unsigned tg = og / nx;
            if (og + 1u == (tg + 1u) * nx) xb_add(&bar[XB_TOPGEN], 1u);
            else XB_SPIN(xb_ld(&bar[XB_TOPGEN]) == tg, bar);
            __builtin_amdgcn_fence(__ATOMIC_ACQUIRE, "agent");
            xb_add(&bar[XB_XGEN(b.x)], 1u);
            asm volatile("s_waitcnt vmcnt(0)" ::: "memory");
        } else {
            XB_SPIN(xb_ld(&bar[XB_XGEN(b.x)]) == gen, bar);
            __builtin_amdgcn_fence(__ATOMIC_ACQUIRE, "agent");
            asm volatile("s_waitcnt vmcnt(0)" ::: "memory");
        }
    }
    __syncthreads();
}

__global__ void __launch_bounds__(512) fwd_megakernel(Params P_arg) {
    const Params& P = P_arg;
    extern __shared__ __attribute__((aligned(16))) unsigned char shm[];
    LAS unsigned char* lds = (LAS unsigned char*)shm;
    cg::grid_group grid = cg::this_grid();
    const int G = gridDim.x, bid = blockIdx.x;
    __shared__ uint4 xb_words;
    if (threadIdx.x == 0) xb_words = make_uint4(0u, 0u, 0u, 0u);
    __syncthreads();
    const XcdBarrier xb = xcd_barrier_post((unsigned*)(P.ws + O_BAR), (volatile LAS unsigned*)&xb_words);
#define WSP() const Params P = load_params(); unsigned char* ws = ls(P.ws); bf16_t* WinT = (bf16_t*)(ws + O_WINT); bf16_t* WoutT = (bf16_t*)(ws + O_WOUTT); bf16_t* HMIX = (bf16_t*)(ws + O_HMIX); bf16_t* PROJ = (bf16_t*)(ws + O_PROJ); (void)WinT; (void)WoutT; (void)HMIX; (void)PROJ

    phase0a(P, lds, G);
    grid.sync();
    {
        WSP();
        SchedFold S; S.G = G; S.c = bid;
        EpiFold E; E.WinT = WinT;
        Gemm g; g.A = (const bf16_t*)(ws + O_MTF); g.Bt = (const bf16_t*)(ws + O_WCX); g.K = 512;
        pg8::gemm_phase(lds, g, S, E);
        const float* modp = (const float*)(ws + O_MODP); float* mod = (float*)(ws + O_MOD);
        for (int e = bid * 512 + threadIdx.x; e < DEPTH * 3 * 1536; e += G * 512) {
            const int n4 = (e % 1536) * 4, lr = e / 1536, l = lr / 3, r = lr % 3;
            f32x4 a = *(const f32x4*)(P.b_mod + (size_t)l * 6144 + n4);
            for (int s = 0; s < 32; ++s) a += *(const f32x4*)(modp + ((size_t)(l * 32 + s) * 3 + r) * 6144 + n4);
            *(f32x4*)(mod + (size_t)lr * 6144 + n4) = a;
        }
    }
    xcd_barrier(xb);
#pragma unroll 1
    for (int layer = 0; layer < DEPTH; ++layer) {
        const bool lastl = layer == DEPTH - 1;
        row_phase(P, layer, G);
        xcd_barrier(xb);
        {
            WSP();
            SchedIn S; S.init(66, 22, G, bid);
            EpiIn E; E.PROJ = PROJ; E.avT = (bf16_t*)(ws + O_AVT); E.VT = (bf16_t*)(ws + O_VT); E.VTc = (bf16_t*)(ws + O_VTC); E.ZT = (bf16_t*)(ws + O_ZT); E.ZTc = (bf16_t*)(ws + O_ZTC); E.rope = (const float2*)(ws + O_ROPE);
            Gemm g; g.A = HMIX; g.Bt = WinT + (size_t)layer * NCOL * DM; g.K = DM;
            pg8::gemm_phase(lds, g, S, E);
        }
        xcd_barrier(xb);
        {
            WSP();
            for (int task = bid; task < 512; task += G) attn_task(P, layer, task, lds);
            {   SchedFew S; S.n = 256; S.G = G; S.c = bid;
                EpiS1 E; E.Bint = (bf16_t*)(ws + O_BINT);
                Gemm g; g.A = (const bf16_t*)(ws + O_F128); g.Bt = (const bf16_t*)(ws + O_ZT); g.K = 256;
                pg8::gemm_phase(lds, g, S, E); }
            const int nch = lastl ? 128 : 132;
            for (int ch = bid; ch < nch; ch += G) gmlp_task(P, layer, ch, lds);
            if (!lastl) {
                const int c2 = (bid - 132 + G) % G;
                for (int t = c2; t < 16; t += G) attn_task(P, layer, 512 + t, lds);
                __syncthreads();
                SchedFew S; S.n = 4; S.G = G; S.c = (bid - 148 + G) % G;
                EpiCtxF E; E.MIX = HMIX; E.PROJ = PROJ; E.bf = P.b_f + (size_t)layer * 512;
                Gemm g; g.A = (const bf16_t*)(ws + O_DCTX); g.Bt = (const bf16_t*)(ws + O_ZTC); g.K = 512;
                pg8::gemm_phase(lds, g, S, E);
            }
        }
        xcd_barrier(xb);
        stage2_phase(P, layer, G);
        if (!lastl) for (int tile = bid; tile < 256; tile += G) ctx_outproj_tile(P, layer, tile, lds);
        xcd_barrier(xb);
        {
            WSP();
            pg8::StaticOrder S; S.init(64, 8, G, bid);
            EpiOut E; E.Y = PROJ;
            Gemm g; g.A = HMIX; g.Bt = WoutT + (size_t)layer * DM * DM; g.K = DM;
            pg8::gemm_phase(lds, g, S, E);
        }
        xcd_barrier(xb);
    }
    row_phase(P, DEPTH, G);
}

extern "C" void kernel_launch(void* const* d_in, const int* in_sizes, int n_in, void* d_out, int out_size, void* d_ws, size_t ws_size, hipStream_t stream) {
    constexpr size_t kDynLds = LDS_TOTAL;
    static int grid_blocks = 0;
    if (!grid_blocks) {
        if (ws_size < WS_END) { fprintf(stderr, "kernel_launch: workspace too small: %zu < %zu\n", ws_size, (size_t)WS_END); grid_blocks = -1; return; }
        int dev = 0, cus = 0, per_cu = 0;
        hipGetDevice(&dev);
        hipDeviceGetAttribute(&cus, hipDeviceAttributeMultiprocessorCount, dev);
        hipFuncSetAttribute((const void*)fwd_megakernel, hipFuncAttributeMaxDynamicSharedMemorySize, (int)kDynLds);
        hipOccupancyMaxActiveBlocksPerMultiprocessor(&per_cu, (const void*)fwd_megakernel, 512, kDynLds);
        if (per_cu < 1) { fprintf(stderr, "kernel_launch: occupancy query says %d blocks/CU\n", per_cu); per_cu = 1; }
        grid_blocks = cus * 1;
    }
    if (grid_blocks < 0) return;
    Params p{};
    p.x = (const float*)d_in[0]; p.c = (const float*)d_in[1]; p.ctx = (const float*)d_in[2]; p.c_ctx = (const float*)d_in[3];
    p.w_mod = (const float*)d_in[4]; p.b_mod = (const float*)d_in[5]; p.g_pre = (const float*)d_in[6]; p.g_post = (const float*)d_in[7];
    p.w_in = (const float*)d_in[8]; p.w_out = (const float*)d_in[9]; p.g_sgu = (const float*)d_in[10]; p.w_sgu = (const float*)d_in[11];
    p.b_sgu = (const float*)d_in[12]; p.sink = (const float*)d_in[13]; p.w_f = (const float*)d_in[14]; p.b_f = (const float*)d_in[15];
    p.out = (float*)d_out; p.ws = (unsigned char*)d_ws;
    (void)hipMemsetAsync((unsigned char*)d_ws + O_BAR, 0, XCD_BAR_WORDS * 4, stream);
    void* args[] = {&p};
    hipError_t e = hipLaunchCooperativeKernel((const void*)fwd_megakernel, dim3(grid_blocks), dim3(512), args, kDynLds, stream);
    if (e != hipSuccess) fprintf(stderr, "cooperative launch failed: %s (grid %d)\n", hipGetErrorString(e), grid_blocks);
}
```

```cpp
#include <hip/hip_runtime.h>
#include <hip/hip_cooperative_groups.h>
#include <cstdio>
#include <cstdint>
namespace cg = cooperative_groups;

#define LAS __attribute__((address_space(3)))
typedef unsigned short bf16_t;
typedef short bf16x8 __attribute__((ext_vector_type(8)));
typedef short bf16x4 __attribute__((ext_vector_type(4)));
typedef float f32x4 __attribute__((ext_vector_type(4)));
typedef unsigned u32x2 __attribute__((ext_vector_type(2)));
typedef unsigned u32x4 __attribute__((ext_vector_type(4)));

constexpr int DM = 2048, SEQ = 8192, NB = 2, DEPTH = 4, CTXL = 256;
constexpr int MLAT = NB * SEQ;
constexpr int MROWS = MLAT + NB * CTXL;
constexpr int NCOL = 5632;
constexpr int C_AU = 0, C_AV = 512, C_AG = 1024, C_Q = 1536, C_K = 2560, C_V = 2816, C_BG = 3072, C_ZR = 4096, C_CG = 5120;
constexpr float EPS = 1e-6f;
constexpr float QSCALE = 0.08838834764831845f * 1.4426950408889634f;
constexpr float LOG2E = 1.4426950408889634f;

constexpr size_t AL(size_t x) { return (x + 255) & ~(size_t)255; }
constexpr size_t O_WINT = 0;
constexpr size_t O_WOUTT = O_WINT + AL((size_t)DEPTH * NCOL * DM * 2);
constexpr size_t O_MOD = O_WOUTT + AL((size_t)DEPTH * DM * DM * 2);
constexpr size_t O_ROPE = O_MOD + AL((size_t)DEPTH * 3 * 6144 * 4);
constexpr size_t O_TWID = O_ROPE + AL((size_t)128 * 32 * 8);
constexpr size_t O_F128 = O_TWID + AL((size_t)8192 * 8);
constexpr size_t O_F64 = O_F128 + AL((size_t)256 * 256 * 2);
constexpr size_t O_DCTX = O_F64 + AL((size_t)64 * 128 * 2);
constexpr size_t O_XC = O_DCTX + AL((size_t)256 * 512 * 2);
constexpr size_t O_HMIX = O_XC + AL((size_t)512 * DM * 4);
constexpr size_t O_PROJ = O_HMIX + AL((size_t)MROWS * DM * 2);
constexpr size_t O_AVT = O_PROJ + AL((size_t)MROWS * NCOL * 2);
constexpr size_t O_VT = O_AVT + AL((size_t)132 * 512 * 128 * 2);
constexpr size_t O_VTC = O_VT + AL((size_t)NB * 2 * 128 * SEQ * 2);
constexpr size_t O_ZT = O_VTC + AL((size_t)NB * 2 * 128 * CTXL * 2);
constexpr size_t O_ZTC = O_ZT + AL((size_t)NB * 512 * 64 * 256 * 2);
constexpr size_t O_BINT = O_ZTC + AL((size_t)NB * 512 * 512 * 2);
constexpr size_t O_YC = O_BINT + AL((size_t)NB * 128 * 512 * 128 * 2);
constexpr size_t O_BAR = O_YC + AL((size_t)512 * DM * 2);
constexpr size_t O_WCX = O_BAR + 16384;
constexpr size_t O_MTF = O_WCX + AL((size_t)DEPTH * DM * 512 * 2);
constexpr size_t O_MODP = O_MTF + AL((size_t)DEPTH * 1024 * 512 * 2);
constexpr size_t O_P0END = O_MODP + AL((size_t)DEPTH * 32 * 3 * 6144 * 4);
constexpr size_t O_XB = O_WCX;
constexpr size_t WS_END = (O_XB + (size_t)MLAT * DM * 2 > O_P0END) ? O_XB + (size_t)MLAT * DM * 2 : O_P0END;

struct Params {
    const float *x, *c, *ctx, *c_ctx, *w_mod, *b_mod, *g_pre, *g_post, *w_in, *w_out, *g_sgu, *w_sgu, *b_sgu, *sink, *w_f, *b_f;
    float* out;
    unsigned char* ws;
};

__device__ __forceinline__ Params load_params() {
#if defined(__HIP_DEVICE_COMPILE__)
    auto p = __builtin_amdgcn_kernarg_segment_ptr(); asm volatile("" : "+s"(p));
    return *(const __attribute__((address_space(4))) Params*)p;
#else
    return Params{};
#endif
}
__device__ __forceinline__ int lv(int x) { asm volatile("" : "+v"(x)); return x; }
template <class T> __device__ __forceinline__ T* ls(T* p) { asm volatile("" : "+s"(p)); return p; }
__device__ __forceinline__ unsigned cvt_pk_bf16(float lo, float hi) { unsigned r; asm volatile("v_cvt_pk_bf16_f32 %0, %1, %2" : "=v"(r) : "v"(lo), "v"(hi)); return r; }
__device__ __forceinline__ bf16_t f2bf(float v) { return (bf16_t)(cvt_pk_bf16(v, 0.f) & 0xffffu); }
__device__ __forceinline__ float bf2f(unsigned b) { return __uint_as_float(b << 16); }
__device__ __forceinline__ float bflo(unsigned w) { return __uint_as_float(w << 16); }
__device__ __forceinline__ float bfhi(unsigned w) { return __uint_as_float(w & 0xffff0000u); }
__device__ __forceinline__ float gelu_t(float x) { const float u2 = x * (x * x * (-2.f * 0.7978845608028654f * 0.044715f * 1.4426950408889634f) + (-2.f * 0.7978845608028654f * 1.4426950408889634f)); return x * __builtin_amdgcn_rcpf(1.f + __builtin_amdgcn_exp2f(u2)); }
__device__ __forceinline__ float silu_f(float x) { return x * __builtin_amdgcn_rcpf(1.f + __builtin_amdgcn_exp2f(x * -1.4426950408889634f)); }
__device__ __forceinline__ float wave_sum(float v) {
#pragma unroll
    for (int o = 1; o < 64; o <<= 1) v += __shfl_xor(v, o);
    return v;
}
__device__ __forceinline__ float xor16_max(float x) { auto r = __builtin_amdgcn_permlane16_swap(__float_as_uint(x), __float_as_uint(x), false, false); return fmaxf(__uint_as_float(r[0]), __uint_as_float(r[1])); }
__device__ __forceinline__ float xor32_max(float x) { auto r = __builtin_amdgcn_permlane32_swap(__float_as_uint(x), __float_as_uint(x), false, false); return fmaxf(__uint_as_float(r[0]), __uint_as_float(r[1])); }
__device__ __forceinline__ float xor16_sum(float x) { auto r = __builtin_amdgcn_permlane16_swap(__float_as_uint(x), __float_as_uint(x), false, false); return __uint_as_float(r[0]) + __uint_as_float(r[1]); }
__device__ __forceinline__ float xor32_sum(float x) { auto r = __builtin_amdgcn_permlane32_swap(__float_as_uint(x), __float_as_uint(x), false, false); return __uint_as_float(r[0]) + __uint_as_float(r[1]); }
__device__ __forceinline__ u32x2 pack4(float a, float b, float c, float d) { u32x2 r; r.x = cvt_pk_bf16(a, b); r.y = cvt_pk_bf16(c, d); return r; }

namespace pg8 {
constexpr int BM = 256, BK = 64, HALF = 128, HTB = HALF * BK * 2, STAGE_BYTES = 8 * HTB, NXCD = 8, WGM = 8;
__host__ __device__ __forceinline__ int lds_byte(int r, int c) { const int st = (r >> 4) * 2 + (c >> 5), rr = r & 15, cc = c & 31, ob = rr * 64 + cc * 2; return st * 1024 + (ob ^ (((ob >> 9) & 1) << 5)); }
__host__ __device__ __forceinline__ void stage_rc(int b, int& R, int& C) { const int st = b / 1024, sb = b % 1024, swz = sb ^ (((sb >> 9) & 1) << 5); R = (st >> 1) * 16 + swz / 64; C = (st & 1) * 32 + (swz % 64) / 2; }
__host__ __device__ __forceinline__ int perm32(int rho) { const int n = rho >> 4, i = rho & 15; return 8 * (i >> 2) + 4 * n + (i & 3); }
struct Unit { int pm, pn; };
struct Gemm { const bf16_t* A; const bf16_t* Bt; int K; };

struct SchedBase {
    __device__ __forceinline__ void amap(const Unit& u, const Gemm& g, const char*& base, unsigned& rs, unsigned& hs) const {
        rs = (unsigned)g.K * 2u; hs = (unsigned)HALF * g.K * 2u; base = (const char*)g.A + (size_t)u.pm * BM * g.K * 2;
    }
    __device__ __forceinline__ void bmap(const Unit& u, const Gemm& g, const char*& base, unsigned& rs, unsigned& hs) const {
        rs = (unsigned)g.K * 2u; hs = (unsigned)HALF * g.K * 2u; base = (const char*)g.Bt + (size_t)u.pn * BM * g.K * 2;
    }
};
struct StaticOrder : SchedBase {
    int nM, nN, nwg, G, c;
    __device__ void init(int nM_, int nN_, int G_, int c_) { nM = nM_; nN = nN_; nwg = nM * nN; G = G_; c = c_; }
    __device__ bool next(int i, Unit& u) const {
        const long L = (long)i * G + c; if (L >= nwg) return false;
        int wgid = (int)L; { const int q = nwg / NXCD, r = nwg % NXCD, xcd = wgid % NXCD, off = wgid / NXCD; wgid = (xcd < r ? xcd * (q + 1) : r * (q + 1) + (xcd - r) * q) + off; }
        const int nig = WGM * nN, gid = wgid / nig, fm = gid * WGM, gsz = (nM - fm) < WGM ? (nM - fm) : WGM;
        u.pm = fm + ((wgid % nig) % gsz); u.pn = (wgid % nig) / gsz; return true;
    }
};

template <class Epi, class Sched>
__device__ __forceinline__ void gemm_phase(LAS unsigned char* lds, const Gemm g, const Sched& S, const Epi& E) {
    const int tid = lv(threadIdx.x), wid = __builtin_amdgcn_readfirstlane(tid >> 6), lane = tid & 63, wr = wid >> 2, wc = wid & 3, fr = lane & 15, fq = lane >> 4;
    int K = g.K; asm volatile("" : "+s"(K));
    const int nt = K / BK;
#define PG8_VOFFB(dst, rs) do { const int _t = lv(tid); _Pragma("unroll") for (int _i = 0; _i < 2; ++_i) { int _R, _C; stage_rc(_t * 16 + _i * 8192, _R, _C); const int _Rb = (_R & ~31) + perm32(_R & 31); dst[_i] = (unsigned)_Rb * (rs) + (unsigned)_C * 2u; } } while (0)
#define PG8_VOFFA(dst, rs) do { const int _t = lv(tid); _Pragma("unroll") for (int _i = 0; _i < 2; ++_i) { int _R, _C; stage_rc(_t * 16 + _i * 8192, _R, _C); dst[_i] = (unsigned)_R * (rs) + (unsigned)_C * 2u; } } while (0)
    const size_t kstep = (size_t)(BK * 2);
    const unsigned ldsw = (unsigned)wid * 1024u;
    const int aoff = lds_byte(wr * 64 + fr, fq * 8), boff = lds_byte(wc * 32 + fr, fq * 8);
#define PG8_SA(b, h) (((b) * 2 + (h)) * HTB)
#define PG8_SB(b, h) ((4 + (b) * 2 + (h)) * HTB)
#define PG8_STAGE(bufoff, gbase, voff) do { _Pragma("unroll") for (int _i = 0; _i < 2; ++_i) \
        __builtin_amdgcn_global_load_lds((const unsigned*)((const char*)(gbase) + (voff)[_i]), (LAS unsigned*)(lds + (bufoff) + ldsw + _i * 8192), 16, 0, 0); } while (0)
#define PG8_LDA(dst, b, h) do { _Pragma("unroll") for (int m = 0; m < 4; ++m) _Pragma("unroll") for (int k = 0; k < 2; ++k) dst[m][k] = *(const LAS bf16x8*)(lds + PG8_SA(b, h) + aoff + m * 2048 + k * 1024); } while (0)
#define PG8_LDB(dst, b, h) do { _Pragma("unroll") for (int n = 0; n < 2; ++n) _Pragma("unroll") for (int k = 0; k < 2; ++k) dst[n][k] = *(const LAS bf16x8*)(lds + PG8_SB(b, h) + boff + n * 2048 + k * 1024); } while (0)
#define PG8_MMA(ai, bj, At, Bt) do { __builtin_amdgcn_s_setprio(1); _Pragma("unroll") for (int m = 0; m < 4; ++m) _Pragma("unroll") for (int n = 0; n < 2; ++n) _Pragma("unroll") for (int k = 0; k < 2; ++k) \
        acc[ai][bj][m][n] = __builtin_amdgcn_mfma_f32_16x16x32_bf16(Bt[n][k], At[m][k], acc[ai][bj][m][n], 0, 0, 0); __builtin_amdgcn_s_setprio(0); } while (0)
#define PG8_WAIT_V(n) asm volatile("s_waitcnt vmcnt(" #n ")" ::: "memory")
#define PG8_WAIT_L(n) asm volatile("s_waitcnt lgkmcnt(" #n ")" ::: "memory")
#define PG8_BAR __builtin_amdgcn_s_barrier()
#define PG8_SCHED __builtin_amdgcn_sched_barrier(0)
    Unit cur, nxt; int ui = 0;
    if (!S.next(0, cur)) return;
    f32x4 acc[2][2][4][2];
#pragma unroll
    for (int a = 0; a < 2; ++a)
#pragma unroll
        for (int b = 0; b < 2; ++b)
#pragma unroll
            for (int m = 0; m < 4; ++m)
#pragma unroll
                for (int n = 0; n < 2; ++n) acc[a][b][m][n] = (f32x4){0.f, 0.f, 0.f, 0.f};
    bf16x8 At[4][2], B0[2][2], B1[2][2];
    const char* cA; unsigned cRS, cHS; S.amap(cur, g, cA, cRS, cHS);
    unsigned vAc[2]; PG8_VOFFA(vAc, cRS);
    const char* cB; unsigned cRSB, cHSB; S.bmap(cur, g, cB, cRSB, cHSB);
    unsigned vBc[2]; PG8_VOFFB(vBc, cRSB);
    PG8_STAGE(PG8_SB(0, 0), cB, vBc); PG8_STAGE(PG8_SA(0, 0), cA, vAc); PG8_STAGE(PG8_SB(0, 1), cB + cHSB, vBc); PG8_STAGE(PG8_SA(0, 1), cA + cHS, vAc);
    if (wr == 1) PG8_BAR;
    PG8_WAIT_V(4); PG8_BAR;
    PG8_STAGE(PG8_SB(1, 0), cB + kstep, vBc); PG8_STAGE(PG8_SA(1, 0), cA + kstep, vAc); PG8_STAGE(PG8_SB(1, 1), cB + cHSB + kstep, vBc);
    PG8_WAIT_V(6); PG8_BAR;
    for (;;) {
        const bool has_next = S.next(ui + 1, nxt);
        const char* nA = cA; unsigned nRS = cRS, nHS = cHS; const char* nB = cB; unsigned nRSB = cRSB, nHSB = cHSB;
        if (has_next) { S.amap(nxt, g, nA, nRS, nHS); S.bmap(nxt, g, nB, nRSB, nHSB); }
        for (int t = 0; t < nt; t += 2) {
            const bool last = (t == nt - 2);
            const char* a1 = cA + (size_t)(t + 1) * kstep;
            const char* a2 = last ? nA : cA + (size_t)(t + 2) * kstep; const char* b2 = last ? nB : cB + (size_t)(t + 2) * kstep;
            const char* a3 = a2 + kstep; const char* b3 = b2 + kstep;
            const unsigned hs2 = last ? nHS : cHS;
            unsigned v2[2] = {vAc[0], vAc[1]}; if (last) PG8_VOFFA(v2, nRS);
            const unsigned hsB2 = last ? nHSB : cHSB;
            unsigned vB2[2] = {vBc[0], vBc[1]}; if (last) PG8_VOFFB(vB2, nRSB);
            PG8_LDB(B0, 0, 0); PG8_SCHED; PG8_LDA(At, 0, 0); PG8_STAGE(PG8_SA(1, 1), a1 + cHS, vAc);
            PG8_WAIT_L(8); PG8_BAR; PG8_WAIT_L(0); PG8_MMA(0, 0, At, B0); PG8_BAR; PG8_SCHED;
            PG8_LDB(B1, 0, 1); PG8_STAGE(PG8_SB(0, 0), b2, vB2);
            PG8_BAR; PG8_WAIT_L(0); PG8_MMA(0, 1, At, B1); PG8_BAR;
            PG8_LDA(At, 0, 1); PG8_STAGE(PG8_SA(0, 0), a2, v2);
            PG8_BAR; PG8_WAIT_L(0); PG8_MMA(1, 0, At, B0); PG8_BAR; PG8_SCHED;
            PG8_STAGE(PG8_SB(0, 1), b2 + hsB2, vB2);
            PG8_WAIT_V(6); PG8_BAR; PG8_MMA(1, 1, At, B1); PG8_BAR;
            PG8_LDB(B0, 1, 0); PG8_SCHED; PG8_LDA(At, 1, 0); PG8_STAGE(PG8_SA(0, 1), a2 + hs2, v2);
            PG8_WAIT_L(8); PG8_BAR; PG8_WAIT_L(0); PG8_MMA(0, 0, At, B0); PG8_BAR; PG8_SCHED;
            PG8_LDB(B1, 1, 1); PG8_STAGE(PG8_SB(1, 0), b3, vB2);
            PG8_BAR; PG8_WAIT_L(0); PG8_MMA(0, 1, At, B1); PG8_BAR;
            PG8_LDA(At, 1, 1); PG8_STAGE(PG8_SA(1, 0), a3, v2);
            PG8_BAR; PG8_WAIT_L(0); PG8_MMA(1, 0, At, B0); PG8_BAR; PG8_SCHED;
            PG8_STAGE(PG8_SB(1, 1), b3 + hsB2, vB2);
            PG8_WAIT_V(6); PG8_BAR; PG8_MMA(1, 1, At, B1); PG8_BAR;
        }
        { const int l2 = lv(threadIdx.x) & 63; E(acc, cur, wr, wc, l2 & 15, l2 >> 4); }
        if (!has_next) break;
#pragma unroll
        for (int a = 0; a < 2; ++a)
#pragma unroll
            for (int b = 0; b < 2; ++b)
#pragma unroll
                for (int m = 0; m < 4; ++m)
#pragma unroll
                    for (int n = 0; n < 2; ++n) acc[a][b][m][n] = (f32x4){0.f, 0.f, 0.f, 0.f};
        cur = nxt; cA = nA; cRS = nRS; cHS = nHS; PG8_VOFFA(vAc, cRS); cB = nB; cRSB = nRSB; cHSB = nHSB; PG8_VOFFB(vBc, cRSB); ++ui;
    }
    PG8_WAIT_V(0);
    if (wr == 0) PG8_BAR;
    PG8_BAR;
#undef PG8_VOFFA
#undef PG8_VOFFB
#undef PG8_SA
#undef PG8_SB
#undef PG8_STAGE
#undef PG8_LDA
#undef PG8_LDB
#undef PG8_MMA
#undef PG8_WAIT_V
#undef PG8_WAIT_L
#undef PG8_BAR
#undef PG8_SCHED
}
}
using pg8::Unit;
using pg8::Gemm;

__device__ __forceinline__ bool in_swapped(int pn) { return pn == 2 || pn == 3 || pn == 11 || (pn >= 16 && pn < 20); }
struct SchedIn : pg8::StaticOrder {
    __device__ __forceinline__ void tokmap(const Unit& u, bool gather, const Gemm& g, const char*& base, unsigned& rs, unsigned& hs) const {
        if (gather && u.pm < 64) { const int b = u.pm >> 5, t20 = 2 * (u.pm & 31); rs = 64u * DM * 2u; hs = DM * 2u; base = (const char*)g.A + ((size_t)b * SEQ + t20) * DM * 2; }
        else { rs = DM * 2u; hs = 128u * DM * 2u; base = (const char*)g.A + (size_t)u.pm * 256 * DM * 2; }
    }
    __device__ __forceinline__ void wmap(const Unit& u, const Gemm& g, const char*& base, unsigned& rs, unsigned& hs) const {
        rs = DM * 2u; hs = 128u * DM * 2u; base = (const char*)g.Bt + (size_t)u.pn * 256 * DM * 2;
    }
    __device__ __forceinline__ void amap(const Unit& u, const Gemm& g, const char*& base, unsigned& rs, unsigned& hs) const {
        if (in_swapped(u.pn)) wmap(u, g, base, rs, hs); else tokmap(u, false, g, base, rs, hs);
    }
    __device__ __forceinline__ void bmap(const Unit& u, const Gemm& g, const char*& base, unsigned& rs, unsigned& hs) const {
        if (in_swapped(u.pn)) tokmap(u, u.pn >= 16, g, base, rs, hs); else wmap(u, g, base, rs, hs);
    }
};
struct SchedFold : pg8::SchedBase {
    int G, c;
    __device__ bool next(int i, Unit& u) const { const int L = i * G + c; if (L >= 128) return false; const int l = L >> 5, r = L & 31; u.pm = l * 4 + (r >> 3); u.pn = l * 8 + (r & 7); return true; }
};
struct SchedFew : pg8::SchedBase {
    int n, G, c;
    __device__ bool next(int i, Unit& u) const { const int L = i * G + c; if (c < 0 || L >= n) return false; u.pm = 0; u.pn = L; return true; }
};

struct EpiIn {
    bf16_t *PROJ, *avT, *VT, *VTc, *ZT, *ZTc; const float2* rope;
    __device__ __forceinline__ void operator()(const f32x4 (&acc)[2][2][4][2], const Unit& u, int wr, int wc, int fr, int fq) const {
        if (in_swapped(u.pn)) {
#pragma unroll
            for (int ai = 0; ai < 2; ++ai) {
                const int nt = 2 * u.pn + ai;
#pragma unroll
                for (int m = 0; m < 4; ++m) {
                    const int ch = wr * 64 + m * 16 + lv(fr);
#pragma unroll
                    for (int bj = 0; bj < 2; ++bj) {
                        const f32x4 v0 = acc[ai][bj][m][0], v1 = acc[ai][bj][m][1];
                        const int tk = 32 * wc + 8 * fq;
                        bf16_t* dst;
                        u32x4 pk;
                        if (nt < 8) {
                            const int chunk = u.pm * 2 + bj;
                            dst = avT + ((size_t)chunk * 512 + (nt - 4) * 128 + ch) * 128 + tk;
                            pk.x = cvt_pk_bf16(gelu_t(v0[0]), gelu_t(v0[1])); pk.y = cvt_pk_bf16(gelu_t(v0[2]), gelu_t(v0[3])); pk.z = cvt_pk_bf16(gelu_t(v1[0]), gelu_t(v1[1])); pk.w = cvt_pk_bf16(gelu_t(v1[2]), gelu_t(v1[3]));
                        } else {
                            pk.x = cvt_pk_bf16(v0[0], v0[1]); pk.y = cvt_pk_bf16(v0[2], v0[3]); pk.z = cvt_pk_bf16(v1[0], v1[1]); pk.w = cvt_pk_bf16(v1[2], v1[3]);
                            if (nt < 24) {
                                const int kvh = nt - 22, row = u.pm * 256 + bj * 128 + tk;
                                if (row < MLAT) dst = VT + ((size_t)((row >> 13) * 2 + kvh) * 128 + ch) * SEQ + (row & 8191);
                                else { const int rc = row - MLAT; dst = VTc + ((size_t)((rc >> 8) * 2 + kvh) * 128 + ch) * CTXL + (rc & 255); }
                            } else {
                                const int ri = (nt - 32) >> 2, j = ((nt - 32) & 3) * 128 + ch;
                                if (u.pm < 64) { const int b = u.pm >> 5, t2 = 2 * (u.pm & 31) + bj; dst = ZT + (((size_t)(b * 512 + j) * 64 + t2) * 256) + ri * 128 + tk; }
                                else { const int rc = (u.pm - 64) * 256 + bj * 128 + tk; dst = ZTc + ((size_t)((rc >> 8) * 512 + j) * 512) + ri * 256 + (rc & 255); }
                            }
                        }
                        *(u32x4*)dst = pk;
                    }
                    asm volatile("" ::: "memory");
                }
            }
            return;
        }
#pragma unroll
        for (int bj = 0; bj < 2; ++bj) {
            const int nt = 2 * u.pn + bj;
            const int colt = nt * 128 + 32 * wc + 8 * fq;
            if (nt < 4 || (nt >= 8 && nt < 12) || (nt >= 24 && nt < 32) || nt >= 40) {
                const bool is_gelu = nt < 4;
#pragma unroll
                for (int ai = 0; ai < 2; ++ai)
#pragma unroll
                    for (int m = 0; m < 4; ++m) {
                        const size_t row = (size_t)u.pm * 256 + ai * 128 + wr * 64 + m * 16 + lv(fr);
                        const f32x4 v0 = acc[ai][bj][m][0], v1 = acc[ai][bj][m][1]; float o[8];
#pragma unroll
                        for (int i = 0; i < 4; ++i) { o[i] = is_gelu ? gelu_t(v0[i]) : silu_f(v0[i]); o[4 + i] = is_gelu ? gelu_t(v1[i]) : silu_f(v1[i]); }
                        u32x4 pk; pk.x = cvt_pk_bf16(o[0], o[1]); pk.y = cvt_pk_bf16(o[2], o[3]); pk.z = cvt_pk_bf16(o[4], o[5]); pk.w = cvt_pk_bf16(o[6], o[7]);
                        *(u32x4*)(PROJ + row * NCOL + colt) = pk;
                        asm volatile("" ::: "memory");
                    }
            } else if (nt < 8) {
#pragma unroll
                for (int ai = 0; ai < 2; ++ai)
#pragma unroll
                    for (int m = 0; m < 4; ++m) {
                        const int row = u.pm * 256 + ai * 128 + wr * 64 + m * 16 + lv(fr);
                        const int chunk = row >> 7, q = row & 127;
#pragma unroll
                        for (int n = 0; n < 2; ++n) {
                            f32x4 v = acc[ai][bj][m][n];
                            const int c0 = (nt - 4) * 128 + 32 * wc + 8 * fq + 4 * n;
#pragma unroll
                            for (int i = 0; i < 4; ++i) avT[((size_t)chunk * 512 + c0 + i) * 128 + q] = f2bf(gelu_t(v[i]));
                            asm volatile("" ::: "memory");
                        }
                    }
            } else if (nt < 22) {
                const bool isq = nt < 20; const float sc = isq ? QSCALE : 1.f;
                const bool lat = u.pm < 64;
                float frev[4];
#pragma unroll
                for (int i = 0; i < 4; ++i) frev[i] = __builtin_amdgcn_exp2f(-(float)((wc & 1) * 16 + fq * 4 + i) * (13.287712379549449f / 32.f)) * 0.15915494309189535f;
#pragma unroll
                for (int ai = 0; ai < 2; ++ai)
#pragma unroll
                    for (int m = 0; m < 4; ++m) {
                        const size_t row = (size_t)u.pm * 256 + ai * 128 + wr * 64 + m * 16 + lv(fr);
                        const int tpos = (int)(row & 8191);
                        const int pos = (wc < 2) ? (tpos >> 6) : (tpos & 63);
                        const f32x4 x0 = acc[ai][bj][m][0], x1 = acc[ai][bj][m][1];
                        float o0[4], o1[4];
                        if (lat) {
#pragma unroll
                            for (int i = 0; i < 4; ++i) { const float rev = (float)pos * frev[i]; const float cx = __builtin_amdgcn_cosf(rev), sx = __builtin_amdgcn_sinf(rev);
                                o0[i] = (x0[i] * cx - x1[i] * sx) * sc; o1[i] = (x1[i] * cx + x0[i] * sx) * sc; }
                        } else {
#pragma unroll
                            for (int i = 0; i < 4; ++i) { o0[i] = x0[i] * sc; o1[i] = x1[i] * sc; }
                        }
                        u32x4 pk; pk.x = cvt_pk_bf16(o0[0], o0[1]); pk.y = cvt_pk_bf16(o0[2], o0[3]); pk.z = cvt_pk_bf16(o1[0], o1[1]); pk.w = cvt_pk_bf16(o1[2], o1[3]);
                        *(u32x4*)(PROJ + row * NCOL + colt) = pk;
                        asm volatile("" ::: "memory");
                    }
            } else if (nt < 24) {
                const int kvh = nt - 22;
#pragma unroll
                for (int ai = 0; ai < 2; ++ai)
#pragma unroll
                    for (int m = 0; m < 4; ++m) {
                        const int row = u.pm * 256 + ai * 128 + wr * 64 + m * 16 + lv(fr);
#pragma unroll
                        for (int n = 0; n < 2; ++n) {
                            f32x4 v = acc[ai][bj][m][n];
                            const int d0 = 32 * wc + 8 * fq + 4 * n;
                            if (row < MLAT) { const int b = row >> 13, t = row & 8191;
#pragma unroll
                                for (int i = 0; i < 4; ++i) VT[((size_t)(b * 2 + kvh) * 128 + d0 + i) * SEQ + t] = f2bf(v[i]);
                            } else { const int rc = row - MLAT, b = rc >> 8, t = rc & 255;
#pragma unroll
                                for (int i = 0; i < 4; ++i) VTc[((size_t)(b * 2 + kvh) * 128 + d0 + i) * CTXL + t] = f2bf(v[i]);
                            }
                            asm volatile("" ::: "memory");
                        }
                    }
            } else {
                const int ri = (nt - 32) >> 2, jt = ((nt - 32) & 3) * 128;
#pragma unroll
                for (int ai = 0; ai < 2; ++ai)
#pragma unroll
                    for (int m = 0; m < 4; ++m) {
                        const int R = wr * 64 + m * 16 + lv(fr);
#pragma unroll
                        for (int n = 0; n < 2; ++n) {
                            f32x4 v = acc[ai][bj][m][n];
                            const int j0 = jt + 32 * wc + 8 * fq + 4 * n;
                            if (u.pm < 64) { const int b = u.pm >> 5, t2 = 2 * (u.pm & 31) + ai;
#pragma unroll
                                for (int i = 0; i < 4; ++i) ZT[(((size_t)(b * 512 + j0 + i) * 64 + t2) * 256) + ri * 128 + R] = f2bf(v[i]);
                            } else { const int rc = (u.pm - 64) * 256 + ai * 128 + R, b = rc >> 8, t = rc & 255;
#pragma unroll
                                for (int i = 0; i < 4; ++i) ZTc[((size_t)(b * 512 + j0 + i) * 512) + ri * 256 + t] = f2bf(v[i]);
                            }
                            asm volatile("" ::: "memory");
                        }
                    }
            }
        }
    }
};
struct EpiOut {
    bf16_t* Y;
    __device__ __forceinline__ void operator()(const f32x4 (&acc)[2][2][4][2], const Unit& u, int wr, int wc, int fr, int fq) const {
#pragma unroll
        for (int ai = 0; ai < 2; ++ai)
#pragma unroll
            for (int m = 0; m < 4; ++m) {
                const size_t row = (size_t)u.pm * 256 + ai * 128 + wr * 64 + m * 16 + fr;
#pragma unroll
                for (int bj = 0; bj < 2; ++bj) { const f32x4 v0 = acc[ai][bj][m][0], v1 = acc[ai][bj][m][1];
                    u32x4 pk; pk.x = cvt_pk_bf16(v0[0], v0[1]); pk.y = cvt_pk_bf16(v0[2], v0[3]); pk.z = cvt_pk_bf16(v1[0], v1[1]); pk.w = cvt_pk_bf16(v1[2], v1[3]);
                    *(u32x4*)(Y + row * DM + u.pn * 256 + bj * 128 + 32 * wc + 8 * fq) = pk; }
            }
    }
};
struct EpiFold {
    bf16_t* WinT;
    __device__ __forceinline__ void operator()(const f32x4 (&acc)[2][2][4][2], const Unit& u, int wr, int wc, int fr, int fq) const {
        const int l = u.pm >> 2;
#pragma unroll
        for (int ai = 0; ai < 2; ++ai)
#pragma unroll
            for (int m = 0; m < 4; ++m) {
                const size_t r = (size_t)(u.pm & 3) * 256 + ai * 128 + wr * 64 + m * 16 + fr;
#pragma unroll
                for (int bj = 0; bj < 2; ++bj) { const f32x4 v0 = acc[ai][bj][m][0], v1 = acc[ai][bj][m][1];
                    u32x4 pk; pk.x = cvt_pk_bf16(v0[0], v0[1]); pk.y = cvt_pk_bf16(v0[2], v0[3]); pk.z = cvt_pk_bf16(v1[0], v1[1]); pk.w = cvt_pk_bf16(v1[2], v1[3]);
                    *(u32x4*)(WinT + ((size_t)l * NCOL + C_ZR + r) * DM + (u.pn & 7) * 256 + bj * 128 + 32 * wc + 8 * fq) = pk; }
            }
    }
};
struct EpiS1 {
    bf16_t* Bint;
    __device__ __forceinline__ void operator()(const f32x4 (&acc)[2][2][4][2], const Unit& u, int wr, int wc, int fr, int fq) const {
#pragma unroll
        for (int m = 0; m < 4; ++m) {
            const int k1 = lv(wr * 64 + m * 16 + fr);
#pragma unroll
            for (int bj = 0; bj < 2; ++bj) {
                const int c = u.pn * 256 + bj * 128 + 32 * wc + 8 * fq;
                const int t2 = c & 63, bjx = c >> 6, b = bjx >> 9, j = bjx & 511;
                float br[8], bi[8];
#pragma unroll
                for (int n = 0; n < 2; ++n) {
                    const f32x4 ar = acc[0][bj][m][n], aim = acc[1][bj][m][n];
#pragma unroll
                    for (int i = 0; i < 4; ++i) { const float rev = (float)(k1 * (t2 + 4 * n + i)) * (1.f / 8192.f); const float cw = __builtin_amdgcn_cosf(rev), sw = __builtin_amdgcn_sinf(rev);
                        br[4 * n + i] = ar[i] * cw - aim[i] * sw; bi[4 * n + i] = ar[i] * sw + aim[i] * cw; }
                }
                const unsigned off = (unsigned)(((b * 128 + k1) * 512 + j) * 128 + t2);
                u32x4 p0, p1; p0.x = cvt_pk_bf16(br[0], br[1]); p0.y = cvt_pk_bf16(br[2], br[3]); p0.z = cvt_pk_bf16(br[4], br[5]); p0.w = cvt_pk_bf16(br[6], br[7]);
                p1.x = cvt_pk_bf16(bi[0], bi[1]); p1.y = cvt_pk_bf16(bi[2], bi[3]); p1.z = cvt_pk_bf16(bi[4], bi[5]); p1.w = cvt_pk_bf16(bi[6], bi[7]);
                *(u32x4*)(Bint + off) = p0; *(u32x4*)(Bint + off + 64) = p1;
            }
            asm volatile("" ::: "memory");
        }
    }
};
struct EpiCtxF {
    bf16_t* MIX; const bf16_t* PROJ; const float* bf;
    __device__ __forceinline__ void operator()(const f32x4 (&acc)[2][2][4][2], const Unit& u, int wr, int wc, int fr, int fq) const {
#pragma unroll
        for (int ai = 0; ai < 2; ++ai) {
            u32x4 gg[4][2];
#pragma unroll
            for (int m = 0; m < 4; ++m)
#pragma unroll
                for (int bj = 0; bj < 2; ++bj) { const int k = ai * 128 + wr * 64 + m * 16 + fr, col = u.pn * 256 + bj * 128 + 32 * wc + 8 * fq, b = col >> 9, j = col & 511;
                    gg[m][bj] = *(const u32x4*)(PROJ + ((size_t)MLAT + b * 256 + k) * NCOL + C_CG + j); }
#pragma unroll
            for (int m = 0; m < 4; ++m)
#pragma unroll
                for (int bj = 0; bj < 2; ++bj) { const int k = ai * 128 + wr * 64 + m * 16 + fr, col = u.pn * 256 + bj * 128 + 32 * wc + 8 * fq, b = col >> 9, j = col & 511;
                    const f32x4 v0 = acc[ai][bj][m][0], v1 = acc[ai][bj][m][1]; const f32x4 b0 = *(const f32x4*)(bf + j), b1 = *(const f32x4*)(bf + j + 4); const u32x4 g2 = gg[m][bj];
                    u32x4 pk; pk.x = cvt_pk_bf16((v0[0] + b0[0]) * bflo(g2.x), (v0[1] + b0[1]) * bfhi(g2.x)); pk.y = cvt_pk_bf16((v0[2] + b0[2]) * bflo(g2.y), (v0[3] + b0[3]) * bfhi(g2.y));
                    pk.z = cvt_pk_bf16((v1[0] + b1[0]) * bflo(g2.z), (v1[1] + b1[1]) * bfhi(g2.z)); pk.w = cvt_pk_bf16((v1[2] + b1[2]) * bflo(g2.w), (v1[3] + b1[3]) * bfhi(g2.w));
                    *(u32x4*)(MIX + ((size_t)MLAT + b * 256 + k) * DM + 1536 + j) = pk; }
            asm volatile("" ::: "memory");
        }
    }
};

__device__ __forceinline__ int qk_dperm(int p) {
    const int wc = p >> 5, fq = (p >> 3) & 3, n = (p >> 2) & 1, i = p & 3;
    return (wc >> 1) * 64 + n * 32 + (wc & 1) * 16 + fq * 4 + i;
}
__device__ __forceinline__ void transpose_blk(const float* src, int sp, int scol0, bf16_t* dst, int k0, int nd0, bool perm, LAS float* scr) {
    const int tid = lv(threadIdx.x);
    f32x4 v[8];
#pragma unroll
    for (int i = 0; i < 8; ++i) { const int k = (tid >> 6) + 8 * i, c4 = (tid & 63) * 4; v[i] = *(const f32x4*)(src + (size_t)(k0 + k) * sp + scol0 + c4); }
#pragma unroll
    for (int i = 0; i < 8; ++i) { const int k = (tid >> 6) + 8 * i, c4 = (tid & 63) * 4; LAS float* s = scr + k * 257 + c4; s[0] = v[i][0]; s[1] = v[i][1]; s[2] = v[i][2]; s[3] = v[i][3]; }
    __syncthreads();
#pragma unroll
    for (int i = 0; i < 4; ++i) { const int n = (tid >> 3) + 64 * i, kc = tid & 7;
      int sc = n;
      if (perm) { const int p = (nd0 + n) & 127; sc = (n & ~63) + (qk_dperm(p) & 63); }
      const LAS float* s = scr + (kc * 8) * 257 + sc;
      u32x4 o; o.x = cvt_pk_bf16(s[0], s[257]); o.y = cvt_pk_bf16(s[2 * 257], s[3 * 257]); o.z = cvt_pk_bf16(s[4 * 257], s[5 * 257]); o.w = cvt_pk_bf16(s[6 * 257], s[7 * 257]);
      *(u32x4*)(dst + (size_t)(nd0 + n) * DM + k0 + kc * 8) = o; }
    __syncthreads();
}

__device__ __forceinline__ void phase0a(const Params& P_unused, LAS unsigned char* lds, int G) {
    const Params P = load_params(); (void)P_unused;
    unsigned char* ws = ls(P.ws);
    bf16_t* WinT = (bf16_t*)(ws + O_WINT); bf16_t* WoutT = (bf16_t*)(ws + O_WOUTT); bf16_t* Wcx = (bf16_t*)(ws + O_WCX); bf16_t* MTf = (bf16_t*)(ws + O_MTF);
    float* modp = (float*)(ws + O_MODP); float2* rope = (float2*)(ws + O_ROPE); float2* twid = (float2*)(ws + O_TWID);
    bf16_t* F128 = (bf16_t*)(ws + O_F128); bf16_t* F64 = (bf16_t*)(ws + O_F64); bf16_t* Dctx = (bf16_t*)(ws + O_DCTX);
    LAS float* scr = (LAS float*)lds;
    const int tid = lv(threadIdx.x), bid = blockIdx.x;
    for (int task = bid; task < 384; task += G) {
        const int l = task / 96, s = (task / 3) & 31, nc = task % 3;
        __syncthreads();
        if (tid < 192) { const int r = tid >> 6, kk = tid & 63; const float v = (r < 2) ? P.c[r * DM + s * 64 + kk] : P.c_ctx[s * 64 + kk]; scr[r * 64 + kk] = silu_f(v); }
        __syncthreads();
        const int n = nc * 2048 + tid * 4;
        f32x4 a0 = {0, 0, 0, 0}, a1 = {0, 0, 0, 0}, a2 = {0, 0, 0, 0};
        const float* wp = P.w_mod + ((size_t)l * DM + s * 64) * 6144 + n;
#pragma unroll 16
        for (int kk = 0; kk < 64; ++kk) { const f32x4 w = *(const f32x4*)(wp + (size_t)kk * 6144); a0 += w * scr[kk]; a1 += w * scr[64 + kk]; a2 += w * scr[128 + kk]; }
        float* op = modp + ((size_t)(l * 32 + s) * 3) * 6144 + n;
        *(f32x4*)(op) = a0; *(f32x4*)(op + 6144) = a1; *(f32x4*)(op + 2 * 6144) = a2;
    }
    __syncthreads();
    for (int task = bid; task < DEPTH * 18 * 32; task += G) {
        const int l = task / (18 * 32), r = task % (18 * 32), nb = r >> 5, kt = r & 31;
        const int nd0 = nb < 16 ? nb * 256 : (5120 + (nb - 16) * 256);
        const int scol0 = nb < 16 ? nd0 : nd0 - 512;
        const bool perm = (nd0 >= C_Q && nd0 < C_V);
        transpose_blk(P.w_in + (size_t)l * DM * 5120, 5120, scol0, WinT + (size_t)l * NCOL * DM, kt * 64, nd0, perm, scr);
    }
    for (int task = bid; task < DEPTH * 8 * 32; task += G) {
        const int l = task >> 8, r = task & 255, nb = r >> 5, kt = r & 31;
        transpose_blk(P.w_out + (size_t)l * DM * DM, DM, nb * 256, WoutT + (size_t)l * DM * DM, kt * 64, nb * 256, false, scr);
    }
    if (tid < 128) { const float a = (float)tid * (1.f / 64.f); scr[tid] = cospif(a); scr[128 + tid] = sinpif(a); }
    __syncthreads();
    const size_t gt = (size_t)bid * 512 + tid, GT = (size_t)G * 512;
    for (size_t e = gt; e < (size_t)DEPTH * DM * 128; e += GT) {
        const size_t lk = e >> 7; const int j4 = (int)(e & 127) * 4;
        const f32x4 v = *(const f32x4*)(P.w_in + lk * 5120 + 4096 + j4);
        *(u32x2*)(Wcx + lk * 512 + j4) = pack4(v[0], v[1], v[2], v[3]);
    }
    for (size_t e = gt; e < (size_t)DEPTH * 1024 * 512; e += GT) {
        const int col = (int)(e & 511), row = (int)((e >> 9) & 1023), l = (int)(e >> 19);
        const int ri = row >> 9, g = (row >> 7) & 3, d = row & 127, g2 = col >> 7, c = col & 127;
        float v = 0.f;
        if (g == g2) {
            const float* wf = P.w_f + ((size_t)(l * 4 + g) * 128) * 128 + d;
            float s = 0.f;
            const LAS float* tb = scr + ri * 128;
#pragma unroll 8
            for (int c2 = 0; c2 < 128; ++c2) s += tb[(c * c2) & 127] * wf[(size_t)c2 * 128];
            v = s * (1.f / 1024.f);
        }
        MTf[e] = f2bf(v);
    }
    for (size_t e = gt; e < 128 * 32; e += GT) { const int pos = (int)(e >> 5), f = (int)(e & 31);
        const float fr = powf(10000.f, -(float)f / 32.f); const float ang = (float)pos * fr; float sn, cs; sincosf(ang, &sn, &cs); rope[e] = make_float2(cs, sn); }
    for (size_t e = gt; e < 8192; e += GT) { const float a = (float)e * (1.f / 4096.f); twid[e] = make_float2(cospif(a), sinpif(a)); }
    for (size_t e = gt; e < 256 * 256; e += GT) { const int n = (int)(e >> 8), kk = (int)(e & 255); const int ro = n >> 7, k1 = n & 127, rin = kk >> 7, t1 = kk & 127;
        const float a = (float)((k1 * t1) & 127) * (1.f / 64.f); const float cs = cospif(a), sn = sinpif(a);
        const float v = ro == 0 ? (rin == 0 ? cs : -sn) : (rin == 0 ? sn : cs); F128[e] = f2bf(v); }
    for (size_t e = gt; e < 64 * 128; e += GT) { const int k2 = (int)(e >> 7), kk = (int)(e & 127); const int rin = kk >> 6, t2 = kk & 63;
        const float a = (float)((k2 * t2) & 63) * (1.f / 32.f); F64[e] = f2bf(rin == 0 ? cospif(a) : -sinpif(a)); }
    for (size_t e = gt; e < 256 * 512; e += GT) { const int k = (int)(e >> 9), kk = (int)(e & 511); const int rin = kk >> 8, t = kk & 255;
        const float a = (float)((k * t) & 255) * (1.f / 128.f); Dctx[e] = f2bf((rin == 0 ? cospif(a) : -sinpif(a)) * 5.656854249492381f); }
}

__device__ __forceinline__ void row_phase(const Params& P_unused, int layer, int G) {
    const Params P = load_params(); (void)P_unused;
    unsigned char* ws = ls(P.ws);
    const float* mod = (const float*)(ws + O_MOD);
    float* XC = (float*)(ws + O_XC);
    bf16_t* XB = (bf16_t*)(ws + O_XB);
    bf16_t* H = (bf16_t*)(ws + O_HMIX);
    const bf16_t* Y = (const bf16_t*)(ws + O_PROJ); const bf16_t* Yc = (const bf16_t*)(ws + O_YC);
    const int tid = lv(threadIdx.x);
    const int lane = tid & 63, gw = blockIdx.x * 8 + (tid >> 6), NGW = G * 8;
    const int nrows = layer == DEPTH ? MLAT : MROWS;
    const bool xb_src = layer >= 2;
    const float* xctx = layer <= 1 ? P.ctx : XC;
    f32x4 vn[8]; u32x2 yn[8], xn[8];
#define ROW_LOAD(r) do { const int _r = (r); \
        if (_r < MLAT && xb_src) { _Pragma("unroll") for (int j = 0; j < 8; ++j) xn[j] = *(const u32x2*)(XB + (size_t)_r * DM + lane * 4 + 256 * j); } \
        else { const float* _x = _r < MLAT ? P.x + (size_t)_r * DM : xctx + (size_t)(_r - MLAT) * DM; _Pragma("unroll") for (int j = 0; j < 8; ++j) vn[j] = *(const f32x4*)(_x + lane * 4 + 256 * j); } \
        if (layer >= 1) { const bf16_t* _y = _r < MLAT ? Y + (size_t)_r * DM : Yc + (size_t)(_r - MLAT) * DM; _Pragma("unroll") for (int j = 0; j < 8; ++j) yn[j] = *(const u32x2*)(_y + lane * 4 + 256 * j); } } while (0)
    if (gw < nrows) ROW_LOAD(gw);
    for (int row = gw; row < nrows; row += NGW) {
        const bool lat = row < MLAT; const int mr = lat ? (row >> 13) : 2;
        f32x4 v[8]; u32x2 yw[8];
        if (lat && xb_src) {
#pragma unroll
            for (int j = 0; j < 8; ++j) v[j] = (f32x4){bflo(xn[j].x), bfhi(xn[j].x), bflo(xn[j].y), bfhi(xn[j].y)};
        } else {
#pragma unroll
            for (int j = 0; j < 8; ++j) v[j] = vn[j];
        }
#pragma unroll
        for (int j = 0; j < 8; ++j) yw[j] = yn[j];
        const int nr = row + NGW;
        if (nr < nrows) ROW_LOAD(nr);
        if (layer >= 1) {
            const float* mg = mod + ((size_t)(layer - 1) * 3 + mr) * 6144 + 4096;
            const float* gp = P.g_post + (size_t)(layer - 1) * DM;
            f32x4 y[8]; float ss = 0.f;
#pragma unroll
            for (int j = 0; j < 8; ++j) { const u32x2 w = yw[j];
                y[j] = (f32x4){bflo(w.x), bfhi(w.x), bflo(w.y), bfhi(w.y)}; ss += y[j][0] * y[j][0] + y[j][1] * y[j][1] + y[j][2] * y[j][2] + y[j][3] * y[j][3]; }
            const float rinv = rsqrtf(wave_sum(ss) * (1.f / DM) + EPS);
#pragma unroll
            for (int j = 0; j < 8; ++j) { const f32x4 g4 = *(const f32x4*)(mg + lane * 4 + 256 * j), p4 = *(const f32x4*)(gp + lane * 4 + 256 * j);
                v[j] = v[j] + g4 * (y[j] * rinv * p4); }
            if (!lat) {
#pragma unroll
                for (int j = 0; j < 8; ++j) *(f32x4*)(XC + (size_t)(row - MLAT) * DM + lane * 4 + 256 * j) = v[j];
            } else if (layer == DEPTH) {
#pragma unroll
                for (int j = 0; j < 8; ++j) *(f32x4*)(P.out + (size_t)row * DM + lane * 4 + 256 * j) = v[j];
            } else {
#pragma unroll
                for (int j = 0; j < 8; ++j) *(u32x2*)(XB + (size_t)row * DM + lane * 4 + 256 * j) = pack4(v[j][0], v[j][1], v[j][2], v[j][3]);
            }
        }
        if (layer < DEPTH) {
            float ss = 0.f;
#pragma unroll
            for (int j = 0; j < 8; ++j) ss += v[j][0] * v[j][0] + v[j][1] * v[j][1] + v[j][2] * v[j][2] + v[j][3] * v[j][3];
            const float rinv = rsqrtf(wave_sum(ss) * (1.f / DM) + EPS);
            const float* msh = mod + ((size_t)layer * 3 + mr) * 6144; const float* msc = msh + 2048;
            const float* gp = P.g_pre + (size_t)layer * DM;
#pragma unroll
            for (int j = 0; j < 8; ++j) { const f32x4 sh = *(const f32x4*)(msh + lane * 4 + 256 * j), sc = *(const f32x4*)(msc + lane * 4 + 256 * j), g4 = *(const f32x4*)(gp + lane * 4 + 256 * j);
                const f32x4 h = (v[j] * rinv * g4) * (sc + 1.f) + sh;
                *(u32x2*)(H + (size_t)row * DM + lane * 4 + 256 * j) = pack4(h[0], h[1], h[2], h[3]); }
        }
    }
#undef ROW_LOAD
}

__device__ __forceinline__ void attn_task(const Params& P_unused, int layer, int task, LAS unsigned char* lds) {
    const Params P = load_params(); (void)P_unused;
    unsigned char* ws = ls(P.ws);
    const bf16_t* PROJ = (const bf16_t*)(ws + O_PROJ);
    const bf16_t* VT = (const bf16_t*)(ws + O_VT); const bf16_t* VTc = (const bf16_t*)(ws + O_VTC);
    bf16_t* MIX = (bf16_t*)(ws + O_HMIX);
    const int tid = lv(threadIdx.x);
    const int lane = tid & 63, w = __builtin_amdgcn_readfirstlane(tid >> 6), fr = lane & 15, fq = lane >> 4;
    int b, blk, kvh, pair; bool isctx;
    if (task < 512) { isctx = false; b = task >> 8; const int rem = task & 255; blk = rem >> 2; kvh = (rem >> 1) & 1; pair = rem & 1; }
    else { isctx = true; const int t = task - 512; b = t >> 3; blk = (t >> 2) & 1; kvh = (t >> 1) & 1; pair = t & 1; }
    const int head = kvh * 4 + pair * 2 + (w >> 2);
    const int a0 = (w & 3) * 32;
    const size_t qrow0 = (isctx ? (size_t)MLAT + b * CTXL : (size_t)b * SEQ) + blk * 128 + a0;
    bf16x8 qf[2][4];
#pragma unroll
    for (int u = 0; u < 2; ++u)
#pragma unroll
        for (int c = 0; c < 4; ++c) qf[u][c] = *(const bf16x8*)(PROJ + (qrow0 + u * 16 + fr) * NCOL + C_Q + head * 128 + c * 32 + fq * 8);
    u32x2 gws[2][8];
#pragma unroll
    for (int u = 0; u < 2; ++u)
#pragma unroll
        for (int dt = 0; dt < 8; ++dt) gws[u][dt] = *(const u32x2*)(PROJ + (qrow0 + u * 16 + fr) * NCOL + C_BG + head * 128 + dt * 16 + 4 * fq);
    float mrun[2], lrun[2];
    const float sk = P.sink[layer * 8 + head] * LOG2E;
    mrun[0] = mrun[1] = sk; lrun[0] = lrun[1] = 1.f;
    f32x4 o[8][2];
#pragma unroll
    for (int dt = 0; dt < 8; ++dt) { o[dt][0] = (f32x4){0, 0, 0, 0}; o[dt][1] = (f32x4){0, 0, 0, 0}; }
    const int nprev = (!isctx && blk > 0) ? 4 : 0, nnext = (!isctx && blk < 63) ? 4 : 0;
    const int T = isctx ? 8 : 12 + nprev + nnext;
    const int lkey = tid >> 4, lkc = (tid & 15) ^ (((lkey >> 3) << 2) | (lkey & 3));
    const unsigned koff = (unsigned)(lkey * NCOL + lkc * 8) * 2u;
    const int ld = tid >> 2, lvc = (tid & 3) ^ ((ld >> 2) & 3);
    const unsigned voff_c = (unsigned)(ld * CTXL + lvc * 8) * 2u, voff_s = (unsigned)(ld * SEQ + lvc * 8) * 2u;
    const char* kctx = (const char*)(PROJ + ((size_t)MLAT + b * CTXL) * NCOL + C_K + kvh * 128);
    const char* klat = (const char*)(PROJ + ((size_t)b * SEQ) * NCOL + C_K + kvh * 128);
    const char* vctx = (const char*)(VTc + (size_t)(b * 2 + kvh) * 128 * CTXL);
    const char* vlat = (const char*)(VT + (size_t)(b * 2 + kvh) * 128 * SEQ);
#define ATT_ISSUE(tt) do { int _t = (tt) < T ? (tt) : T - 1; const char* _kp; const char* _vp; unsigned _vo; \
        if (_t < 8) { _kp = kctx + (size_t)(_t * 32) * NCOL * 2; _vp = vctx + _t * 64; _vo = voff_c; } \
        else { const int _r = _t - 8, _seg = _r < nprev ? 0 : (_r < nprev + 4 ? 1 : 2), _st = _seg == 0 ? _r : (_seg == 1 ? _r - nprev : _r - nprev - 4); \
               const int _kb = (blk - 1 + _seg) * 128 + _st * 32; _kp = klat + (size_t)_kb * NCOL * 2; _vp = vlat + _kb * 2; _vo = voff_s; } \
        LAS unsigned char* _dst = lds + ((tt) & 7) * 16384 + w * 1024; \
        __builtin_amdgcn_global_load_lds((const unsigned*)(_kp + koff), (LAS unsigned*)(_dst), 16, 0, 0); \
        __builtin_amdgcn_global_load_lds((const unsigned*)(_vp + _vo), (LAS unsigned*)(_dst + 8192), 16, 0, 0); } while (0)
    ATT_ISSUE(0); ATT_ISSUE(1); ATT_ISSUE(2); ATT_ISSUE(3); ATT_ISSUE(4); ATT_ISSUE(5);
    const int kfo = (8 * (fr >> 2) + (fr & 3)) * 256, vfo = fr * 64 + ((fq ^ ((fr >> 2) & 3)) * 16);
    int kofs[4];
#pragma unroll
    for (int c = 0; c < 4; ++c) kofs[c] = kfo + (((c * 4 + fq) ^ fr) * 16);
    const f32x4 zero4 = {0.f, 0.f, 0.f, 0.f};
    for (int tp = 0; tp < T; tp += 2) {
        asm volatile("s_waitcnt vmcnt(8) lgkmcnt(0)" ::: "memory");
        __builtin_amdgcn_s_barrier();
        asm volatile("" ::: "memory");
        ATT_ISSUE(tp + 6); ATT_ISSUE(tp + 7);
        int mtype = 0, st = 0;
        if (tp >= 8) { const int r = tp - 8; if (r < nprev) { mtype = 1; st = r; } else if (r >= nprev + 4) { mtype = 2; st = r - nprev - 4; } }
        const int k0 = st * 32;
        if (mtype == 1 && k0 + 63 < a0) continue;
        if (mtype == 2 && k0 > a0 + 31) continue;
        f32x4 s[2][2][2];
#pragma unroll
        for (int tl = 0; tl < 2; ++tl) {
            const LAS unsigned char* kb = lds + ((tp + tl) & 7) * 16384;
#pragma unroll
            for (int v = 0; v < 2; ++v)
#pragma unroll
                for (int c = 0; c < 4; ++c) {
                    const bf16x8 ka = *(const LAS bf16x8*)(kb + kofs[c] + v * 1024);
                    s[0][tl][v] = __builtin_amdgcn_mfma_f32_16x16x32_bf16(ka, qf[0][c], c == 0 ? zero4 : s[0][tl][v], 0, 0, 0);
                    s[1][tl][v] = __builtin_amdgcn_mfma_f32_16x16x32_bf16(ka, qf[1][c], c == 0 ? zero4 : s[1][tl][v], 0, 0, 0);
                }
        }
        bf16x8 pb[2][2];
#pragma unroll
        for (int u = 0; u < 2; ++u) {
            if (mtype == 1) {
                asm volatile("" ::: "memory");
                const int a = a0 + u * 16 + fr - k0 - 8 * fq;
#pragma unroll
                for (int tl = 0; tl < 2; ++tl)
#pragma unroll
                    for (int v = 0; v < 2; ++v)
#pragma unroll
                        for (int r = 0; r < 4; ++r) { if (32 * tl + 4 * v + r < a) s[u][tl][v][r] = -1e30f; }
            } else if (mtype == 2) {
                asm volatile("" ::: "memory");
                const int a = a0 + u * 16 + fr - k0 - 8 * fq;
#pragma unroll
                for (int tl = 0; tl < 2; ++tl)
#pragma unroll
                    for (int v = 0; v < 2; ++v)
#pragma unroll
                        for (int r = 0; r < 4; ++r) { if (32 * tl + 4 * v + r > a) s[u][tl][v][r] = -1e30f; }
            }
            float mx = -3e38f;
#pragma unroll
            for (int tl = 0; tl < 2; ++tl)
#pragma unroll
                for (int v = 0; v < 2; ++v) mx = fmaxf(mx, fmaxf(fmaxf(s[u][tl][v][0], s[u][tl][v][1]), fmaxf(s[u][tl][v][2], s[u][tl][v][3])));
            mx = xor16_max(mx); mx = xor32_max(mx);
            const float mn = fmaxf(mrun[u], mx);
            const float alpha = __builtin_amdgcn_exp2f(mrun[u] - mn);
            float p[16]; float ps = 0.f;
#pragma unroll
            for (int tl = 0; tl < 2; ++tl)
#pragma unroll
                for (int v = 0; v < 2; ++v)
#pragma unroll
                    for (int r = 0; r < 4; ++r) { const float e = __builtin_amdgcn_exp2f(s[u][tl][v][r] - mn); p[tl * 8 + v * 4 + r] = e; ps += e; }
            ps = xor16_sum(ps); ps = xor32_sum(ps);
            lrun[u] = lrun[u] * alpha + ps;
            if (__any(mn > mrun[u])) {
#pragma unroll
                for (int dt = 0; dt < 8; ++dt) o[dt][u] = o[dt][u] * alpha;
            }
            mrun[u] = mn;
#pragma unroll
            for (int tl = 0; tl < 2; ++tl) {
                u32x4 pk; pk.x = cvt_pk_bf16(p[tl * 8 + 0], p[tl * 8 + 1]); pk.y = cvt_pk_bf16(p[tl * 8 + 2], p[tl * 8 + 3]); pk.z = cvt_pk_bf16(p[tl * 8 + 4], p[tl * 8 + 5]); pk.w = cvt_pk_bf16(p[tl * 8 + 6], p[tl * 8 + 7]);
                pb[u][tl] = __builtin_bit_cast(bf16x8, pk);
            }
        }
#pragma unroll
        for (int tl = 0; tl < 2; ++tl) {
            const LAS unsigned char* vb = lds + ((tp + tl) & 7) * 16384 + 8192;
#pragma unroll
            for (int dt = 0; dt < 8; ++dt) {
                const bf16x8 va = *(const LAS bf16x8*)(vb + dt * 1024 + vfo);
                o[dt][0] = __builtin_amdgcn_mfma_f32_16x16x32_bf16(va, pb[0][tl], o[dt][0], 0, 0, 0);
                o[dt][1] = __builtin_amdgcn_mfma_f32_16x16x32_bf16(va, pb[1][tl], o[dt][1], 0, 0, 0);
            }
        }
    }
    asm volatile("s_waitcnt vmcnt(0) lgkmcnt(0)" ::: "memory");
    __builtin_amdgcn_s_barrier();
    asm volatile("" ::: "memory");
#undef ATT_ISSUE
#pragma unroll
    for (int u = 0; u < 2; ++u) {
        const float inv = 1.f / lrun[u];
        const size_t row = qrow0 + u * 16 + fr;
#pragma unroll
        for (int dt = 0; dt < 8; ++dt) {
            const int d0 = head * 128 + dt * 16 + 4 * fq;
            const u32x2 gw = gws[u][dt];
            const f32x4 ov = o[dt][u] * inv;
            *(u32x2*)(MIX + row * DM + 512 + d0) = pack4(ov[0] * bflo(gw.x), ov[1] * bfhi(gw.x), ov[2] * bflo(gw.y), ov[3] * bfhi(gw.y));
        }
    }
}

constexpr int GM_PART = 131072, GM_RQ = GM_PART + 32 * 128 * 4, LDS_TOTAL = GM_RQ + 512;
__device__ __forceinline__ void gmlp_task(const Params& P_unused, int layer, int chunk, LAS unsigned char* lds) {
    const Params P = load_params(); (void)P_unused;
    unsigned char* ws = ls(P.ws);
    const bf16_t* PROJ = (const bf16_t*)(ws + O_PROJ); const bf16_t* avT = (const bf16_t*)(ws + O_AVT) + (size_t)chunk * 512 * 128;
    bf16_t* MIX = (bf16_t*)(ws + O_HMIX);
    LAS float* part = (LAS float*)(lds + GM_PART);
    LAS float* rq = (LAS float*)(lds + GM_RQ);
    const int tid = lv(threadIdx.x), lane = tid & 63, w = __builtin_amdgcn_readfirstlane(tid >> 6), fr = lane & 15, fq = lane >> 4;
    __syncthreads();
    const int myc = (tid & 15) ^ ((tid >> 4) & 15);
    { const char* src = (const char*)avT + (size_t)(tid >> 4) * 256 + myc * 16;
#pragma unroll
      for (int i = 0; i < 16; ++i) __builtin_amdgcn_global_load_lds((const unsigned*)(src + (size_t)i * 32 * 256), (LAS unsigned*)(lds + i * 8192 + w * 1024), 16, 0, 0); }
    const int p = 16 * w + fr; const size_t row = (size_t)chunk * 128 + p;
    f32x4 wsn[8]; u32x2 uun[8], ggn[8];
#define GM_LOAD(h) do { const float* _wsr = P.w_sgu + (((size_t)layer * 4 + (h)) * 128 + p) * 128; \
        _Pragma("unroll") for (int c = 0; c < 4; ++c) { wsn[2 * c] = *(const f32x4*)(_wsr + c * 32 + 8 * fq); wsn[2 * c + 1] = *(const f32x4*)(_wsr + c * 32 + 8 * fq + 4); } \
        _Pragma("unroll") for (int dt = 0; dt < 8; ++dt) { const int _col = (h) * 128 + dt * 16 + 4 * fq; uun[dt] = *(const u32x2*)(PROJ + row * NCOL + C_AU + _col); ggn[dt] = *(const u32x2*)(PROJ + row * NCOL + C_AG + _col); } } while (0)
    GM_LOAD(0);
    asm volatile("s_waitcnt vmcnt(0)" ::: "memory");
    __builtin_amdgcn_s_barrier();
    asm volatile("" ::: "memory");
    { float s8[8] = {0, 0, 0, 0, 0, 0, 0, 0};
#pragma unroll
      for (int i = 0; i < 16; ++i) { const u32x4 v = *(const LAS u32x4*)(lds + i * 8192 + tid * 16);
          float f; f = bflo(v.x); s8[0] += f * f; f = bfhi(v.x); s8[1] += f * f; f = bflo(v.y); s8[2] += f * f; f = bfhi(v.y); s8[3] += f * f;
          f = bflo(v.z); s8[4] += f * f; f = bfhi(v.z); s8[5] += f * f; f = bflo(v.w); s8[6] += f * f; f = bfhi(v.w); s8[7] += f * f; }
#pragma unroll
      for (int e = 0; e < 8; ++e) part[(tid >> 4) * 128 + myc * 8 + e] = s8[e]; }
    __syncthreads();
    if (tid < 128) { float s = 0.f; for (int i = 0; i < 32; ++i) s += part[i * 128 + tid]; rq[tid] = rsqrtf(s * (1.f / 512.f) + EPS); }
    __syncthreads();
    for (int h = 0; h < 4; ++h) {
        f32x4 wsc[8]; u32x2 uu[8], gg[8];
#pragma unroll
        for (int i = 0; i < 8; ++i) { wsc[i] = wsn[i]; uu[i] = uun[i]; gg[i] = ggn[i]; }
        if (h < 3) GM_LOAD(h + 1);
        bf16x8 bfr[4];
#pragma unroll
        for (int c = 0; c < 4; ++c) { const int q0 = c * 32 + 8 * fq; const f32x4 w0 = wsc[2 * c], w1 = wsc[2 * c + 1];
            u32x4 pk; pk.x = cvt_pk_bf16(w0[0] * rq[q0], w0[1] * rq[q0 + 1]); pk.y = cvt_pk_bf16(w0[2] * rq[q0 + 2], w0[3] * rq[q0 + 3]);
            pk.z = cvt_pk_bf16(w1[0] * rq[q0 + 4], w1[1] * rq[q0 + 5]); pk.w = cvt_pk_bf16(w1[2] * rq[q0 + 6], w1[3] * rq[q0 + 7]); bfr[c] = __builtin_bit_cast(bf16x8, pk); }
        f32x4 acc[8];
#pragma unroll
        for (int dt = 0; dt < 8; ++dt) { acc[dt] = (f32x4){0, 0, 0, 0};
#pragma unroll
            for (int c = 0; c < 4; ++c) { const bf16x8 a = *(const LAS bf16x8*)(lds + (h * 128 + dt * 16 + fr) * 256 + (((c * 4 + fq) ^ fr) * 16));
                acc[dt] = __builtin_amdgcn_mfma_f32_16x16x32_bf16(a, bfr[c], acc[dt], 0, 0, 0); } }
        const float bs = P.b_sgu[((size_t)layer * 4 + h) * 128 + p];
#pragma unroll
        for (int dt = 0; dt < 8; ++dt) { const int col = h * 128 + dt * 16 + 4 * fq;
            const f32x4 g4 = *(const f32x4*)(P.g_sgu + (size_t)layer * 512 + col);
            const u32x2 u2 = uu[dt], g2 = gg[dt];
            const float y0 = bflo(u2.x) * (acc[dt][0] * g4[0] + bs) * bflo(g2.x), y1 = bfhi(u2.x) * (acc[dt][1] * g4[1] + bs) * bfhi(g2.x);
            const float y2 = bflo(u2.y) * (acc[dt][2] * g4[2] + bs) * bflo(g2.y), y3 = bfhi(u2.y) * (acc[dt][3] * g4[3] + bs) * bfhi(g2.y);
            *(u32x2*)(MIX + row * DM + col) = pack4(y0, y1, y2, y3); }
    }
#undef GM_LOAD
    __syncthreads();
}

__device__ __forceinline__ void stage2_phase(const Params& P_unused, int layer, int G) {
    const Params P = load_params(); (void)P_unused;
    unsigned char* ws = ls(P.ws);
    const bf16_t* Bint = (const bf16_t*)(ws + O_BINT); const bf16_t* F64 = (const bf16_t*)(ws + O_F64); const bf16_t* PROJ = (const bf16_t*)(ws + O_PROJ);
    bf16_t* MIX = (bf16_t*)(ws + O_HMIX);
    const int tid = lv(threadIdx.x);
    const int lane = tid & 63, w = __builtin_amdgcn_readfirstlane(tid >> 6), fr = lane & 15, fq = lane >> 4;
    bf16x8 ff[4][4];
#pragma unroll
    for (int nt = 0; nt < 4; ++nt)
#pragma unroll
        for (int c = 0; c < 4; ++c) ff[nt][c] = *(const bf16x8*)(F64 + (size_t)(nt * 16 + fr) * 128 + c * 32 + fq * 8);
    for (int task = blockIdx.x; task < 256; task += G) {
        const int b = task >> 7, k1 = task & 127;
        bf16x8 af[4][4]; u32x2 gg[4][4]; f32x4 bias[4];
#pragma unroll
        for (int mi = 0; mi < 4; ++mi) {
            const int j0 = (w * 4 + mi) * 16, jc = j0 + 4 * fq;
#pragma unroll
            for (int c = 0; c < 4; ++c) af[mi][c] = *(const bf16x8*)(Bint + (((size_t)(b * 128 + k1) * 512 + j0 + fr) * 128) + c * 32 + fq * 8);
            bias[mi] = *(const f32x4*)(P.b_f + (size_t)layer * 512 + jc);
#pragma unroll
            for (int nt = 0; nt < 4; ++nt) gg[mi][nt] = *(const u32x2*)(PROJ + ((size_t)b * SEQ + k1 + 128 * (nt * 16 + fr)) * NCOL + C_CG + jc);
        }
#pragma unroll
        for (int mi = 0; mi < 4; ++mi) {
            const int jc = (w * 4 + mi) * 16 + 4 * fq;
#pragma unroll
            for (int nt = 0; nt < 4; ++nt) {
                f32x4 acc = {0, 0, 0, 0};
#pragma unroll
                for (int c = 0; c < 4; ++c) acc = __builtin_amdgcn_mfma_f32_16x16x32_bf16(af[mi][c], ff[nt][c], acc, 0, 0, 0);
                const int k2 = nt * 16 + fr; const size_t row = (size_t)b * SEQ + k1 + 128 * k2;
                const u32x2 g2 = gg[mi][nt];
                *(u32x2*)(MIX + row * DM + 1536 + jc) = pack4((acc[0] + bias[mi][0]) * bflo(g2.x), (acc[1] + bias[mi][1]) * bfhi(g2.x), (acc[2] + bias[mi][2]) * bflo(g2.y), (acc[3] + bias[mi][3]) * bfhi(g2.y));
            }
        }
    }
}

__device__ __forceinline__ void ctx_outproj_tile(const Params& P_unused, int layer, int tile, LAS unsigned char* lds) {
    const Params P = load_params(); (void)P_unused;
    unsigned char* ws = ls(P.ws);
    const bf16_t* A = (const bf16_t*)(ws + O_HMIX) + (size_t)MLAT * DM;
    const bf16_t* Bt = (const bf16_t*)(ws + O_WOUTT) + (size_t)layer * DM * DM;
    bf16_t* Yc = (bf16_t*)(ws + O_YC);
    const int tid = lv(threadIdx.x);
    const int lane = tid & 63, w = __builtin_amdgcn_readfirstlane(tid >> 6), fr = lane & 15, fq = lane >> 4;
    const int m0 = (tile >> 5) * 64, n0 = (tile & 31) * 64;
    f32x4 acc[4][4];
#pragma unroll
    for (int i = 0; i < 4; ++i)
#pragma unroll
        for (int j = 0; j < 4; ++j) acc[i][j] = (f32x4){0, 0, 0, 0};
    const bf16_t* ap = A + (size_t)(m0 + fr) * DM + w * 256 + fq * 8;
    const bf16_t* bp = Bt + (size_t)(n0 + fr) * DM + w * 256 + fq * 8;
#pragma unroll 4
    for (int ks = 0; ks < 8; ++ks) {
        bf16x8 af[4], bv[4];
#pragma unroll
        for (int i = 0; i < 4; ++i) { af[i] = *(const bf16x8*)(ap + (size_t)i * 16 * DM + ks * 32); bv[i] = *(const bf16x8*)(bp + (size_t)i * 16 * DM + ks * 32); }
#pragma unroll
        for (int i = 0; i < 4; ++i)
#pragma unroll
            for (int j = 0; j < 4; ++j) acc[i][j] = __builtin_amdgcn_mfma_f32_16x16x32_bf16(af[i], bv[j], acc[i][j], 0, 0, 0);
    }
    __syncthreads();
    LAS float* red = (LAS float*)lds + w * 4096;
#pragma unroll
    for (int i = 0; i < 4; ++i)
#pragma unroll
        for (int j = 0; j < 4; ++j)
#pragma unroll
            for (int r = 0; r < 4; ++r) red[(i * 16 + 4 * fq + r) * 64 + j * 16 + fr] = acc[i][j][r];
    __syncthreads();
    { const int e0 = tid * 8, row = e0 >> 6, col = e0 & 63;
      f32x4 s0 = {0, 0, 0, 0}, s1 = {0, 0, 0, 0};
#pragma unroll
      for (int wv = 0; wv < 8; ++wv) { const LAS f32x4* p = (const LAS f32x4*)((LAS float*)lds + wv * 4096 + e0); s0 += p[0]; s1 += p[1]; }
      u32x4 o; o.x = cvt_pk_bf16(s0[0], s0[1]); o.y = cvt_pk_bf16(s0[2], s0[3]); o.z = cvt_pk_bf16(s1[0], s1[1]); o.w = cvt_pk_bf16(s1[2], s1[3]);
      *(u32x4*)(Yc + (size_t)(m0 + row) * DM + n0 + col) = o; }
    __syncthreads();
}

#define XB_TMO      128
#define XB_XCNT(j)  (256  + 64 * (j))
#define XB_XSUB(j)  (1280 + 64 * (j))
#define XB_XGEN(j)  (2304 + 64 * (j))
#define XB_TOP      3328
#define XB_TOPGEN   3392
#define XCD_BAR_WORDS 3456
#define XB_SPIN_CAP (1u << 18)
__device__ __forceinline__ unsigned xb_ld(unsigned* p)              { return __hip_atomic_load(p, __ATOMIC_RELAXED, __HIP_MEMORY_SCOPE_AGENT); }
__device__ __forceinline__ unsigned xb_add(unsigned* p, unsigned v) { return __hip_atomic_fetch_add(p, v, __ATOMIC_RELAXED, __HIP_MEMORY_SCOPE_AGENT); }
__device__ __forceinline__ unsigned xb_xcc_id() { return (unsigned)__builtin_amdgcn_s_getreg((3 << 11) | 20) & 0xFu; }
#define XB_SPIN(cond, bar) do { unsigned _sp = 0; while (cond) { __builtin_amdgcn_s_sleep(1); \
    if ((++_sp & 255u) == 0u) { if (xb_ld(&(bar)[XB_TMO])) break; if (_sp > XB_SPIN_CAP) { atomicAdd(&(bar)[XB_TMO], 1u); break; } } } } while (0)
struct XcdBarrier { unsigned* bar; unsigned x; volatile LAS unsigned* st; };
__device__ __forceinline__ XcdBarrier xcd_barrier_post(unsigned* bar, volatile LAS unsigned* st) {
    XcdBarrier b; b.bar = bar; b.x = xb_xcc_id(); b.st = st;
    if (threadIdx.x == 0) (void)xb_add(&bar[XB_XCNT(b.x)], 1u);
    return b;
}
__device__ __forceinline__ void xcd_barrier_complete(unsigned* bar, unsigned x, unsigned& nloc, unsigned& nx) {
    const unsigned G = gridDim.x * gridDim.y * gridDim.z;
    unsigned sum, cnt, mine, sp = 0u;
    for (;;) {
        sum = 0u; cnt = 0u; mine = 0u;
#pragma unroll
        for (unsigned j = 0; j < 16; ++j) { const unsigned c = xb_ld(&bar[XB_XCNT(j)]); sum += c; cnt += (c > 0u) ? 1u : 0u; mine = (j == x) ? c : mine; }
        if (sum == G) break;
        __builtin_amdgcn_s_sleep(1);
        if ((++sp & 255u) == 0u) { if (xb_ld(&bar[XB_TMO])) break; if (sp > XB_SPIN_CAP) { atomicAdd(&bar[XB_TMO], 1u); break; } }
    }
    nloc = mine > 0u ? mine : 1u; nx = cnt > 0u ? cnt : 1u;
}
__device__ __forceinline__ void xcd_barrier(const XcdBarrier& b) {
    asm volatile("s_waitcnt vmcnt(0)" ::: "memory");
    __syncthreads();
    if (threadIdx.x == 0) {
        unsigned* bar = b.bar;
        __builtin_amdgcn_s_waitcnt(0);
        unsigned nloc = b.st[0], nx = b.st[1];
        if (nloc == 0u) { xcd_barrier_complete(bar, b.x, nloc, nx); b.st[0] = nloc; b.st[1] = nx; }
        const unsigned old = xb_add(&bar[XB_XSUB(b.x)], 1u);
        const unsigned gen = old / nloc;
        if (old + 1u == (gen + 1u) * nloc) {
            __builtin_amdgcn_fence(__ATOMIC_RELEASE, "agent");
            asm volatile("s_waitcnt vmcnt(0)" ::: "memory");
            const unsigned og = xb_add(&bar[XB_TOP], 1u);
            const unsigned tg = og / nx;
            if (og + 1u == (tg + 1u) * nx) xb_add(&bar[XB_TOPGEN], 1u);
            else XB_SPIN(xb_ld(&bar[XB_TOPGEN]) == tg, bar);
            __builtin_amdgcn_fence(__ATOMIC_ACQUIRE, "agent");
            xb_add(&bar[XB_XGEN(b.x)], 1u);
            asm volatile("s_waitcnt vmcnt(0)" ::: "memory");
        } else {
            XB_SPIN(xb_ld(&bar[XB_XGEN(b.x)]) == gen, bar);
            __builtin_amdgcn_fence(__ATOMIC_ACQUIRE, "agent");
            asm volatile("s_waitcnt vmcnt(0)" ::: "memory");
        }
    }
    __syncthreads();
}

__global__ void __launch_bounds__(512) fwd_megakernel(Params P_arg) {
    const Params& P = P_arg;
    extern __shared__ __attribute__((aligned(16))) unsigned char shm[];
    LAS unsigned char* lds = (LAS unsigned char*)shm;
    cg::grid_group grid = cg::this_grid();
    const int G = gridDim.x, bid = blockIdx.x;
    __shared__ uint4 xb_words;
    if (threadIdx.x == 0) xb_words = make_uint4(0u, 0u, 0u, 0u);
    __syncthreads();
    const XcdBarrier xb = xcd_barrier_post((unsigned*)(P.ws + O_BAR), (volatile LAS unsigned*)&xb_words);
#define WSP() const Params P = load_params(); unsigned char* ws = ls(P.ws); bf16_t* WinT = (bf16_t*)(ws + O_WINT); bf16_t* WoutT = (bf16_t*)(ws + O_WOUTT); bf16_t* HMIX = (bf16_t*)(ws + O_HMIX); bf16_t* PROJ = (bf16_t*)(ws + O_PROJ); (void)WinT; (void)WoutT; (void)HMIX; (void)PROJ

    phase0a(P, lds, G);
    grid.sync();
    {
        WSP();
        SchedFold S; S.G = G; S.c = bid;
        EpiFold E; E.WinT = WinT;
        Gemm g; g.A = (const bf16_t*)(ws + O_MTF); g.Bt = (const bf16_t*)(ws + O_WCX); g.K = 512;
        pg8::gemm_phase(lds, g, S, E);
        const float* modp = (const float*)(ws + O_MODP); float* mod = (float*)(ws + O_MOD);
        for (int e = bid * 512 + threadIdx.x; e < DEPTH * 3 * 1536; e += G * 512) {
            const int n4 = (e % 1536) * 4, lr = e / 1536, l = lr / 3, r = lr % 3;
            f32x4 a = *(const f32x4*)(P.b_mod + (size_t)l * 6144 + n4);
            for (int s = 0; s < 32; ++s) a += *(const f32x4*)(modp + ((size_t)(l * 32 + s) * 3 + r) * 6144 + n4);
            *(f32x4*)(mod + (size_t)lr * 6144 + n4) = a;
        }
    }
    xcd_barrier(xb);
#pragma unroll 1
    for (int layer = 0; layer < DEPTH; ++layer) {
        const bool lastl = layer == DEPTH - 1;
        row_phase(P, layer, G);
        xcd_barrier(xb);
        {
            WSP();
            SchedIn S; S.init(66, 22, G, bid);
            EpiIn E; E.PROJ = PROJ; E.avT = (bf16_t*)(ws + O_AVT); E.VT = (bf16_t*)(ws + O_VT); E.VTc = (bf16_t*)(ws + O_VTC); E.ZT = (bf16_t*)(ws + O_ZT); E.ZTc = (bf16_t*)(ws + O_ZTC); E.rope = (const float2*)(ws + O_ROPE);
            Gemm g; g.A = HMIX; g.Bt = WinT + (size_t)layer * NCOL * DM; g.K = DM;
            pg8::gemm_phase(lds, g, S, E);
        }
        xcd_barrier(xb);
        {
            WSP();
            for (int task = bid; task < 512; task += G) attn_task(P, layer, task, lds);
            {   SchedFew S; S.n = 256; S.G = G; S.c = bid;
                EpiS1 E; E.Bint = (bf16_t*)(ws + O_BINT);
                Gemm g; g.A = (const bf16_t*)(ws + O_F128); g.Bt = (const bf16_t*)(ws + O_ZT); g.K = 256;
                pg8::gemm_phase(lds, g, S, E); }
            const int nch = lastl ? 128 : 132;
            for (int ch = bid; ch < nch; ch += G) gmlp_task(P, layer, ch, lds);
            if (!lastl) {
                const int c2 = (bid - 132 + G) % G;
                for (int t = c2; t < 16; t += G) attn_task(P, layer, 512 + t, lds);
                __syncthreads();
                SchedFew S; S.n = 4; S.G = G; S.c = (bid - 148 + G) % G;
                EpiCtxF E; E.MIX = HMIX; E.PROJ = PROJ; E.bf = P.b_f + (size_t)layer * 512;
                Gemm g; g.A = (const bf16_t*)(ws + O_DCTX); g.Bt = (const bf16_t*)(ws + O_ZTC); g.K = 512;
                pg8::gemm_phase(lds, g, S, E);
            }
        }
        xcd_barrier(xb);
        stage2_phase(P, layer, G);
        if (!lastl) for (int tile = bid; tile < 256; tile += G) ctx_outproj_tile(P, layer, tile, lds);
        xcd_barrier(xb);
        {
            WSP();
            pg8::StaticOrder S; S.init(64, 8, G, bid);
            EpiOut E; E.Y = PROJ;
            Gemm g; g.A = HMIX; g.Bt = WoutT + (size_t)layer * DM * DM; g.K = DM;
            pg8::gemm_phase(lds, g, S, E);
        }
        xcd_barrier(xb);
    }
    row_phase(P, DEPTH, G);
}

extern "C" void kernel_launch(void* const* d_in, const int* in_sizes, int n_in, void* d_out, int out_size, void* d_ws, size_t ws_size, hipStream_t stream) {
    constexpr size_t kDynLds = LDS_TOTAL;
    static int grid_blocks = 0;
    if (!grid_blocks) {
        if (ws_size < WS_END) { fprintf(stderr, "kernel_launch: workspace too small: %zu < %zu\n", ws_size, (size_t)WS_END); grid_blocks = -1; return; }
        int dev = 0, cus = 0, per_cu = 0;
        hipGetDevice(&dev);
        hipDeviceGetAttribute(&cus, hipDeviceAttributeMultiprocessorCount, dev);
        hipFuncSetAttribute((const void*)fwd_megakernel, hipFuncAttributeMaxDynamicSharedMemorySize, (int)kDynLds);
        hipOccupancyMaxActiveBlocksPerMultiprocessor(&per_cu, (const void*)fwd_megakernel, 512, kDynLds);
        if (per_cu < 1) { fprintf(stderr, "kernel_launch: occupancy query says %d blocks/CU\n", per_cu); per_cu = 1; }
        grid_blocks = cus * 1;
    }
    if (grid_blocks < 0) return;
    Params p{};
    p.x = (const float*)d_in[0]; p.c = (const float*)d_in[1]; p.ctx = (const float*)d_in[2]; p.c_ctx = (const float*)d_in[3];
    p.w_mod = (const float*)d_in[4]; p.b_mod = (const float*)d_in[5]; p.g_pre = (const float*)d_in[6]; p.g_post = (const float*)d_in[7];
    p.w_in = (const float*)d_in[8]; p.w_out = (const float*)d_in[9]; p.g_sgu = (const float*)d_in[10]; p.w_sgu = (const float*)d_in[11];
    p.b_sgu = (const float*)d_in[12]; p.sink = (const float*)d_in[13]; p.w_f = (const float*)d_in[14]; p.b_f = (const float*)d_in[15];
    p.out = (float*)d_out; p.ws = (unsigned char*)d_ws;
    (void)hipMemsetAsync((unsigned char*)d_ws + O_BAR, 0, XCD_BAR_WORDS * 4, stream);
    void* args[] = {&p};
    hipError_t e = hipLaunchCooperativeKernel((const void*)fwd_megakernel, dim3(grid_blocks), dim3(512), args, kDynLds, stream);
    if (e != hipSuccess) fprintf(stderr, "cooperative launch failed: %s (grid %d)\n", hipGetErrorString(e), grid_blocks);
}
```

```cpp
#include <hip/hip_runtime.h>
#include <hip/hip_cooperative_groups.h>
#include <cstdio>
#include <cstdint>
namespace cg = cooperative_groups;

#define LAS __attribute__((address_space(3)))
typedef unsigned short bf16_t;
typedef short bf16x8 __attribute__((ext_vector_type(8)));
typedef short bf16x4 __attribute__((ext_vector_type(4)));
typedef float f32x4 __attribute__((ext_vector_type(4)));
typedef unsigned u32x2 __attribute__((ext_vector_type(2)));
typedef unsigned u32x4 __attribute__((ext_vector_type(4)));

constexpr int DM = 2048, SEQ = 8192, NB = 2, DEPTH = 4, CTXL = 256;
constexpr int MLAT = NB * SEQ;
constexpr int MROWS = MLAT + NB * CTXL;
constexpr int NCOL = 5632;
constexpr int C_AU = 0, C_AV = 512, C_AG = 1024, C_Q = 1536, C_K = 2560, C_V = 2816, C_BG = 3072, C_ZR = 4096, C_CG = 5120;
constexpr float EPS = 1e-6f;
constexpr float QSCALE = 0.08838834764831845f * 1.4426950408889634f;
constexpr float LOG2E = 1.4426950408889634f;

constexpr size_t AL(size_t x) { return (x + 255) & ~(size_t)255; }
constexpr size_t O_WINT = 0;
constexpr size_t O_WOUTT = O_WINT + AL((size_t)DEPTH * NCOL * DM * 2);
constexpr size_t O_MOD = O_WOUTT + AL((size_t)DEPTH * DM * DM * 2);
constexpr size_t O_ROPE = O_MOD + AL((size_t)DEPTH * 3 * 6144 * 4);
constexpr size_t O_TWID = O_ROPE + AL((size_t)128 * 32 * 8);
constexpr size_t O_F128 = O_TWID + AL((size_t)8192 * 8);
constexpr size_t O_F64 = O_F128 + AL((size_t)256 * 256 * 2);
constexpr size_t O_DCTX = O_F64 + AL((size_t)64 * 128 * 2);
constexpr size_t O_XC = O_DCTX + AL((size_t)256 * 512 * 2);
constexpr size_t O_HMIX = O_XC + AL((size_t)512 * DM * 4);
constexpr size_t O_PROJ = O_HMIX + AL((size_t)MROWS * DM * 2);
constexpr size_t O_AVT = O_PROJ + AL((size_t)MROWS * NCOL * 2);
constexpr size_t O_VT = O_AVT + AL((size_t)132 * 512 * 128 * 2);
constexpr size_t O_VTC = O_VT + AL((size_t)NB * 2 * 128 * SEQ * 2);
constexpr size_t O_ZT = O_VTC + AL((size_t)NB * 2 * 128 * CTXL * 2);
constexpr size_t O_ZTC = O_ZT + AL((size_t)NB * 512 * 64 * 256 * 2);
constexpr size_t O_BINT = O_ZTC + AL((size_t)NB * 512 * 512 * 2);
constexpr size_t O_YC = O_BINT + AL((size_t)NB * 128 * 512 * 128 * 2);
constexpr size_t O_BAR = O_YC + AL((size_t)512 * DM * 2);
constexpr size_t O_WCX = O_BAR + 16384;
constexpr size_t O_MTF = O_WCX + AL((size_t)DEPTH * DM * 512 * 2);
constexpr size_t O_MODP = O_MTF + AL((size_t)DEPTH * 1024 * 512 * 2);
constexpr size_t O_P0END = O_MODP + AL((size_t)DEPTH * 32 * 3 * 6144 * 4);
constexpr size_t O_XB = O_WCX;
constexpr size_t WS_END = (O_XB + (size_t)MLAT * DM * 2 > O_P0END) ? O_XB + (size_t)MLAT * DM * 2 : O_P0END;

struct Params {
    const float *x, *c, *ctx, *c_ctx, *w_mod, *b_mod, *g_pre, *g_post, *w_in, *w_out, *g_sgu, *w_sgu, *b_sgu, *sink, *w_f, *b_f;
    float* out;
    unsigned char* ws;
};

__device__ __forceinline__ Params load_params() {
#if defined(__HIP_DEVICE_COMPILE__)
    auto p = __builtin_amdgcn_kernarg_segment_ptr(); asm volatile("" : "+s"(p));
    return *(const __attribute__((address_space(4))) Params*)p;
#else
    return Params{};
#endif
}
__device__ __forceinline__ int lv(int x) { asm volatile("" : "+v"(x)); return x; }
template <class T> __device__ __forceinline__ T* ls(T* p) { asm volatile("" : "+s"(p)); return p; }
__device__ __forceinline__ unsigned cvt_pk_bf16(float lo, float hi) { unsigned r; asm volatile("v_cvt_pk_bf16_f32 %0, %1, %2" : "=v"(r) : "v"(lo), "v"(hi)); return r; }
__device__ __forceinline__ bf16_t f2bf(float v) { return (bf16_t)(cvt_pk_bf16(v, 0.f) & 0xffffu); }
__device__ __forceinline__ float bf2f(unsigned b) { return __uint_as_float(b << 16); }
__device__ __forceinline__ float bflo(unsigned w) { return __uint_as_float(w << 16); }
__device__ __forceinline__ float bfhi(unsigned w) { return __uint_as_float(w & 0xffff0000u); }
__device__ __forceinline__ float gelu_t(float x) { const float u2 = x * (x * x * (-2.f * 0.7978845608028654f * 0.044715f * 1.4426950408889634f) + (-2.f * 0.7978845608028654f * 1.4426950408889634f)); return x * __builtin_amdgcn_rcpf(1.f + __builtin_amdgcn_exp2f(u2)); }
__device__ __forceinline__ float silu_f(float x) { return x * __builtin_amdgcn_rcpf(1.f + __builtin_amdgcn_exp2f(x * -1.4426950408889634f)); }
__device__ __forceinline__ float wave_sum(float v) {
#pragma unroll
    for (int o = 1; o < 64; o <<= 1) v += __shfl_xor(v, o);
    return v;
}
__device__ __forceinline__ float xor16_max(float x) { auto r = __builtin_amdgcn_permlane16_swap(__float_as_uint(x), __float_as_uint(x), false, false); return fmaxf(__uint_as_float(r[0]), __uint_as_float(r[1])); }
__device__ __forceinline__ float xor32_max(float x) { auto r = __builtin_amdgcn_permlane32_swap(__float_as_uint(x), __float_as_uint(x), false, false); return fmaxf(__uint_as_float(r[0]), __uint_as_float(r[1])); }
__device__ __forceinline__ float xor16_sum(float x) { auto r = __builtin_amdgcn_permlane16_swap(__float_as_uint(x), __float_as_uint(x), false, false); return __uint_as_float(r[0]) + __uint_as_float(r[1]); }
__device__ __forceinline__ float xor32_sum(float x) { auto r = __builtin_amdgcn_permlane32_swap(__float_as_uint(x), __float_as_uint(x), false, false); return __uint_as_float(r[0]) + __uint_as_float(r[1]); }
__device__ __forceinline__ u32x2 pack4(float a, float b, float c, float d) { u32x2 r; r.x = cvt_pk_bf16(a, b); r.y = cvt_pk_bf16(c, d); return r; }

namespace pg8 {
constexpr int BM = 256, BK = 64, HALF = 128, HTB = HALF * BK * 2, STAGE_BYTES = 8 * HTB, NXCD = 8, WGM = 8;
__host__ __device__ __forceinline__ int lds_byte(int r, int c) { const int st = (r >> 4) * 2 + (c >> 5), rr = r & 15, cc = c & 31, ob = rr * 64 + cc * 2; return st * 1024 + (ob ^ (((ob >> 9) & 1) << 5)); }
__host__ __device__ __forceinline__ void stage_rc(int b, int& R, int& C) { const int st = b / 1024, sb = b % 1024, swz = sb ^ (((sb >> 9) & 1) << 5); R = (st >> 1) * 16 + swz / 64; C = (st & 1) * 32 + (swz % 64) / 2; }
__host__ __device__ __forceinline__ int perm32(int rho) { const int n = rho >> 4, i = rho & 15; return 8 * (i >> 2) + 4 * n + (i & 3); }
struct Unit { int pm, pn; };
struct Gemm { const bf16_t* A; const bf16_t* Bt; int K; };

struct SchedBase {
    __device__ __forceinline__ void amap(const Unit& u, const Gemm& g, const char*& base, unsigned& rs, unsigned& hs) const {
        rs = (unsigned)g.K * 2u; hs = (unsigned)HALF * g.K * 2u; base = (const char*)g.A + (size_t)u.pm * BM * g.K * 2;
    }
    __device__ __forceinline__ void bmap(const Unit& u, const Gemm& g, const char*& base, unsigned& rs, unsigned& hs) const {
        rs = (unsigned)g.K * 2u; hs = (unsigned)HALF * g.K * 2u; base = (const char*)g.Bt + (size_t)u.pn * BM * g.K * 2;
    }
};
struct StaticOrder : SchedBase {
    int nM, nN, nwg, G, c;
    __device__ void init(int nM_, int nN_, int G_, int c_) { nM = nM_; nN = nN_; nwg = nM * nN; G = G_; c = c_; }
    __device__ bool next(int i, Unit& u) const {
        const long L = (long)i * G + c; if (L >= nwg) return false;
        int wgid = (int)L; { const int q = nwg / NXCD, r = nwg % NXCD, xcd = wgid % NXCD, off = wgid / NXCD; wgid = (xcd < r ? xcd * (q + 1) : r * (q + 1) + (xcd - r) * q) + off; }
        const int nig = WGM * nN, gid = wgid / nig, fm = gid * WGM, gsz = (nM - fm) < WGM ? (nM - fm) : WGM;
        u.pm = fm + ((wgid % nig) % gsz); u.pn = (wgid % nig) / gsz; return true;
    }
};

template <class Epi, class Sched>
__device__ __forceinline__ void gemm_phase(LAS unsigned char* lds, const Gemm g, const Sched& S, const Epi& E) {
    const int tid = lv(threadIdx.x), wid = __builtin_amdgcn_readfirstlane(tid >> 6), lane = tid & 63, wr = wid >> 2, wc = wid & 3, fr = lane & 15, fq = lane >> 4;
    int K = g.K; asm volatile("" : "+s"(K));
    const int nt = K / BK;
#define PG8_VOFFB(dst, rs) do { const int _t = lv(tid); _Pragma("unroll") for (int _i = 0; _i < 2; ++_i) { int _R, _C; stage_rc(_t * 16 + _i * 8192, _R, _C); const int _Rb = (_R & ~31) + perm32(_R & 31); dst[_i] = (unsigned)_Rb * (rs) + (unsigned)_C * 2u; } } while (0)
#define PG8_VOFFA(dst, rs) do { const int _t = lv(tid); _Pragma("unroll") for (int _i = 0; _i < 2; ++_i) { int _R, _C; stage_rc(_t * 16 + _i * 8192, _R, _C); dst[_i] = (unsigned)_R * (rs) + (unsigned)_C * 2u; } } while (0)
    const size_t kstep = (size_t)(BK * 2);
    const unsigned ldsw = (unsigned)wid * 1024u;
    const int aoff = lds_byte(wr * 64 + fr, fq * 8), boff = lds_byte(wc * 32 + fr, fq * 8);
#define PG8_SA(b, h) (((b) * 2 + (h)) * HTB)
#define PG8_SB(b, h) ((4 + (b) * 2 + (h)) * HTB)
#define PG8_STAGE(bufoff, gbase, voff) do { _Pragma("unroll") for (int _i = 0; _i < 2; ++_i) \
        __builtin_amdgcn_global_load_lds((const unsigned*)((const char*)(gbase) + (voff)[_i]), (LAS unsigned*)(lds + (bufoff) + ldsw + _i * 8192), 16, 0, 0); } while (0)
#define PG8_LDA(dst, b, h) do { _Pragma("unroll") for (int m = 0; m < 4; ++m) _Pragma("unroll") for (int k = 0; k < 2; ++k) dst[m][k] = *(const LAS bf16x8*)(lds + PG8_SA(b, h) + aoff + m * 2048 + k * 1024); } while (0)
#define PG8_LDB(dst, b, h) do { _Pragma("unroll") for (int n = 0; n < 2; ++n) _Pragma("unroll") for (int k = 0; k < 2; ++k) dst[n][k] = *(const LAS bf16x8*)(lds + PG8_SB(b, h) + boff + n * 2048 + k * 1024); } while (0)
#define PG8_MMA(ai, bj, At, Bt) do { __builtin_amdgcn_s_setprio(1); _Pragma("unroll") for (int m = 0; m < 4; ++m) _Pragma("unroll") for (int n = 0; n < 2; ++n) _Pragma("unroll") for (int k = 0; k < 2; ++k) \
        acc[ai][bj][m][n] = __builtin_amdgcn_mfma_f32_16x16x32_bf16(Bt[n][k], At[m][k], acc[ai][bj][m][n], 0, 0, 0); __builtin_amdgcn_s_setprio(0); } while (0)
#define PG8_WAIT_V(n) asm volatile("s_waitcnt vmcnt(" #n ")" ::: "memory")
#define PG8_WAIT_L(n) asm volatile("s_waitcnt lgkmcnt(" #n ")" ::: "memory")
#define PG8_BAR __builtin_amdgcn_s_barrier()
#define PG8_SCHED __builtin_amdgcn_sched_barrier(0)
    Unit cur, nxt; int ui = 0;
    if (!S.next(0, cur)) return;
    f32x4 acc[2][2][4][2];
#pragma unroll
    for (int a = 0; a < 2; ++a)
#pragma unroll
        for (int b = 0; b < 2; ++b)
#pragma unroll
            for (int m = 0; m < 4; ++m)
#pragma unroll
                for (int n = 0; n < 2; ++n) acc[a][b][m][n] = (f32x4){0.f, 0.f, 0.f, 0.f};
    bf16x8 At[4][2], B0[2][2], B1[2][2];
    const char* cA; unsigned cRS, cHS; S.amap(cur, g, cA, cRS, cHS);
    unsigned vAc[2]; PG8_VOFFA(vAc, cRS);
    const char* cB; unsigned cRSB, cHSB; S.bmap(cur, g, cB, cRSB, cHSB);
    unsigned vBc[2]; PG8_VOFFB(vBc, cRSB);
    PG8_STAGE(PG8_SB(0, 0), cB, vBc); PG8_STAGE(PG8_SB(0, 1), cB + cHSB, vBc); PG8_STAGE(PG8_SA(0, 0), cA, vAc); PG8_STAGE(PG8_SA(0, 1), cA + cHS, vAc);
    if (wr == 1) PG8_BAR;
    PG8_WAIT_V(2); PG8_BAR;
    PG8_STAGE(PG8_SB(1, 0), cB + kstep, vBc); PG8_STAGE(PG8_SA(1, 0), cA + kstep, vAc); PG8_STAGE(PG8_SB(1, 1), cB + cHSB + kstep, vBc);
    PG8_WAIT_V(6); PG8_BAR;
    for (;;) {
        const bool has_next = S.next(ui + 1, nxt);
        const char* nA = cA; unsigned nRS = cRS, nHS = cHS; const char* nB = cB; unsigned nRSB = cRSB, nHSB = cHSB;
        if (has_next) { S.amap(nxt, g, nA, nRS, nHS); S.bmap(nxt, g, nB, nRSB, nHSB); }
        for (int t = 0; t < nt; t += 2) {
            const bool last = (t == nt - 2);
            const char* a1 = cA + (size_t)(t + 1) * kstep;
            const char* a2 = last ? nA : cA + (size_t)(t + 2) * kstep; const char* b2 = last ? nB : cB + (size_t)(t + 2) * kstep;
            const char* a3 = a2 + kstep; const char* b3 = b2 + kstep;
            const unsigned hs2 = last ? nHS : cHS;
            unsigned v2[2] = {vAc[0], vAc[1]}; if (last) PG8_VOFFA(v2, nRS);
            const unsigned hsB2 = last ? nHSB : cHSB;
            unsigned vB2[2] = {vBc[0], vBc[1]}; if (last) PG8_VOFFB(vB2, nRSB);
            PG8_LDB(B0, 0, 0); PG8_LDB(B1, 0, 1); PG8_SCHED; PG8_LDA(At, 0, 0); PG8_STAGE(PG8_SA(1, 1), a1 + cHS, vAc);
            PG8_WAIT_V(8); PG8_WAIT_L(0); PG8_BAR; PG8_MMA(0, 0, At, B0); PG8_MMA(0, 1, At, B1); PG8_BAR; PG8_SCHED;
            PG8_LDA(At, 0, 1); PG8_STAGE(PG8_SB(0, 0), b2, vB2); PG8_STAGE(PG8_SB(0, 1), b2 + hsB2, vB2); PG8_STAGE(PG8_SA(0, 0), a2, v2);
            PG8_WAIT_V(8); PG8_WAIT_L(0); PG8_BAR; PG8_MMA(1, 0, At, B0); PG8_MMA(1, 1, At, B1); PG8_BAR; PG8_SCHED;
            PG8_LDB(B0, 1, 0); PG8_LDB(B1, 1, 1); PG8_SCHED; PG8_LDA(At, 1, 0); PG8_STAGE(PG8_SA(0, 1), a2 + hs2, v2);
            PG8_WAIT_V(8); PG8_WAIT_L(0); PG8_BAR; PG8_MMA(0, 0, At, B0); PG8_MMA(0, 1, At, B1); PG8_BAR; PG8_SCHED;
            PG8_LDA(At, 1, 1); PG8_STAGE(PG8_SB(1, 0), b3, vB2); PG8_STAGE(PG8_SB(1, 1), b3 + hsB2, vB2); PG8_STAGE(PG8_SA(1, 0), a3, v2);
            PG8_WAIT_V(8); PG8_WAIT_L(0); PG8_BAR; PG8_MMA(1, 0, At, B0); PG8_MMA(1, 1, At, B1); PG8_BAR; PG8_SCHED;
        }
        if (wr == 0) PG8_BAR;
        { const int l2 = lv(threadIdx.x) & 63; E(acc, cur, wr, wc, l2 & 15, l2 >> 4); }
        if (!has_next) break;
#pragma unroll
        for (int a = 0; a < 2; ++a)
#pragma unroll
            for (int b = 0; b < 2; ++b)
#pragma unroll
                for (int m = 0; m < 4; ++m)
#pragma unroll
                    for (int n = 0; n < 2; ++n) acc[a][b][m][n] = (f32x4){0.f, 0.f, 0.f, 0.f};
        cur = nxt; cA = nA; cRS = nRS; cHS = nHS; PG8_VOFFA(vAc, cRS); cB = nB; cRSB = nRSB; cHSB = nHSB; PG8_VOFFB(vBc, cRSB); ++ui;
        if (wr == 1) PG8_BAR;
    }
    PG8_WAIT_V(0);
    PG8_BAR;
#undef PG8_VOFFA
#undef PG8_VOFFB
#undef PG8_SA
#undef PG8_SB
#undef PG8_STAGE
#undef PG8_LDA
#undef PG8_LDB
#undef PG8_MMA
#undef PG8_WAIT_V
#undef PG8_WAIT_L
#undef PG8_BAR
#undef PG8_SCHED
}
}
using pg8::Unit;
using pg8::Gemm;

__device__ __forceinline__ bool in_swapped(int pn) { return pn == 2 || pn == 3 || pn == 11 || (pn >= 16 && pn < 20); }
struct SchedIn : pg8::StaticOrder {
    __device__ __forceinline__ void tokmap(const Unit& u, bool gather, const Gemm& g, const char*& base, unsigned& rs, unsigned& hs) const {
        if (gather && u.pm < 64) { const int b = u.pm >> 5, t20 = 2 * (u.pm & 31); rs = 64u * DM * 2u; hs = DM * 2u; base = (const char*)g.A + ((size_t)b * SEQ + t20) * DM * 2; }
        else { rs = DM * 2u; hs = 128u * DM * 2u; base = (const char*)g.A + (size_t)u.pm * 256 * DM * 2; }
    }
    __device__ __forceinline__ void wmap(const Unit& u, const Gemm& g, const char*& base, unsigned& rs, unsigned& hs) const {
        rs = DM * 2u; hs = 128u * DM * 2u; base = (const char*)g.Bt + (size_t)u.pn * 256 * DM * 2;
    }
    __device__ __forceinline__ void amap(const Unit& u, const Gemm& g, const char*& base, unsigned& rs, unsigned& hs) const {
        if (in_swapped(u.pn)) wmap(u, g, base, rs, hs); else tokmap(u, false, g, base, rs, hs);
    }
    __device__ __forceinline__ void bmap(const Unit& u, const Gemm& g, const char*& base, unsigned& rs, unsigned& hs) const {
        if (in_swapped(u.pn)) tokmap(u, u.pn >= 16, g, base, rs, hs); else wmap(u, g, base, rs, hs);
    }
};
struct SchedFold : pg8::SchedBase {
    int G, c;
    __device__ bool next(int i, Unit& u) const { const int L = i * G + c; if (L >= 128) return false; const int l = L >> 5, r = L & 31; u.pm = l * 4 + (r >> 3); u.pn = l * 8 + (r & 7); return true; }
};
struct SchedFew : pg8::SchedBase {
    int n, G, c;
    __device__ bool next(int i, Unit& u) const { const int L = i * G + c; if (c < 0 || L >= n) return false; u.pm = 0; u.pn = L; return true; }
};

struct EpiIn {
    bf16_t *PROJ, *avT, *VT, *VTc, *ZT, *ZTc; const float2* rope;
    __device__ __forceinline__ void operator()(const f32x4 (&acc)[2][2][4][2], const Unit& u, int wr, int wc, int fr, int fq) const {
        if (in_swapped(u.pn)) {
#pragma unroll
            for (int ai = 0; ai < 2; ++ai) {
                const int nt = 2 * u.pn + ai;
#pragma unroll
                for (int m = 0; m < 4; ++m) {
                    const int ch = wr * 64 + m * 16 + lv(fr);
#pragma unroll
                    for (int bj = 0; bj < 2; ++bj) {
                        const f32x4 v0 = acc[ai][bj][m][0], v1 = acc[ai][bj][m][1];
                        const int tk = 32 * wc + 8 * fq;
                        bf16_t* dst;
                        u32x4 pk;
                        if (nt < 8) {
                            const int chunk = u.pm * 2 + bj;
                            dst = avT + ((size_t)chunk * 512 + (nt - 4) * 128 + ch) * 128 + tk;
                            pk.x = cvt_pk_bf16(gelu_t(v0[0]), gelu_t(v0[1])); pk.y = cvt_pk_bf16(gelu_t(v0[2]), gelu_t(v0[3])); pk.z = cvt_pk_bf16(gelu_t(v1[0]), gelu_t(v1[1])); pk.w = cvt_pk_bf16(gelu_t(v1[2]), gelu_t(v1[3]));
                        } else {
                            pk.x = cvt_pk_bf16(v0[0], v0[1]); pk.y = cvt_pk_bf16(v0[2], v0[3]); pk.z = cvt_pk_bf16(v1[0], v1[1]); pk.w = cvt_pk_bf16(v1[2], v1[3]);
                            if (nt < 24) {
                                const int kvh = nt - 22, row = u.pm * 256 + bj * 128 + tk;
                                if (row < MLAT) dst = VT + ((size_t)((row >> 13) * 2 + kvh) * 128 + ch) * SEQ + (row & 8191);
                                else { const int rc = row - MLAT; dst = VTc + ((size_t)((rc >> 8) * 2 + kvh) * 128 + ch) * CTXL + (rc & 255); }
                            } else {
                                const int ri = (nt - 32) >> 2, j = ((nt - 32) & 3) * 128 + ch;
                                if (u.pm < 64) { const int b = u.pm >> 5, t2 = 2 * (u.pm & 31) + bj; dst = ZT + (((size_t)(b * 512 + j) * 64 + t2) * 256) + ri * 128 + tk; }
                                else { const int rc = (u.pm - 64) * 256 + bj * 128 + tk; dst = ZTc + ((size_t)((rc >> 8) * 512 + j) * 512) + ri * 256 + (rc & 255); }
                            }
                        }
                        *(u32x4*)dst = pk;
                    }
                    asm volatile("" ::: "memory");
                }
            }
            return;
        }
#pragma unroll
        for (int bj = 0; bj < 2; ++bj) {
            const int nt = 2 * u.pn + bj;
            const int colt = nt * 128 + 32 * wc + 8 * fq;
            if (nt < 4 || (nt >= 8 && nt < 12) || (nt >= 24 && nt < 32) || nt >= 40) {
                const bool is_gelu = nt < 4;
#pragma unroll
                for (int ai = 0; ai < 2; ++ai)
#pragma unroll
                    for (int m = 0; m < 4; ++m) {
                        const size_t row = (size_t)u.pm * 256 + ai * 128 + wr * 64 + m * 16 + lv(fr);
                        const f32x4 v0 = acc[ai][bj][m][0], v1 = acc[ai][bj][m][1]; float o[8];
#pragma unroll
                        for (int i = 0; i < 4; ++i) { o[i] = is_gelu ? gelu_t(v0[i]) : silu_f(v0[i]); o[4 + i] = is_gelu ? gelu_t(v1[i]) : silu_f(v1[i]); }
                        u32x4 pk; pk.x = cvt_pk_bf16(o[0], o[1]); pk.y = cvt_pk_bf16(o[2], o[3]); pk.z = cvt_pk_bf16(o[4], o[5]); pk.w = cvt_pk_bf16(o[6], o[7]);
                        *(u32x4*)(PROJ + row * NCOL + colt) = pk;
                        asm volatile("" ::: "memory");
                    }
            } else if (nt < 8) {
#pragma unroll
                for (int ai = 0; ai < 2; ++ai)
#pragma unroll
                    for (int m = 0; m < 4; ++m) {
                        const int row = u.pm * 256 + ai * 128 + wr * 64 + m * 16 + lv(fr);
                        const int chunk = row >> 7, q = row & 127;
#pragma unroll
                        for (int n = 0; n < 2; ++n) {
                            f32x4 v = acc[ai][bj][m][n];
                            const int c0 = (nt - 4) * 128 + 32 * wc + 8 * fq + 4 * n;
#pragma unroll
                            for (int i = 0; i < 4; ++i) avT[((size_t)chunk * 512 + c0 + i) * 128 + q] = f2bf(gelu_t(v[i]));
                            asm volatile("" ::: "memory");
                        }
                    }
            } else if (nt < 22) {
                const bool isq = nt < 20; const float sc = isq ? QSCALE : 1.f;
                const bool lat = u.pm < 64;
                float frev[4];
#pragma unroll
                for (int i = 0; i < 4; ++i) frev[i] = __builtin_amdgcn_exp2f(-(float)((wc & 1) * 16 + fq * 4 + i) * (13.287712379549449f / 32.f)) * 0.15915494309189535f;
#pragma unroll
                for (int ai = 0; ai < 2; ++ai)
#pragma unroll
                    for (int m = 0; m < 4; ++m) {
                        const size_t row = (size_t)u.pm * 256 + ai * 128 + wr * 64 + m * 16 + lv(fr);
                        const int tpos = (int)(row & 8191);
                        const int pos = (wc < 2) ? (tpos >> 6) : (tpos & 63);
                        const f32x4 x0 = acc[ai][bj][m][0], x1 = acc[ai][bj][m][1];
                        float o0[4], o1[4];
                        if (lat) {
#pragma unroll
                            for (int i = 0; i < 4; ++i) { const float rev = (float)pos * frev[i]; const float cx = __builtin_amdgcn_cosf(rev), sx = __builtin_amdgcn_sinf(rev);
                                o0[i] = (x0[i] * cx - x1[i] * sx) * sc; o1[i] = (x1[i] * cx + x0[i] * sx) * sc; }
                        } else {
#pragma unroll
                            for (int i = 0; i < 4; ++i) { o0[i] = x0[i] * sc; o1[i] = x1[i] * sc; }
                        }
                        u32x4 pk; pk.x = cvt_pk_bf16(o0[0], o0[1]); pk.y = cvt_pk_bf16(o0[2], o0[3]); pk.z = cvt_pk_bf16(o1[0], o1[1]); pk.w = cvt_pk_bf16(o1[2], o1[3]);
                        *(u32x4*)(PROJ + row * NCOL + colt) = pk;
                        asm volatile("" ::: "memory");
                    }
            } else if (nt < 24) {
                const int kvh = nt - 22;
#pragma unroll
                for (int ai = 0; ai < 2; ++ai)
#pragma unroll
                    for (int m = 0; m < 4; ++m) {
                        const int row = u.pm * 256 + ai * 128 + wr * 64 + m * 16 + lv(fr);
#pragma unroll
                        for (int n = 0; n < 2; ++n) {
                            f32x4 v = acc[ai][bj][m][n];
                            const int d0 = 32 * wc + 8 * fq + 4 * n;
                            if (row < MLAT) { const int b = row >> 13, t = row & 8191;
#pragma unroll
                                for (int i = 0; i < 4; ++i) VT[((size_t)(b * 2 + kvh) * 128 + d0 + i) * SEQ + t] = f2bf(v[i]);
                            } else { const int rc = row - MLAT, b = rc >> 8, t = rc & 255;
#pragma unroll
                                for (int i = 0; i < 4; ++i) VTc[((size_t)(b * 2 + kvh) * 128 + d0 + i) * CTXL + t] = f2bf(v[i]);
                            }
                            asm volatile("" ::: "memory");
                        }
                    }
            } else {
                const int ri = (nt - 32) >> 2, jt = ((nt - 32) & 3) * 128;
#pragma unroll
                for (int ai = 0; ai < 2; ++ai)
#pragma unroll
                    for (int m = 0; m < 4; ++m) {
                        const int R = wr * 64 + m * 16 + lv(fr);
#pragma unroll
                        for (int n = 0; n < 2; ++n) {
                            f32x4 v = acc[ai][bj][m][n];
                            const int j0 = jt + 32 * wc + 8 * fq + 4 * n;
                            if (u.pm < 64) { const int b = u.pm >> 5, t2 = 2 * (u.pm & 31) + ai;
#pragma unroll
                                for (int i = 0; i < 4; ++i) ZT[(((size_t)(b * 512 + j0 + i) * 64 + t2) * 256) + ri * 128 + R] = f2bf(v[i]);
                            } else { const int rc = (u.pm - 64) * 256 + ai * 128 + R, b = rc >> 8, t = rc & 255;
#pragma unroll
                                for (int i = 0; i < 4; ++i) ZTc[((size_t)(b * 512 + j0 + i) * 512) + ri * 256 + t] = f2bf(v[i]);
                            }
                            asm volatile("" ::: "memory");
                        }
                    }
            }
        }
    }
};
struct EpiOut {
    bf16_t* Y;
    __device__ __forceinline__ void operator()(const f32x4 (&acc)[2][2][4][2], const Unit& u, int wr, int wc, int fr, int fq) const {
#pragma unroll
        for (int ai = 0; ai < 2; ++ai)
#pragma unroll
            for (int m = 0; m < 4; ++m) {
                const size_t row = (size_t)u.pm * 256 + ai * 128 + wr * 64 + m * 16 + fr;
#pragma unroll
                for (int bj = 0; bj < 2; ++bj) { const f32x4 v0 = acc[ai][bj][m][0], v1 = acc[ai][bj][m][1];
                    u32x4 pk; pk.x = cvt_pk_bf16(v0[0], v0[1]); pk.y = cvt_pk_bf16(v0[2], v0[3]); pk.z = cvt_pk_bf16(v1[0], v1[1]); pk.w = cvt_pk_bf16(v1[2], v1[3]);
                    *(u32x4*)(Y + row * DM + u.pn * 256 + bj * 128 + 32 * wc + 8 * fq) = pk; }
            }
    }
};
struct EpiFold {
    bf16_t* WinT;
    __device__ __forceinline__ void operator()(const f32x4 (&acc)[2][2][4][2], const Unit& u, int wr, int wc, int fr, int fq) const {
        const int l = u.pm >> 2;
#pragma unroll
        for (int ai = 0; ai < 2; ++ai)
#pragma unroll
            for (int m = 0; m < 4; ++m) {
                const size_t r = (size_t)(u.pm & 3) * 256 + ai * 128 + wr * 64 + m * 16 + fr;
#pragma unroll
                for (int bj = 0; bj < 2; ++bj) { const f32x4 v0 = acc[ai][bj][m][0], v1 = acc[ai][bj][m][1];
                    u32x4 pk; pk.x = cvt_pk_bf16(v0[0], v0[1]); pk.y = cvt_pk_bf16(v0[2], v0[3]); pk.z = cvt_pk_bf16(v1[0], v1[1]); pk.w = cvt_pk_bf16(v1[2], v1[3]);
                    *(u32x4*)(WinT + ((size_t)l * NCOL + C_ZR + r) * DM + (u.pn & 7) * 256 + bj * 128 + 32 * wc + 8 * fq) = pk; }
            }
    }
};
struct EpiS1 {
    bf16_t* Bint;
    __device__ __forceinline__ void operator()(const f32x4 (&acc)[2][2][4][2], const Unit& u, int wr, int wc, int fr, int fq) const {
#pragma unroll
        for (int m = 0; m < 4; ++m) {
            const int k1 = lv(wr * 64 + m * 16 + fr);
#pragma unroll
            for (int bj = 0; bj < 2; ++bj) {
                const int c = u.pn * 256 + bj * 128 + 32 * wc + 8 * fq;
                const int t2 = c & 63, bjx = c >> 6, b = bjx >> 9, j = bjx & 511;
                float br[8], bi[8];
#pragma unroll
                for (int n = 0; n < 2; ++n) {
                    const f32x4 ar = acc[0][bj][m][n], aim = acc[1][bj][m][n];
#pragma unroll
                    for (int i = 0; i < 4; ++i) { const float rev = (float)(k1 * (t2 + 4 * n + i)) * (1.f / 8192.f); const float cw = __builtin_amdgcn_cosf(rev), sw = __builtin_amdgcn_sinf(rev);
                        br[4 * n + i] = ar[i] * cw - aim[i] * sw; bi[4 * n + i] = ar[i] * sw + aim[i] * cw; }
                }
                const unsigned off = (unsigned)(((b * 128 + k1) * 512 + j) * 128 + t2);
                u32x4 p0, p1; p0.x = cvt_pk_bf16(br[0], br[1]); p0.y = cvt_pk_bf16(br[2], br[3]); p0.z = cvt_pk_bf16(br[4], br[5]); p0.w = cvt_pk_bf16(br[6], br[7]);
                p1.x = cvt_pk_bf16(bi[0], bi[1]); p1.y = cvt_pk_bf16(bi[2], bi[3]); p1.z = cvt_pk_bf16(bi[4], bi[5]); p1.w = cvt_pk_bf16(bi[6], bi[7]);
                *(u32x4*)(Bint + off) = p0; *(u32x4*)(Bint + off + 64) = p1;
            }
            asm volatile("" ::: "memory");
        }
    }
};
struct EpiCtxF {
    bf16_t* MIX; const bf16_t* PROJ; const float* bf;
    __device__ __forceinline__ void operator()(const f32x4 (&acc)[2][2][4][2], const Unit& u, int wr, int wc, int fr, int fq) const {
#pragma unroll
        for (int ai = 0; ai < 2; ++ai) {
            u32x4 gg[4][2];
#pragma unroll
            for (int m = 0; m < 4; ++m)
#pragma unroll
                for (int bj = 0; bj < 2; ++bj) { const int k = ai * 128 + wr * 64 + m * 16 + fr, col = u.pn * 256 + bj * 128 + 32 * wc + 8 * fq, b = col >> 9, j = col & 511;
                    gg[m][bj] = *(const u32x4*)(PROJ + ((size_t)MLAT + b * 256 + k) * NCOL + C_CG + j); }
#pragma unroll
            for (int m = 0; m < 4; ++m)
#pragma unroll
                for (int bj = 0; bj < 2; ++bj) { const int k = ai * 128 + wr * 64 + m * 16 + fr, col = u.pn * 256 + bj * 128 + 32 * wc + 8 * fq, b = col >> 9, j = col & 511;
                    const f32x4 v0 = acc[ai][bj][m][0], v1 = acc[ai][bj][m][1]; const f32x4 b0 = *(const f32x4*)(bf + j), b1 = *(const f32x4*)(bf + j + 4); const u32x4 g2 = gg[m][bj];
                    u32x4 pk; pk.x = cvt_pk_bf16((v0[0] + b0[0]) * bflo(g2.x), (v0[1] + b0[1]) * bfhi(g2.x)); pk.y = cvt_pk_bf16((v0[2] + b0[2]) * bflo(g2.y), (v0[3] + b0[3]) * bfhi(g2.y));
                    pk.z = cvt_pk_bf16((v1[0] + b1[0]) * bflo(g2.z), (v1[1] + b1[1]) * bfhi(g2.z)); pk.w = cvt_pk_bf16((v1[2] + b1[2]) * bflo(g2.w), (v1[3] + b1[3]) * bfhi(g2.w));
                    *(u32x4*)(MIX + ((size_t)MLAT + b * 256 + k) * DM + 1536 + j) = pk; }
            asm volatile("" ::: "memory");
        }
    }
};

__device__ __forceinline__ int qk_dperm(int p) {
    const int wc = p >> 5, fq = (p >> 3) & 3, n = (p >> 2) & 1, i = p & 3;
    return (wc >> 1) * 64 + n * 32 + (wc & 1) * 16 + fq * 4 + i;
}
__device__ __forceinline__ void transpose_blk(const float* src, int sp, int scol0, bf16_t* dst, int k0, int nd0, bool perm, LAS float* scr) {
    const int tid = lv(threadIdx.x);
    f32x4 v[8];
#pragma unroll
    for (int i = 0; i < 8; ++i) { const int k = (tid >> 6) + 8 * i, c4 = (tid & 63) * 4; v[i] = *(const f32x4*)(src + (size_t)(k0 + k) * sp + scol0 + c4); }
#pragma unroll
    for (int i = 0; i < 8; ++i) { const int k = (tid >> 6) + 8 * i, c4 = (tid & 63) * 4; LAS float* s = scr + k * 257 + c4; s[0] = v[i][0]; s[1] = v[i][1]; s[2] = v[i][2]; s[3] = v[i][3]; }
    __syncthreads();
#pragma unroll
    for (int i = 0; i < 4; ++i) { const int n = (tid >> 3) + 64 * i, kc = tid & 7;
      int sc = n;
      if (perm) { const int p = (nd0 + n) & 127; sc = (n & ~63) + (qk_dperm(p) & 63); }
      const LAS float* s = scr + (kc * 8) * 257 + sc;
      u32x4 o; o.x = cvt_pk_bf16(s[0], s[257]); o.y = cvt_pk_bf16(s[2 * 257], s[3 * 257]); o.z = cvt_pk_bf16(s[4 * 257], s[5 * 257]); o.w = cvt_pk_bf16(s[6 * 257], s[7 * 257]);
      *(u32x4*)(dst + (size_t)(nd0 + n) * DM + k0 + kc * 8) = o; }
    __syncthreads();
}

__device__ __forceinline__ void phase0a(const Params& P_unused, LAS unsigned char* lds, int G) {
    const Params P = load_params(); (void)P_unused;
    unsigned char* ws = ls(P.ws);
    bf16_t* WinT = (bf16_t*)(ws + O_WINT); bf16_t* WoutT = (bf16_t*)(ws + O_WOUTT); bf16_t* Wcx = (bf16_t*)(ws + O_WCX); bf16_t* MTf = (bf16_t*)(ws + O_MTF);
    float* modp = (float*)(ws + O_MODP); float2* rope = (float2*)(ws + O_ROPE); float2* twid = (float2*)(ws + O_TWID);
    bf16_t* F128 = (bf16_t*)(ws + O_F128); bf16_t* F64 = (bf16_t*)(ws + O_F64); bf16_t* Dctx = (bf16_t*)(ws + O_DCTX);
    LAS float* scr = (LAS float*)lds;
    const int tid = lv(threadIdx.x), bid = blockIdx.x;
    for (int task = bid; task < 384; task += G) {
        const int l = task / 96, s = (task / 3) & 31, nc = task % 3;
        __syncthreads();
        if (tid < 192) { const int r = tid >> 6, kk = tid & 63; const float v = (r < 2) ? P.c[r * DM + s * 64 + kk] : P.c_ctx[s * 64 + kk]; scr[r * 64 + kk] = silu_f(v); }
        __syncthreads();
        const int n = nc * 2048 + tid * 4;
        f32x4 a0 = {0, 0, 0, 0}, a1 = {0, 0, 0, 0}, a2 = {0, 0, 0, 0};
        const float* wp = P.w_mod + ((size_t)l * DM + s * 64) * 6144 + n;
#pragma unroll 16
        for (int kk = 0; kk < 64; ++kk) { const f32x4 w = *(const f32x4*)(wp + (size_t)kk * 6144); a0 += w * scr[kk]; a1 += w * scr[64 + kk]; a2 += w * scr[128 + kk]; }
        float* op = modp + ((size_t)(l * 32 + s) * 3) * 6144 + n;
        *(f32x4*)(op) = a0; *(f32x4*)(op + 6144) = a1; *(f32x4*)(op + 2 * 6144) = a2;
    }
    __syncthreads();
    for (int task = bid; task < DEPTH * 18 * 32; task += G) {
        const int l = task / (18 * 32), r = task % (18 * 32), nb = r >> 5, kt = r & 31;
        const int nd0 = nb < 16 ? nb * 256 : (5120 + (nb - 16) * 256);
        const int scol0 = nb < 16 ? nd0 : nd0 - 512;
        const bool perm = (nd0 >= C_Q && nd0 < C_V);
        transpose_blk(P.w_in + (size_t)l * DM * 5120, 5120, scol0, WinT + (size_t)l * NCOL * DM, kt * 64, nd0, perm, scr);
    }
    for (int task = bid; task < DEPTH * 8 * 32; task += G) {
        const int l = task >> 8, r = task & 255, nb = r >> 5, kt = r & 31;
        transpose_blk(P.w_out + (size_t)l * DM * DM, DM, nb * 256, WoutT + (size_t)l * DM * DM, kt * 64, nb * 256, false, scr);
    }
    if (tid < 128) { const float a = (float)tid * (1.f / 64.f); scr[tid] = cospif(a); scr[128 + tid] = sinpif(a); }
    __syncthreads();
    const size_t gt = (size_t)bid * 512 + tid, GT = (size_t)G * 512;
    for (size_t e = gt; e < (size_t)DEPTH * DM * 128; e += GT) {
        const size_t lk = e >> 7; const int j4 = (int)(e & 127) * 4;
        const f32x4 v = *(const f32x4*)(P.w_in + lk * 5120 + 4096 + j4);
        *(u32x2*)(Wcx + lk * 512 + j4) = pack4(v[0], v[1], v[2], v[3]);
    }
    for (size_t e = gt; e < (size_t)DEPTH * 1024 * 512; e += GT) {
        const int col = (int)(e & 511), row = (int)((e >> 9) & 1023), l = (int)(e >> 19);
        const int ri = row >> 9, g = (row >> 7) & 3, d = row & 127, g2 = col >> 7, c = col & 127;
        float v = 0.f;
        if (g == g2) {
            const float* wf = P.w_f + ((size_t)(l * 4 + g) * 128) * 128 + d;
            float s = 0.f;
            const LAS float* tb = scr + ri * 128;
#pragma unroll 8
            for (int c2 = 0; c2 < 128; ++c2) s += tb[(c * c2) & 127] * wf[(size_t)c2 * 128];
            v = s * (1.f / 1024.f);
        }
        MTf[e] = f2bf(v);
    }
    for (size_t e = gt; e < 128 * 32; e += GT) { const int pos = (int)(e >> 5), f = (int)(e & 31);
        const float fr = powf(10000.f, -(float)f / 32.f); const float ang = (float)pos * fr; float sn, cs; sincosf(ang, &sn, &cs); rope[e] = make_float2(cs, sn); }
    for (size_t e = gt; e < 8192; e += GT) { const float a = (float)e * (1.f / 4096.f); twid[e] = make_float2(cospif(a), sinpif(a)); }
    for (size_t e = gt; e < 256 * 256; e += GT) { const int n = (int)(e >> 8), kk = (int)(e & 255); const int ro = n >> 7, k1 = n & 127, rin = kk >> 7, t1 = kk & 127;
        const float a = (float)((k1 * t1) & 127) * (1.f / 64.f); const float cs = cospif(a), sn = sinpif(a);
        const float v = ro == 0 ? (rin == 0 ? cs : -sn) : (rin == 0 ? sn : cs); F128[e] = f2bf(v); }
    for (size_t e = gt; e < 64 * 128; e += GT) { const int k2 = (int)(e >> 7), kk = (int)(e & 127); const int rin = kk >> 6, t2 = kk & 63;
        const float a = (float)((k2 * t2) & 63) * (1.f / 32.f); F64[e] = f2bf(rin == 0 ? cospif(a) : -sinpif(a)); }
    for (size_t e = gt; e < 256 * 512; e += GT) { const int k = (int)(e >> 9), kk = (int)(e & 511); const int rin = kk >> 8, t = kk & 255;
        const float a = (float)((k * t) & 255) * (1.f / 128.f); Dctx[e] = f2bf((rin == 0 ? cospif(a) : -sinpif(a)) * 5.656854249492381f); }
}

__device__ __forceinline__ void row_phase(const Params& P_unused, int layer, int G) {
    const Params P = load_params(); (void)P_unused;
    unsigned char* ws = ls(P.ws);
    const float* mod = (const float*)(ws + O_MOD);
    float* XC = (float*)(ws + O_XC);
    bf16_t* XB = (bf16_t*)(ws + O_XB);
    bf16_t* H = (bf16_t*)(ws + O_HMIX);
    const bf16_t* Y = (const bf16_t*)(ws + O_PROJ); const bf16_t* Yc = (const bf16_t*)(ws + O_YC);
    const int tid = lv(threadIdx.x);
    const int lane = tid & 63, gw = blockIdx.x * 8 + (tid >> 6), NGW = G * 8;
    const int nrows = layer == DEPTH ? MLAT : MROWS;
    const bool xb_src = layer >= 2;
    const float* xctx = layer <= 1 ? P.ctx : XC;
    f32x4 vn[8]; u32x2 yn[8], xn[8];
#define ROW_LOAD(r) do { const int _r = (r); \
        if (_r < MLAT && xb_src) { _Pragma("unroll") for (int j = 0; j < 8; ++j) xn[j] = *(const u32x2*)(XB + (size_t)_r * DM + lane * 4 + 256 * j); } \
        else { const float* _x = _r < MLAT ? P.x + (size_t)_r * DM : xctx + (size_t)(_r - MLAT) * DM; _Pragma("unroll") for (int j = 0; j < 8; ++j) vn[j] = *(const f32x4*)(_x + lane * 4 + 256 * j); } \
        if (layer >= 1) { const bf16_t* _y = _r < MLAT ? Y + (size_t)_r * DM : Yc + (size_t)(_r - MLAT) * DM; _Pragma("unroll") for (int j = 0; j < 8; ++j) yn[j] = *(const u32x2*)(_y + lane * 4 + 256 * j); } } while (0)
    if (gw < nrows) ROW_LOAD(gw);
    for (int row = gw; row < nrows; row += NGW) {
        const bool lat = row < MLAT; const int mr = lat ? (row >> 13) : 2;
        f32x4 v[8]; u32x2 yw[8];
        if (lat && xb_src) {
#pragma unroll
            for (int j = 0; j < 8; ++j) v[j] = (f32x4){bflo(xn[j].x), bfhi(xn[j].x), bflo(xn[j].y), bfhi(xn[j].y)};
        } else {
#pragma unroll
            for (int j = 0; j < 8; ++j) v[j] = vn[j];
        }
#pragma unroll
        for (int j = 0; j < 8; ++j) yw[j] = yn[j];
        const int nr = row + NGW;
        if (nr < nrows) ROW_LOAD(nr);
        if (layer >= 1) {
            const float* mg = mod + ((size_t)(layer - 1) * 3 + mr) * 6144 + 4096;
            const float* gp = P.g_post + (size_t)(layer - 1) * DM;
            f32x4 y[8]; float ss = 0.f;
#pragma unroll
            for (int j = 0; j < 8; ++j) { const u32x2 w = yw[j];
                y[j] = (f32x4){bflo(w.x), bfhi(w.x), bflo(w.y), bfhi(w.y)}; ss += y[j][0] * y[j][0] + y[j][1] * y[j][1] + y[j][2] * y[j][2] + y[j][3] * y[j][3]; }
            const float rinv = rsqrtf(wave_sum(ss) * (1.f / DM) + EPS);
#pragma unroll
            for (int j = 0; j < 8; ++j) { const f32x4 g4 = *(const f32x4*)(mg + lane * 4 + 256 * j), p4 = *(const f32x4*)(gp + lane * 4 + 256 * j);
                v[j] = v[j] + g4 * (y[j] * rinv * p4); }
            if (!lat) {
#pragma unroll
                for (int j = 0; j < 8; ++j) *(f32x4*)(XC + (size_t)(row - MLAT) * DM + lane * 4 + 256 * j) = v[j];
            } else if (layer == DEPTH) {
#pragma unroll
                for (int j = 0; j < 8; ++j) *(f32x4*)(P.out + (size_t)row * DM + lane * 4 + 256 * j) = v[j];
            } else {
#pragma unroll
                for (int j = 0; j < 8; ++j) *(u32x2*)(XB + (size_t)row * DM + lane * 4 + 256 * j) = pack4(v[j][0], v[j][1], v[j][2], v[j][3]);
            }
        }
        if (layer < DEPTH) {
            float ss = 0.f;
#pragma unroll
            for (int j = 0; j < 8; ++j) ss += v[j][0] * v[j][0] + v[j][1] * v[j][1] + v[j][2] * v[j][2] + v[j][3] * v[j][3];
            const float rinv = rsqrtf(wave_sum(ss) * (1.f / DM) + EPS);
            const float* msh = mod + ((size_t)layer * 3 + mr) * 6144; const float* msc = msh + 2048;
            const float* gp = P.g_pre + (size_t)layer * DM;
#pragma unroll
            for (int j = 0; j < 8; ++j) { const f32x4 sh = *(const f32x4*)(msh + lane * 4 + 256 * j), sc = *(const f32x4*)(msc + lane * 4 + 256 * j), g4 = *(const f32x4*)(gp + lane * 4 + 256 * j);
                const f32x4 h = (v[j] * rinv * g4) * (sc + 1.f) + sh;
                *(u32x2*)(H + (size_t)row * DM + lane * 4 + 256 * j) = pack4(h[0], h[1], h[2], h[3]); }
        }
    }
#undef ROW_LOAD
}

__device__ __forceinline__ void attn_task(const Params& P_unused, int layer, int task, LAS unsigned char* lds) {
    const Params P = load_params(); (void)P_unused;
    unsigned char* ws = ls(P.ws);
    const bf16_t* PROJ = (const bf16_t*)(ws + O_PROJ);
    const bf16_t* VT = (const bf16_t*)(ws + O_VT); const bf16_t* VTc = (const bf16_t*)(ws + O_VTC);
    bf16_t* MIX = (bf16_t*)(ws + O_HMIX);
    const int tid = lv(threadIdx.x);
    const int lane = tid & 63, w = __builtin_amdgcn_readfirstlane(tid >> 6), fr = lane & 15, fq = lane >> 4;
    int b, blk, kvh, pair; bool isctx;
    if (task < 512) { isctx = false; b = task >> 8; const int rem = task & 255; blk = rem >> 2; kvh = (rem >> 1) & 1; pair = rem & 1; }
    else { isctx = true; const int t = task - 512; b = t >> 3; blk = (t >> 2) & 1; kvh = (t >> 1) & 1; pair = t & 1; }
    const int head = kvh * 4 + pair * 2 + (w >> 2);
    const int a0 = (w & 3) * 32;
    const size_t qrow0 = (isctx ? (size_t)MLAT + b * CTXL : (size_t)b * SEQ) + blk * 128 + a0;
    bf16x8 qf[2][4];
#pragma unroll
    for (int u = 0; u < 2; ++u)
#pragma unroll
        for (int c = 0; c < 4; ++c) qf[u][c] = *(const bf16x8*)(PROJ + (qrow0 + u * 16 + fr) * NCOL + C_Q + head * 128 + c * 32 + fq * 8);
    u32x2 gws[2][8];
#pragma unroll
    for (int u = 0; u < 2; ++u)
#pragma unroll
        for (int dt = 0; dt < 8; ++dt) gws[u][dt] = *(const u32x2*)(PROJ + (qrow0 + u * 16 + fr) * NCOL + C_BG + head * 128 + dt * 16 + 4 * fq);
    float mrun[2], lrun[2];
    const float sk = P.sink[layer * 8 + head] * LOG2E;
    mrun[0] = mrun[1] = sk; lrun[0] = lrun[1] = 1.f;
    f32x4 o[8][2];
#pragma unroll
    for (int dt = 0; dt < 8; ++dt) { o[dt][0] = (f32x4){0, 0, 0, 0}; o[dt][1] = (f32x4){0, 0, 0, 0}; }
    const int nprev = (!isctx && blk > 0) ? 4 : 0, nnext = (!isctx && blk < 63) ? 4 : 0;
    const int T = isctx ? 8 : 12 + nprev + nnext;
    const int lkey = tid >> 4, lkc = (tid & 15) ^ (((lkey >> 3) << 2) | (lkey & 3));
    const unsigned koff = (unsigned)(lkey * NCOL + lkc * 8) * 2u;
    const int ld = tid >> 2, lvc = (tid & 3) ^ ((ld >> 2) & 3);
    const unsigned voff_c = (unsigned)(ld * CTXL + lvc * 8) * 2u, voff_s = (unsigned)(ld * SEQ + lvc * 8) * 2u;
    const char* kctx = (const char*)(PROJ + ((size_t)MLAT + b * CTXL) * NCOL + C_K + kvh * 128);
    const char* klat = (const char*)(PROJ + ((size_t)b * SEQ) * NCOL + C_K + kvh * 128);
    const char* vctx = (const char*)(VTc + (size_t)(b * 2 + kvh) * 128 * CTXL);
    const char* vlat = (const char*)(VT + (size_t)(b * 2 + kvh) * 128 * SEQ);
#define ATT_ISSUE(tt) do { int _t = (tt) < T ? (tt) : T - 1; const char* _kp; const char* _vp; unsigned _vo; \
        if (_t < 8) { _kp = kctx + (size_t)(_t * 32) * NCOL * 2; _vp = vctx + _t * 64; _vo = voff_c; } \
        else { const int _r = _t - 8, _seg = _r < nprev ? 0 : (_r < nprev + 4 ? 1 : 2), _st = _seg == 0 ? _r : (_seg == 1 ? _r - nprev : _r - nprev - 4); \
               const int _kb = (blk - 1 + _seg) * 128 + _st * 32; _kp = klat + (size_t)_kb * NCOL * 2; _vp = vlat + _kb * 2; _vo = voff_s; } \
        LAS unsigned char* _dst = lds + ((tt) & 7) * 16384 + w * 1024; \
        __builtin_amdgcn_global_load_lds((const unsigned*)(_kp + koff), (LAS unsigned*)(_dst), 16, 0, 0); \
        __builtin_amdgcn_global_load_lds((const unsigned*)(_vp + _vo), (LAS unsigned*)(_dst + 8192), 16, 0, 0); } while (0)
    ATT_ISSUE(0); ATT_ISSUE(1); ATT_ISSUE(2); ATT_ISSUE(3); ATT_ISSUE(4); ATT_ISSUE(5);
    const int kfo = (8 * (fr >> 2) + (fr & 3)) * 256, vfo = fr * 64 + ((fq ^ ((fr >> 2) & 3)) * 16);
    int kofs[4];
#pragma unroll
    for (int c = 0; c < 4; ++c) kofs[c] = kfo + (((c * 4 + fq) ^ fr) * 16);
    const f32x4 zero4 = {0.f, 0.f, 0.f, 0.f};
    for (int tp = 0; tp < T; tp += 2) {
        asm volatile("s_waitcnt vmcnt(8) lgkmcnt(0)" ::: "memory");
        __builtin_amdgcn_s_barrier();
        asm volatile("" ::: "memory");
        ATT_ISSUE(tp + 6); ATT_ISSUE(tp + 7);
        int mtype = 0, st = 0;
        if (tp >= 8) { const int r = tp - 8; if (r < nprev) { mtype = 1; st = r; } else if (r >= nprev + 4) { mtype = 2; st = r - nprev - 4; } }
        const int k0 = st * 32;
        if (mtype == 1 && k0 + 63 < a0) continue;
        if (mtype == 2 && k0 > a0 + 31) continue;
        f32x4 s[2][2][2];
#pragma unroll
        for (int tl = 0; tl < 2; ++tl) {
            const LAS unsigned char* kb = lds + ((tp + tl) & 7) * 16384;
#pragma unroll
            for (int v = 0; v < 2; ++v)
#pragma unroll
                for (int c = 0; c < 4; ++c) {
                    const bf16x8 ka = *(const LAS bf16x8*)(kb + kofs[c] + v * 1024);
                    s[0][tl][v] = __builtin_amdgcn_mfma_f32_16x16x32_bf16(ka, qf[0][c], c == 0 ? zero4 : s[0][tl][v], 0, 0, 0);
                    s[1][tl][v] = __builtin_amdgcn_mfma_f32_16x16x32_bf16(ka, qf[1][c], c == 0 ? zero4 : s[1][tl][v], 0, 0, 0);
                }
        }
        bf16x8 pb[2][2];
#pragma unroll
        for (int u = 0; u < 2; ++u) {
            if (mtype == 1) {
                asm volatile("" ::: "memory");
                const int a = a0 + u * 16 + fr - k0 - 8 * fq;
#pragma unroll
                for (int tl = 0; tl < 2; ++tl)
#pragma unroll
                    for (int v = 0; v < 2; ++v)
#pragma unroll
                        for (int r = 0; r < 4; ++r) { if (32 * tl + 4 * v + r < a) s[u][tl][v][r] = -1e30f; }
            } else if (mtype == 2) {
                asm volatile("" ::: "memory");
                const int a = a0 + u * 16 + fr - k0 - 8 * fq;
#pragma unroll
                for (int tl = 0; tl < 2; ++tl)
#pragma unroll
                    for (int v = 0; v < 2; ++v)
#pragma unroll
                        for (int r = 0; r < 4; ++r) { if (32 * tl + 4 * v + r > a) s[u][tl][v][r] = -1e30f; }
            }
            float mx = -3e38f;
#pragma unroll
            for (int tl = 0; tl < 2; ++tl)
#pragma unroll
                for (int v = 0; v < 2; ++v) mx = fmaxf(mx, fmaxf(fmaxf(s[u][tl][v][0], s[u][tl][v][1]), fmaxf(s[u][tl][v][2], s[u][tl][v][3])));
            mx = xor16_max(mx); mx = xor32_max(mx);
            const float mn = fmaxf(mrun[u], mx);
            const float alpha = __builtin_amdgcn_exp2f(mrun[u] - mn);
            float p[16]; float ps = 0.f;
#pragma unroll
            for (int tl = 0; tl < 2; ++tl)
#pragma unroll
                for (int v = 0; v < 2; ++v)
#pragma unroll
                    for (int r = 0; r < 4; ++r) { const float e = __builtin_amdgcn_exp2f(s[u][tl][v][r] - mn); p[tl * 8 + v * 4 + r] = e; ps += e; }
            ps = xor16_sum(ps); ps = xor32_sum(ps);
            lrun[u] = lrun[u] * alpha + ps;
            if (__any(mn > mrun[u])) {
#pragma unroll
                for (int dt = 0; dt < 8; ++dt) o[dt][u] = o[dt][u] * alpha;
            }
            mrun[u] = mn;
#pragma unroll
            for (int tl = 0; tl < 2; ++tl) {
                u32x4 pk; pk.x = cvt_pk_bf16(p[tl * 8 + 0], p[tl * 8 + 1]); pk.y = cvt_pk_bf16(p[tl * 8 + 2], p[tl * 8 + 3]); pk.z = cvt_pk_bf16(p[tl * 8 + 4], p[tl * 8 + 5]); pk.w = cvt_pk_bf16(p[tl * 8 + 6], p[tl * 8 + 7]);
                pb[u][tl] = __builtin_bit_cast(bf16x8, pk);
            }
        }
#pragma unroll
        for (int tl = 0; tl < 2; ++tl) {
            const LAS unsigned char* vb = lds + ((tp + tl) & 7) * 16384 + 8192;
#pragma unroll
            for (int dt = 0; dt < 8; ++dt) {
                const bf16x8 va = *(const LAS bf16x8*)(vb + dt * 1024 + vfo);
                o[dt][0] = __builtin_amdgcn_mfma_f32_16x16x32_bf16(va, pb[0][tl], o[dt][0], 0, 0, 0);
                o[dt][1] = __builtin_amdgcn_mfma_f32_16x16x32_bf16(va, pb[1][tl], o[dt][1], 0, 0, 0);
            }
        }
    }
    asm volatile("s_waitcnt vmcnt(0) lgkmcnt(0)" ::: "memory");
    __builtin_amdgcn_s_barrier();
    asm volatile("" ::: "memory");
#undef ATT_ISSUE
#pragma unroll
    for (int u = 0; u < 2; ++u) {
        const float inv = 1.f / lrun[u];
        const size_t row = qrow0 + u * 16 + fr;
#pragma unroll
        for (int dt = 0; dt < 8; ++dt) {
            const int d0 = head * 128 + dt * 16 + 4 * fq;
            const u32x2 gw = gws[u][dt];
            const f32x4 ov = o[dt][u] * inv;
            *(u32x2*)(MIX + row * DM + 512 + d0) = pack4(ov[0] * bflo(gw.x), ov[1] * bfhi(gw.x), ov[2] * bflo(gw.y), ov[3] * bfhi(gw.y));
        }
    }
}

constexpr int GM_PART = 131072, GM_RQ = GM_PART + 32 * 128 * 4, LDS_TOTAL = GM_RQ + 512;
__device__ __forceinline__ void gmlp_task(const Params& P_unused, int layer, int chunk, LAS unsigned char* lds) {
    const Params P = load_params(); (void)P_unused;
    unsigned char* ws = ls(P.ws);
    const bf16_t* PROJ = (const bf16_t*)(ws + O_PROJ); const bf16_t* avT = (const bf16_t*)(ws + O_AVT) + (size_t)chunk * 512 * 128;
    bf16_t* MIX = (bf16_t*)(ws + O_HMIX);
    LAS float* part = (LAS float*)(lds + GM_PART);
    LAS float* rq = (LAS float*)(lds + GM_RQ);
    const int tid = lv(threadIdx.x), lane = tid & 63, w = __builtin_amdgcn_readfirstlane(tid >> 6), fr = lane & 15, fq = lane >> 4;
    __syncthreads();
    const int myc = (tid & 15) ^ ((tid >> 4) & 15);
    { const char* src = (const char*)avT + (size_t)(tid >> 4) * 256 + myc * 16;
#pragma unroll
      for (int i = 0; i < 16; ++i) __builtin_amdgcn_global_load_lds((const unsigned*)(src + (size_t)i * 32 * 256), (LAS unsigned*)(lds + i * 8192 + w * 1024), 16, 0, 0); }
    const int p = 16 * w + fr; const size_t row = (size_t)chunk * 128 + p;
    f32x4 wsn[8]; u32x2 uun[8], ggn[8];
#define GM_LOAD(h) do { const float* _wsr = P.w_sgu + (((size_t)layer * 4 + (h)) * 128 + p) * 128; \
        _Pragma("unroll") for (int c = 0; c < 4; ++c) { wsn[2 * c] = *(const f32x4*)(_wsr + c * 32 + 8 * fq); wsn[2 * c + 1] = *(const f32x4*)(_wsr + c * 32 + 8 * fq + 4); } \
        _Pragma("unroll") for (int dt = 0; dt < 8; ++dt) { const int _col = (h) * 128 + dt * 16 + 4 * fq; uun[dt] = *(const u32x2*)(PROJ + row * NCOL + C_AU + _col); ggn[dt] = *(const u32x2*)(PROJ + row * NCOL + C_AG + _col); } } while (0)
    GM_LOAD(0);
    asm volatile("s_waitcnt vmcnt(0)" ::: "memory");
    __builtin_amdgcn_s_barrier();
    asm volatile("" ::: "memory");
    { float s8[8] = {0, 0, 0, 0, 0, 0, 0, 0};
#pragma unroll
      for (int i = 0; i < 16; ++i) { const u32x4 v = *(const LAS u32x4*)(lds + i * 8192 + tid * 16);
          float f; f = bflo(v.x); s8[0] += f * f; f = bfhi(v.x); s8[1] += f * f; f = bflo(v.y); s8[2] += f * f; f = bfhi(v.y); s8[3] += f * f;
          f = bflo(v.z); s8[4] += f * f; f = bfhi(v.z); s8[5] += f * f; f = bflo(v.w); s8[6] += f * f; f = bfhi(v.w); s8[7] += f * f; }
#pragma unroll
      for (int e = 0; e < 8; ++e) part[(tid >> 4) * 128 + myc * 8 + e] = s8[e]; }
    __syncthreads();
    if (tid < 128) { float s = 0.f; for (int i = 0; i < 32; ++i) s += part[i * 128 + tid]; rq[tid] = rsqrtf(s * (1.f / 512.f) + EPS); }
    __syncthreads();
    for (int h = 0; h < 4; ++h) {
        f32x4 wsc[8]; u32x2 uu[8], gg[8];
#pragma unroll
        for (int i = 0; i < 8; ++i) { wsc[i] = wsn[i]; uu[i] = uun[i]; gg[i] = ggn[i]; }
        if (h < 3) GM_LOAD(h + 1);
        bf16x8 bfr[4];
#pragma unroll
        for (int c = 0; c < 4; ++c) { const int q0 = c * 32 + 8 * fq; const f32x4 w0 = wsc[2 * c], w1 = wsc[2 * c + 1];
            u32x4 pk; pk.x = cvt_pk_bf16(w0[0] * rq[q0], w0[1] * rq[q0 + 1]); pk.y = cvt_pk_bf16(w0[2] * rq[q0 + 2], w0[3] * rq[q0 + 3]);
            pk.z = cvt_pk_bf16(w1[0] * rq[q0 + 4], w1[1] * rq[q0 + 5]); pk.w = cvt_pk_bf16(w1[2] * rq[q0 + 6], w1[3] * rq[q0 + 7]); bfr[c] = __builtin_bit_cast(bf16x8, pk); }
        f32x4 acc[8];
#pragma unroll
        for (int dt = 0; dt < 8; ++dt) { acc[dt] = (f32x4){0, 0, 0, 0};
#pragma unroll
            for (int c = 0; c < 4; ++c) { const bf16x8 a = *(const LAS bf16x8*)(lds + (h * 128 + dt * 16 + fr) * 256 + (((c * 4 + fq) ^ fr) * 16));
                acc[dt] = __builtin_amdgcn_mfma_f32_16x16x32_bf16(a, bfr[c], acc[dt], 0, 0, 0); } }
        const float bs = P.b_sgu[((size_t)layer * 4 + h) * 128 + p];
#pragma unroll
        for (int dt = 0; dt < 8; ++dt) { const int col = h * 128 + dt * 16 + 4 * fq;
            const f32x4 g4 = *(const f32x4*)(P.g_sgu + (size_t)layer * 512 + col);
            const u32x2 u2 = uu[dt], g2 = gg[dt];
            const float y0 = bflo(u2.x) * (acc[dt][0] * g4[0] + bs) * bflo(g2.x), y1 = bfhi(u2.x) * (acc[dt][1] * g4[1] + bs) * bfhi(g2.x);
            const float y2 = bflo(u2.y) * (acc[dt][2] * g4[2] + bs) * bflo(g2.y), y3 = bfhi(u2.y) * (acc[dt][3] * g4[3] + bs) * bfhi(g2.y);
            *(u32x2*)(MIX + row * DM + col) = pack4(y0, y1, y2, y3); }
    }
#undef GM_LOAD
    __syncthreads();
}

__device__ __forceinline__ void stage2_phase(const Params& P_unused, int layer, int G) {
    const Params P = load_params(); (void)P_unused;
    unsigned char* ws = ls(P.ws);
    const bf16_t* Bint = (const bf16_t*)(ws + O_BINT); const bf16_t* F64 = (const bf16_t*)(ws + O_F64); const bf16_t* PROJ = (const bf16_t*)(ws + O_PROJ);
    bf16_t* MIX = (bf16_t*)(ws + O_HMIX);
    const int tid = lv(threadIdx.x);
    const int lane = tid & 63, w = __builtin_amdgcn_readfirstlane(tid >> 6), fr = lane & 15, fq = lane >> 4;
    bf16x8 ff[4][4];
#pragma unroll
    for (int nt = 0; nt < 4; ++nt)
#pragma unroll
        for (int c = 0; c < 4; ++c) ff[nt][c] = *(const bf16x8*)(F64 + (size_t)(nt * 16 + fr) * 128 + c * 32 + fq * 8);
    for (int task = blockIdx.x; task < 256; task += G) {
        const int b = task >> 7, k1 = task & 127;
        bf16x8 af[4][4]; u32x2 gg[4][4]; f32x4 bias[4];
#pragma unroll
        for (int mi = 0; mi < 4; ++mi) {
            const int j0 = (w * 4 + mi) * 16, jc = j0 + 4 * fq;
#pragma unroll
            for (int c = 0; c < 4; ++c) af[mi][c] = *(const bf16x8*)(Bint + (((size_t)(b * 128 + k1) * 512 + j0 + fr) * 128) + c * 32 + fq * 8);
            bias[mi] = *(const f32x4*)(P.b_f + (size_t)layer * 512 + jc);
#pragma unroll
            for (int nt = 0; nt < 4; ++nt) gg[mi][nt] = *(const u32x2*)(PROJ + ((size_t)b * SEQ + k1 + 128 * (nt * 16 + fr)) * NCOL + C_CG + jc);
        }
#pragma unroll
        for (int mi = 0; mi < 4; ++mi) {
            const int jc = (w * 4 + mi) * 16 + 4 * fq;
#pragma unroll
            for (int nt = 0; nt < 4; ++nt) {
                f32x4 acc = {0, 0, 0, 0};
#pragma unroll
                for (int c = 0; c < 4; ++c) acc = __builtin_amdgcn_mfma_f32_16x16x32_bf16(af[mi][c], ff[nt][c], acc, 0, 0, 0);
                const int k2 = nt * 16 + fr; const size_t row = (size_t)b * SEQ + k1 + 128 * k2;
                const u32x2 g2 = gg[mi][nt];
                *(u32x2*)(MIX + row * DM + 1536 + jc) = pack4((acc[0] + bias[mi][0]) * bflo(g2.x), (acc[1] + bias[mi][1]) * bfhi(g2.x), (acc[2] + bias[mi][2]) * bflo(g2.y), (acc[3] + bias[mi][3]) * bfhi(g2.y));
            }
        }
    }
}

__device__ __forceinline__ void ctx_outproj_tile(const Params& P_unused, int layer, int tile, LAS unsigned char* lds) {
    const Params P = load_params(); (void)P_unused;
    unsigned char* ws = ls(P.ws);
    const bf16_t* A = (const bf16_t*)(ws + O_HMIX) + (size_t)MLAT * DM;
    const bf16_t* Bt = (const bf16_t*)(ws + O_WOUTT) + (size_t)layer * DM * DM;
    bf16_t* Yc = (bf16_t*)(ws + O_YC);
    const int tid = lv(threadIdx.x);
    const int lane = tid & 63, w = __builtin_amdgcn_readfirstlane(tid >> 6), fr = lane & 15, fq = lane >> 4;
    const int m0 = (tile >> 5) * 64, n0 = (tile & 31) * 64;
    f32x4 acc[4][4];
#pragma unroll
    for (int i = 0; i < 4; ++i)
#pragma unroll
        for (int j = 0; j < 4; ++j) acc[i][j] = (f32x4){0, 0, 0, 0};
    const bf16_t* ap = A + (size_t)(m0 + fr) * DM + w * 256 + fq * 8;
    const bf16_t* bp = Bt + (size_t)(n0 + fr) * DM + w * 256 + fq * 8;
#pragma unroll 4
    for (int ks = 0; ks < 8; ++ks) {
        bf16x8 af[4], bv[4];
#pragma unroll
        for (int i = 0; i < 4; ++i) { af[i] = *(const bf16x8*)(ap + (size_t)i * 16 * DM + ks * 32); bv[i] = *(const bf16x8*)(bp + (size_t)i * 16 * DM + ks * 32); }
#pragma unroll
        for (int i = 0; i < 4; ++i)
#pragma unroll
            for (int j = 0; j < 4; ++j) acc[i][j] = __builtin_amdgcn_mfma_f32_16x16x32_bf16(af[i], bv[j], acc[i][j], 0, 0, 0);
    }
    __syncthreads();
    LAS float* red = (LAS float*)lds + w * 4096;
#pragma unroll
    for (int i = 0; i < 4; ++i)
#pragma unroll
        for (int j = 0; j < 4; ++j)
#pragma unroll
            for (int r = 0; r < 4; ++r) red[(i * 16 + 4 * fq + r) * 64 + j * 16 + fr] = acc[i][j][r];
    __syncthreads();
    { const int e0 = tid * 8, row = e0 >> 6, col = e0 & 63;
      f32x4 s0 = {0, 0, 0, 0}, s1 = {0, 0, 0, 0};
#pragma unroll
      for (int wv = 0; wv < 8; ++wv) { const LAS f32x4* p = (const LAS f32x4*)((LAS float*)lds + wv * 4096 + e0); s0 += p[0]; s1 += p[1]; }
      u32x4 o; o.x = cvt_pk_bf16(s0[0], s0[1]); o.y = cvt_pk_bf16(s0[2], s0[3]); o.z = cvt_pk_bf16(s1[0], s1[1]); o.w = cvt_pk_bf16(s1[2], s1[3]);
      *(u32x4*)(Yc + (size_t)(m0 + row) * DM + n0 + col) = o; }
    __syncthreads();
}

#define XB_TMO      128
#define XB_XCNT(j)  (256  + 64 * (j))
#define XB_XSUB(j)  (1280 + 64 * (j))
#define XB_XGEN(j)  (2304 + 64 * (j))
#define XB_TOP      3328
#define XB_TOPGEN   3392
#define XCD_BAR_WORDS 3456
#define XB_SPIN_CAP (1u << 18)
__device__ __forceinline__ unsigned xb_ld(unsigned* p)              { return __hip_atomic_load(p, __ATOMIC_RELAXED, __HIP_MEMORY_SCOPE_AGENT); }
__device__ __forceinline__ unsigned xb_add(unsigned* p, unsigned v) { return __hip_atomic_fetch_add(p, v, __ATOMIC_RELAXED, __HIP_MEMORY_SCOPE_AGENT); }
__device__ __forceinline__ unsigned xb_xcc_id() { return (unsigned)__builtin_amdgcn_s_getreg((3 << 11) | 20) & 0xFu; }
#define XB_SPIN(cond, bar) do { unsigned _sp = 0; while (cond) { __builtin_amdgcn_s_sleep(1); \
    if ((++_sp & 255u) == 0u) { if (xb_ld(&(bar)[XB_TMO])) break; if (_sp > XB_SPIN_CAP) { atomicAdd(&(bar)[XB_TMO], 1u); break; } } } } while (0)
struct XcdBarrier { unsigned* bar; unsigned x; volatile LAS unsigned* st; };
__device__ __forceinline__ XcdBarrier xcd_barrier_post(unsigned* bar, volatile LAS unsigned* st) {
    XcdBarrier b; b.bar = bar; b.x = xb_xcc_id(); b.st = st;
    if (threadIdx.x == 0) (void)xb_add(&bar[XB_XCNT(b.x)], 1u);
    return b;
}
__device__ __forceinline__ void xcd_barrier_complete(unsigned* bar, unsigned x, unsigned& nloc, unsigned& nx) {
    const unsigned G = gridDim.x * gridDim.y * gridDim.z;
    unsigned sum, cnt, mine, sp = 0u;
    for (;;) {
        sum = 0u; cnt = 0u; mine = 0u;
#pragma unroll
        for (unsigned j = 0; j < 16; ++j) { const unsigned c = xb_ld(&bar[XB_XCNT(j)]); sum += c; cnt += (c > 0u) ? 1u : 0u; mine = (j == x) ? c : mine; }
        if (sum == G) break;
        __builtin_amdgcn_s_sleep(1);
        if ((++sp & 255u) == 0u) { if (xb_ld(&bar[XB_TMO])) break; if (sp > XB_SPIN_CAP) { atomicAdd(&bar[XB_TMO], 1u); break; } }
    }
    nloc = mine > 0u ? mine : 1u; nx = cnt > 0u ? cnt : 1u;
}
__device__ __forceinline__ void xcd_barrier(const XcdBarrier& b) {
    asm volatile("s_waitcnt vmcnt(0)" ::: "memory");
    __syncthreads();
    if (threadIdx.x == 0) {
        unsigned* bar = b.bar;
        __builtin_amdgcn_s_waitcnt(0);
        unsigned nloc = b.st[0], nx = b.st[1];
        if (nloc == 0u) { xcd_barrier_complete(bar, b.x, nloc, nx); b.st[0] = nloc; b.st[1] = nx; }
        const unsigned old = xb_add(&bar[XB_XSUB(b.x)], 1u);
        const unsigned gen = old / nloc;
        if (old + 1u == (gen + 1u) * nloc) {
            __builtin_amdgcn_fence(__ATOMIC_RELEASE, "agent");
            asm volatile("s_waitcnt vmcnt(0)" ::: "memory");
            const unsigned og = xb_add(&bar[XB_TOP], 1u);
            const unsigned tg = og / nx;
            if (og + 1u == (tg + 1u) * nx) xb_add(&bar[XB_TOPGEN], 1u);
            else XB_SPIN(xb_ld(&bar[XB_TOPGEN]) == tg, bar);
            __builtin_amdgcn_fence(__ATOMIC_ACQUIRE, "agent");
            xb_add(&bar[XB_XGEN(b.x)], 1u);
            asm volatile("s_waitcnt vmcnt(0)" ::: "memory");
        } else {
            XB_SPIN(xb_ld(&bar[XB_XGEN(b.x)]) == gen, bar);
            __builtin_amdgcn_fence(__ATOMIC_ACQUIRE, "agent");
            asm volatile("s_waitcnt vmcnt(0)" ::: "memory");
        }
    }
    __syncthreads();
}

__global__ void __launch_bounds__(512) fwd_megakernel(Params P_arg) {
    const Params& P = P_arg;
    extern __shared__ __attribute__((aligned(16))) unsigned char shm[];
    LAS unsigned char* lds = (LAS unsigned char*)shm;
    cg::grid_group grid = cg::this_grid();
    const int G = gridDim.x, bid = blockIdx.x;
    __shared__ uint4 xb_words;
    if (threadIdx.x == 0) xb_words = make_uint4(0u, 0u, 0u, 0u);
    __syncthreads();
    const XcdBarrier xb = xcd_barrier_post((unsigned*)(P.ws + O_BAR), (volatile LAS unsigned*)&xb_words);
#define WSP() const Params P = load_params(); unsigned char* ws = ls(P.ws); bf16_t* WinT = (bf16_t*)(ws + O_WINT); bf16_t* WoutT = (bf16_t*)(ws + O_WOUTT); bf16_t* HMIX = (bf16_t*)(ws + O_HMIX); bf16_t* PROJ = (bf16_t*)(ws + O_PROJ); (void)WinT; (void)WoutT; (void)HMIX; (void)PROJ

    phase0a(P, lds, G);
    grid.sync();
    {
        WSP();
        SchedFold S; S.G = G; S.c = bid;
        EpiFold E; E.WinT = WinT;
        Gemm g; g.A = (const bf16_t*)(ws + O_MTF); g.Bt = (const bf16_t*)(ws + O_WCX); g.K = 512;
        pg8::gemm_phase(lds, g, S, E);
        const float* modp = (const float*)(ws + O_MODP); float* mod = (float*)(ws + O_MOD);
        for (int e = bid * 512 + threadIdx.x; e < DEPTH * 3 * 1536; e += G * 512) {
            const int n4 = (e % 1536) * 4, lr = e / 1536, l = lr / 3, r = lr % 3;
            f32x4 a = *(const f32x4*)(P.b_mod + (size_t)l * 6144 + n4);
            for (int s = 0; s < 32; ++s) a += *(const f32x4*)(modp + ((size_t)(l * 32 + s) * 3 + r) * 6144 + n4);
            *(f32x4*)(mod + (size_t)lr * 6144 + n4) = a;
        }
    }
    xcd_barrier(xb);
#pragma unroll 1
    for (int layer = 0; layer < DEPTH; ++layer) {
        const bool lastl = layer == DEPTH - 1;
        row_phase(P, layer, G);
        xcd_barrier(xb);
        {
            WSP();
            SchedIn S; S.init(66, 22, G, bid);
            EpiIn E; E.PROJ = PROJ; E.avT = (bf16_t*)(ws + O_AVT); E.VT = (bf16_t*)(ws + O_VT); E.VTc = (bf16_t*)(ws + O_VTC); E.ZT = (bf16_t*)(ws + O_ZT); E.ZTc = (bf16_t*)(ws + O_ZTC); E.rope = (const float2*)(ws + O_ROPE);
            Gemm g; g.A = HMIX; g.Bt = WinT + (size_t)layer * NCOL * DM; g.K = DM;
            pg8::gemm_phase(lds, g, S, E);
        }
        xcd_barrier(xb);
        {
            WSP();
            for (int task = bid; task < 512; task += G) attn_task(P, layer, task, lds);
            {   SchedFew S; S.n = 256; S.G = G; S.c = bid;
                EpiS1 E; E.Bint = (bf16_t*)(ws + O_BINT);
                Gemm g; g.A = (const bf16_t*)(ws + O_F128); g.Bt = (const bf16_t*)(ws + O_ZT); g.K = 256;
                pg8::gemm_phase(lds, g, S, E); }
            const int nch = lastl ? 128 : 132;
            for (int ch = bid; ch < nch; ch += G) gmlp_task(P, layer, ch, lds);
            if (!lastl) {
                const int c2 = (bid - 132 + G) % G;
                for (int t = c2; t < 16; t += G) attn_task(P, layer, 512 + t, lds);
                __syncthreads();
                SchedFew S; S.n = 4; S.G = G; S.c = (bid - 148 + G) % G;
                EpiCtxF E; E.MIX = HMIX; E.PROJ = PROJ; E.bf = P.b_f + (size_t)layer * 512;
                Gemm g; g.A = (const bf16_t*)(ws + O_DCTX); g.Bt = (const bf16_t*)(ws + O_ZTC); g.K = 512;
                pg8::gemm_phase(lds, g, S, E);
            }
        }
        xcd_barrier(xb);
        stage2_phase(P, layer, G);
        if (!lastl) for (int tile = bid; tile < 256; tile += G) ctx_outproj_tile(P, layer, tile, lds);
        xcd_barrier(xb);
        {
            WSP();
            pg8::StaticOrder S; S.init(64, 8, G, bid);
            EpiOut E; E.Y = PROJ;
            Gemm g; g.A = HMIX; g.Bt = WoutT + (size_t)layer * DM * DM; g.K = DM;
            pg8::gemm_phase(lds, g, S, E);
        }
        xcd_barrier(xb);
    }
    row_phase(P, DEPTH, G);
}

extern "C" void kernel_launch(void* const* d_in, const int* in_sizes, int n_in, void* d_out, int out_size, void* d_ws, size_t ws_size, hipStream_t stream) {
    constexpr size_t kDynLds = LDS_TOTAL;
    static int grid_blocks = 0;
    if (!grid_blocks) {
        if (ws_size < WS_END) { fprintf(stderr, "kernel_launch: workspace too small: %zu < %zu\n", ws_size, (size_t)WS_END); grid_blocks = -1; return; }
        int dev = 0, cus = 0, per_cu = 0;
        hipGetDevice(&dev);
        hipDeviceGetAttribute(&cus, hipDeviceAttributeMultiprocessorCount, dev);
        hipFuncSetAttribute((const void*)fwd_megakernel, hipFuncAttributeMaxDynamicSharedMemorySize, (int)kDynLds);
        hipOccupancyMaxActiveBlocksPerMultiprocessor(&per_cu, (const void*)fwd_megakernel, 512, kDynLds);
        if (per_cu < 1) { fprintf(stderr, "kernel_launch: occupancy query says %d blocks/CU\n", per_cu); per_cu = 1; }
        grid_blocks = cus * 1;
    }
    if (grid_blocks < 0) return;
    Params p{};
    p.x = (const float*)d_in[0]; p.c = (const float*)d_in[1]; p.ctx = (const float*)d_in[2]; p.c_ctx = (const float*)d_in[3];
    p.w_mod = (const float*)d_in[4]; p.b_mod = (const float*)d_in[5]; p.g_pre = (const float*)d_in[6]; p.g_post = (const float*)d_in[7];
    p.w_in = (const float*)d_in[8]; p.w_out = (const float*)d_in[9]; p.g_sgu = (const float*)d_in[10]; p.w_sgu = (const float*)d_in[11];
    p.b_sgu = (const float*)d_in[12]; p.sink = (const float*)d_in[13]; p.w_f = (const float*)d_in[14]; p.b_f = (const float*)d_in[15];
    p.out = (float*)d_out; p.ws = (unsigned char*)d_ws;
    (void)hipMemsetAsync((unsigned char*)d_ws + O_BAR, 0, XCD_BAR_WORDS * 4, stream);
    void* args[] = {&p};
    hipError_t e = hipLaunchCooperativeKernel((const void*)fwd_megakernel, dim3(grid_blocks), dim3(512), args, kDynLds, stream);
    if (e != hipSuccess) fprintf(stderr, "cooperative launch failed: %s (grid %d)\n", hipGetErrorString(e), grid_blocks);
}
```

```cpp
#include <hip/hip_runtime.h>
#include <hip/hip_cooperative_groups.h>
#include <cstdio>
#include <cstdint>
namespace cg = cooperative_groups;

#define LAS __attribute__((address_space(3)))
typedef unsigned short bf16_t;
typedef short bf16x8 __attribute__((ext_vector_type(8)));
typedef short bf16x4 __attribute__((ext_vector_type(4)));
typedef float f32x4 __attribute__((ext_vector_type(4)));
typedef unsigned u32x2 __attribute__((ext_vector_type(2)));
typedef unsigned u32x4 __attribute__((ext_vector_type(4)));

constexpr int DM = 2048, SEQ = 8192, NB = 2, DEPTH = 4, CTXL = 256;
constexpr int MLAT = NB * SEQ;
constexpr int MROWS = MLAT + NB * CTXL;
constexpr int NCOL = 5632;
constexpr int C_AU = 0, C_AV = 512, C_AG = 1024, C_Q = 1536, C_K = 2560, C_V = 2816, C_BG = 3072, C_ZR = 4096, C_CG = 5120;
constexpr float EPS = 1e-6f;
constexpr float QSCALE = 0.08838834764831845f * 1.4426950408889634f;
constexpr float LOG2E = 1.4426950408889634f;

constexpr size_t AL(size_t x) { return (x + 255) & ~(size_t)255; }
constexpr size_t O_WINT = 0;
constexpr size_t O_WOUTT = O_WINT + AL((size_t)DEPTH * NCOL * DM * 2);
constexpr size_t O_MOD = O_WOUTT + AL((size_t)DEPTH * DM * DM * 2);
constexpr size_t O_ROPE = O_MOD + AL((size_t)DEPTH * 3 * 6144 * 4);
constexpr size_t O_TWID = O_ROPE + AL((size_t)128 * 32 * 8);
constexpr size_t O_F128 = O_TWID + AL((size_t)8192 * 8);
constexpr size_t O_F64 = O_F128 + AL((size_t)256 * 256 * 2);
constexpr size_t O_DCTX = O_F64 + AL((size_t)64 * 128 * 2);
constexpr size_t O_XC = O_DCTX + AL((size_t)256 * 512 * 2);
constexpr size_t O_HMIX = O_XC + AL((size_t)512 * DM * 4);
constexpr size_t O_PROJ = O_HMIX + AL((size_t)MROWS * DM * 2);
constexpr size_t O_AVT = O_PROJ + AL((size_t)MROWS * NCOL * 2);
constexpr size_t O_VT = O_AVT + AL((size_t)132 * 512 * 128 * 2);
constexpr size_t O_VTC = O_VT + AL((size_t)NB * 2 * 128 * SEQ * 2);
constexpr size_t O_ZT = O_VTC + AL((size_t)NB * 2 * 128 * CTXL * 2);
constexpr size_t O_ZTC = O_ZT + AL((size_t)NB * 512 * 64 * 256 * 2);
constexpr size_t O_BINT = O_ZTC + AL((size_t)NB * 512 * 512 * 2);
constexpr size_t O_YC = O_BINT + AL((size_t)NB * 128 * 512 * 128 * 2);
constexpr size_t O_BAR = O_YC + AL((size_t)512 * DM * 2);
constexpr size_t O_WCX = O_BAR + 16384;
constexpr size_t O_MTF = O_WCX + AL((size_t)DEPTH * DM * 512 * 2);
constexpr size_t O_MODP = O_MTF + AL((size_t)DEPTH * 1024 * 512 * 2);
constexpr size_t O_P0END = O_MODP + AL((size_t)DEPTH * 32 * 3 * 6144 * 4);
constexpr size_t O_XB = O_WCX;
constexpr size_t WS_END = (O_XB + (size_t)MLAT * DM * 2 > O_P0END) ? O_XB + (size_t)MLAT * DM * 2 : O_P0END;

struct Params {
    const float *x, *c, *ctx, *c_ctx, *w_mod, *b_mod, *g_pre, *g_post, *w_in, *w_out, *g_sgu, *w_sgu, *b_sgu, *sink, *w_f, *b_f;
    float* out;
    unsigned char* ws;
};

__device__ __forceinline__ Params load_params() {
#if defined(__HIP_DEVICE_COMPILE__)
    auto p = __builtin_amdgcn_kernarg_segment_ptr(); asm volatile("" : "+s"(p));
    return *(const __attribute__((address_space(4))) Params*)p;
#else
    return Params{};
#endif
}
__device__ __forceinline__ int lv(int x) { asm volatile("" : "+v"(x)); return x; }
template <class T> __device__ __forceinline__ T* ls(T* p) { asm volatile("" : "+s"(p)); return p; }
__device__ __forceinline__ unsigned cvt_pk_bf16(float lo, float hi) { unsigned r; asm volatile("v_cvt_pk_bf16_f32 %0, %1, %2" : "=v"(r) : "v"(lo), "v"(hi)); return r; }
__device__ __forceinline__ bf16_t f2bf(float v) { return (bf16_t)(cvt_pk_bf16(v, 0.f) & 0xffffu); }
__device__ __forceinline__ float bf2f(unsigned b) { return __uint_as_float(b << 16); }
__device__ __forceinline__ float bflo(unsigned w) { return __uint_as_float(w << 16); }
__device__ __forceinline__ float bfhi(unsigned w) { return __uint_as_float(w & 0xffff0000u); }
__device__ __forceinline__ float gelu_t(float x) { const float u2 = x * (x * x * (-2.f * 0.7978845608028654f * 0.044715f * 1.4426950408889634f) + (-2.f * 0.7978845608028654f * 1.4426950408889634f)); return x * __builtin_amdgcn_rcpf(1.f + __builtin_amdgcn_exp2f(u2)); }
__device__ __forceinline__ float silu_f(float x) { return x * __builtin_amdgcn_rcpf(1.f + __builtin_amdgcn_exp2f(x * -1.4426950408889634f)); }
__device__ __forceinline__ float wave_sum(float v) {
#pragma unroll
    for (int o = 1; o < 64; o <<= 1) v += __shfl_xor(v, o);
    return v;
}
__device__ __forceinline__ float xor16_max(float x) { auto r = __builtin_amdgcn_permlane16_swap(__float_as_uint(x), __float_as_uint(x), false, false); return fmaxf(__uint_as_float(r[0]), __uint_as_float(r[1])); }
__device__ __forceinline__ float xor32_max(float x) { auto r = __builtin_amdgcn_permlane32_swap(__float_as_uint(x), __float_as_uint(x), false, false); return fmaxf(__uint_as_float(r[0]), __uint_as_float(r[1])); }
__device__ __forceinline__ float xor16_sum(float x) { auto r = __builtin_amdgcn_permlane16_swap(__float_as_uint(x), __float_as_uint(x), false, false); return __uint_as_float(r[0]) + __uint_as_float(r[1]); }
__device__ __forceinline__ float xor32_sum(float x) { auto r = __builtin_amdgcn_permlane32_swap(__float_as_uint(x), __float_as_uint(x), false, false); return __uint_as_float(r[0]) + __uint_as_float(r[1]); }
__device__ __forceinline__ u32x2 pack4(float a, float b, float c, float d) { u32x2 r; r.x = cvt_pk_bf16(a, b); r.y = cvt_pk_bf16(c, d); return r; }

namespace pg8 {
constexpr int BM = 256, BK = 64, HALF = 128, HTB = HALF * BK * 2, STAGE_BYTES = 8 * HTB, NXCD = 8, WGM = 8;
__host__ __device__ __forceinline__ int lds_byte(int r, int c) { const int st = (r >> 4) * 2 + (c >> 5), rr = r & 15, cc = c & 31, ob = rr * 64 + cc * 2; return st * 1024 + (ob ^ (((ob >> 9) & 1) << 5)); }
__host__ __device__ __forceinline__ void stage_rc(int b, int& R, int& C) { const int st = b / 1024, sb = b % 1024, swz = sb ^ (((sb >> 9) & 1) << 5); R = (st >> 1) * 16 + swz / 64; C = (st & 1) * 32 + (swz % 64) / 2; }
__host__ __device__ __forceinline__ int perm32(int rho) { const int n = rho >> 4, i = rho & 15; return 8 * (i >> 2) + 4 * n + (i & 3); }
struct Unit { int pm, pn; };
struct Gemm { const bf16_t* A; const bf16_t* Bt; int K; };

struct SchedBase {
    __device__ __forceinline__ void amap(const Unit& u, const Gemm& g, const char*& base, unsigned& rs, unsigned& hs) const {
        rs = (unsigned)g.K * 2u; hs = (unsigned)HALF * g.K * 2u; base = (const char*)g.A + (size_t)u.pm * BM * g.K * 2;
    }
    __device__ __forceinline__ void bmap(const Unit& u, const Gemm& g, const char*& base, unsigned& rs, unsigned& hs) const {
        rs = (unsigned)g.K * 2u; hs = (unsigned)HALF * g.K * 2u; base = (const char*)g.Bt + (size_t)u.pn * BM * g.K * 2;
    }
};
struct StaticOrder : SchedBase {
    int nM, nN, nwg, G, c;
    __device__ void init(int nM_, int nN_, int G_, int c_) { nM = nM_; nN = nN_; nwg = nM * nN; G = G_; c = c_; }
    __device__ bool next(int i, Unit& u) const {
        const long L = (long)i * G + c; if (L >= nwg) return false;
        int wgid = (int)L; { const int q = nwg / NXCD, r = nwg % NXCD, xcd = wgid % NXCD, off = wgid / NXCD; wgid = (xcd < r ? xcd * (q + 1) : r * (q + 1) + (xcd - r) * q) + off; }
        const int nig = WGM * nN, gid = wgid / nig, fm = gid * WGM, gsz = (nM - fm) < WGM ? (nM - fm) : WGM;
        u.pm = fm + ((wgid % nig) % gsz); u.pn = (wgid % nig) / gsz; return true;
    }
};

template <class Epi, class Sched>
__device__ __forceinline__ void gemm_phase(LAS unsigned char* lds, const Gemm g, const Sched& S, const Epi& E) {
    const int tid = lv(threadIdx.x), wid = __builtin_amdgcn_readfirstlane(tid >> 6), lane = tid & 63, wr = wid >> 2, wc = wid & 3, fr = lane & 15, fq = lane >> 4;
    int K = g.K; asm volatile("" : "+s"(K));
    const int nt = K / BK;
#define PG8_VOFFB(dst, rs) do { const int _t = lv(tid); _Pragma("unroll") for (int _i = 0; _i < 2; ++_i) { int _R, _C; stage_rc(_t * 16 + _i * 8192, _R, _C); const int _Rb = (_R & ~31) + perm32(_R & 31); dst[_i] = (unsigned)_Rb * (rs) + (unsigned)_C * 2u; } } while (0)
#define PG8_VOFFA(dst, rs) do { const int _t = lv(tid); _Pragma("unroll") for (int _i = 0; _i < 2; ++_i) { int _R, _C; stage_rc(_t * 16 + _i * 8192, _R, _C); dst[_i] = (unsigned)_R * (rs) + (unsigned)_C * 2u; } } while (0)
    const size_t kstep = (size_t)(BK * 2);
    const unsigned ldsw = (unsigned)wid * 1024u;
    const int aoff = lds_byte(wr * 64 + fr, fq * 8), boff = lds_byte(wc * 32 + fr, fq * 8);
#define PG8_SA(b, h) (((b) * 2 + (h)) * HTB)
#define PG8_SB(b, h) ((4 + (b) * 2 + (h)) * HTB)
#define PG8_STAGE(bufoff, gbase, voff) do { _Pragma("unroll") for (int _i = 0; _i < 2; ++_i) \
        __builtin_amdgcn_global_load_lds((const unsigned*)((const char*)(gbase) + (voff)[_i]), (LAS unsigned*)(lds + (bufoff) + ldsw + _i * 8192), 16, 0, 0); } while (0)
#define PG8_LDA(dst, b, h) do { _Pragma("unroll") for (int m = 0; m < 4; ++m) _Pragma("unroll") for (int k = 0; k < 2; ++k) dst[m][k] = *(const LAS bf16x8*)(lds + PG8_SA(b, h) + aoff + m * 2048 + k * 1024); } while (0)
#define PG8_LDB(dst, b, h) do { _Pragma("unroll") for (int n = 0; n < 2; ++n) _Pragma("unroll") for (int k = 0; k < 2; ++k) dst[n][k] = *(const LAS bf16x8*)(lds + PG8_SB(b, h) + boff + n * 2048 + k * 1024); } while (0)
#define PG8_MMA(ai, bj, At, Bt) do { __builtin_amdgcn_s_setprio(1); _Pragma("unroll") for (int m = 0; m < 4; ++m) _Pragma("unroll") for (int n = 0; n < 2; ++n) _Pragma("unroll") for (int k = 0; k < 2; ++k) \
        acc[ai][bj][m][n] = __builtin_amdgcn_mfma_f32_16x16x32_bf16(Bt[n][k], At[m][k], acc[ai][bj][m][n], 0, 0, 0); __builtin_amdgcn_s_setprio(0); } while (0)
#define PG8_WAIT_V(n) asm volatile("s_waitcnt vmcnt(" #n ")" ::: "memory")
#define PG8_WAIT_L(n) asm volatile("s_waitcnt lgkmcnt(" #n ")" ::: "memory")
#define PG8_BAR __builtin_amdgcn_s_barrier()
#define PG8_SCHED __builtin_amdgcn_sched_barrier(0)
    Unit cur, nxt; int ui = 0;
    if (!S.next(0, cur)) return;
    f32x4 acc[2][2][4][2];
#pragma unroll
    for (int a = 0; a < 2; ++a)
#pragma unroll
        for (int b = 0; b < 2; ++b)
#pragma unroll
            for (int m = 0; m < 4; ++m)
#pragma unroll
                for (int n = 0; n < 2; ++n) acc[a][b][m][n] = (f32x4){0.f, 0.f, 0.f, 0.f};
    bf16x8 At[4][2], B0[2][2], B1[2][2];
    const char* cA; unsigned cRS, cHS; S.amap(cur, g, cA, cRS, cHS);
    unsigned vAc[2]; PG8_VOFFA(vAc, cRS);
    const char* cB; unsigned cRSB, cHSB; S.bmap(cur, g, cB, cRSB, cHSB);
    unsigned vBc[2]; PG8_VOFFB(vBc, cRSB);
    PG8_STAGE(PG8_SB(0, 0), cB, vBc); PG8_STAGE(PG8_SB(0, 1), cB + cHSB, vBc); PG8_STAGE(PG8_SA(0, 0), cA, vAc); PG8_STAGE(PG8_SA(0, 1), cA + cHS, vAc);
    if (wr == 1) PG8_BAR;
    PG8_WAIT_V(2); PG8_BAR;
    PG8_STAGE(PG8_SB(1, 0), cB + kstep, vBc); PG8_STAGE(PG8_SA(1, 0), cA + kstep, vAc); PG8_STAGE(PG8_SB(1, 1), cB + cHSB + kstep, vBc);
    PG8_WAIT_V(6); PG8_BAR;
    for (;;) {
        const bool has_next = S.next(ui + 1, nxt);
        const char* nA = cA; unsigned nRS = cRS, nHS = cHS; const char* nB = cB; unsigned nRSB = cRSB, nHSB = cHSB;
        if (has_next) { S.amap(nxt, g, nA, nRS, nHS); S.bmap(nxt, g, nB, nRSB, nHSB); }
        for (int t = 0; t < nt; t += 2) {
            const bool last = (t == nt - 2);
            const char* a1 = cA + (size_t)(t + 1) * kstep;
            const char* a2 = last ? nA : cA + (size_t)(t + 2) * kstep; const char* b2 = last ? nB : cB + (size_t)(t + 2) * kstep;
            const char* a3 = a2 + kstep; const char* b3 = b2 + kstep;
            const unsigned hs2 = last ? nHS : cHS;
            unsigned v2[2] = {vAc[0], vAc[1]}; if (last) PG8_VOFFA(v2, nRS);
            const unsigned hsB2 = last ? nHSB : cHSB;
            unsigned vB2[2] = {vBc[0], vBc[1]}; if (last) PG8_VOFFB(vB2, nRSB);
            PG8_LDB(B0, 0, 0); PG8_LDB(B1, 0, 1); PG8_SCHED; PG8_LDA(At, 0, 0); PG8_STAGE(PG8_SA(1, 1), a1 + cHS, vAc);
            PG8_WAIT_V(8); PG8_WAIT_L(0); PG8_BAR; PG8_MMA(0, 0, At, B0); PG8_MMA(0, 1, At, B1); PG8_BAR; PG8_SCHED;
            PG8_LDA(At, 0, 1); PG8_STAGE(PG8_SB(0, 0), b2, vB2); PG8_STAGE(PG8_SB(0, 1), b2 + hsB2, vB2); PG8_STAGE(PG8_SA(0, 0), a2, v2);
            PG8_WAIT_V(8); PG8_WAIT_L(0); PG8_BAR; PG8_MMA(1, 0, At, B0); PG8_MMA(1, 1, At, B1); PG8_BAR; PG8_SCHED;
            PG8_LDB(B0, 1, 0); PG8_LDB(B1, 1, 1); PG8_SCHED; PG8_LDA(At, 1, 0); PG8_STAGE(PG8_SA(0, 1), a2 + hs2, v2);
            PG8_WAIT_V(8); PG8_WAIT_L(0); PG8_BAR; PG8_MMA(0, 0, At, B0); PG8_MMA(0, 1, At, B1); PG8_BAR; PG8_SCHED;
            PG8_LDA(At, 1, 1); PG8_STAGE(PG8_SB(1, 0), b3, vB2); PG8_STAGE(PG8_SB(1, 1), b3 + hsB2, vB2); PG8_STAGE(PG8_SA(1, 0), a3, v2);
            PG8_WAIT_V(8); PG8_WAIT_L(0); PG8_BAR; PG8_MMA(1, 0, At, B0); PG8_MMA(1, 1, At, B1); PG8_BAR; PG8_SCHED;
        }
        if (wr == 0) PG8_BAR;
        { const int l2 = lv(threadIdx.x) & 63; E(acc, cur, wr, wc, l2 & 15, l2 >> 4); }
        if (!has_next) break;
#pragma unroll
        for (int a = 0; a < 2; ++a)
#pragma unroll
            for (int b = 0; b < 2; ++b)
#pragma unroll
                for (int m = 0; m < 4; ++m)
#pragma unroll
                    for (int n = 0; n < 2; ++n) acc[a][b][m][n] = (f32x4){0.f, 0.f, 0.f, 0.f};
        cur = nxt; cA = nA; cRS = nRS; cHS = nHS; PG8_VOFFA(vAc, cRS); cB = nB; cRSB = nRSB; cHSB = nHSB; PG8_VOFFB(vBc, cRSB); ++ui;
        if (wr == 1) PG8_BAR;
    }
    PG8_WAIT_V(0);
    PG8_BAR;
#undef PG8_VOFFA
#undef PG8_VOFFB
#undef PG8_SA
#undef PG8_SB
#undef PG8_STAGE
#undef PG8_LDA
#undef PG8_LDB
#undef PG8_MMA
#undef PG8_WAIT_V
#undef PG8_WAIT_L
#undef PG8_BAR
#undef PG8_SCHED
}
}
using pg8::Unit;
using pg8::Gemm;

__device__ __forceinline__ bool in_swapped(int pn) { return pn == 2 || pn == 3 || pn == 11 || (pn >= 16 && pn < 20); }
struct SchedIn : pg8::StaticOrder {
    __device__ __forceinline__ void tokmap(const Unit& u, bool gather, const Gemm& g, const char*& base, unsigned& rs, unsigned& hs) const {
        if (gather && u.pm < 64) { const int b = u.pm >> 5, t20 = 2 * (u.pm & 31); rs = 64u * DM * 2u; hs = DM * 2u; base = (const char*)g.A + ((size_t)b * SEQ + t20) * DM * 2; }
        else { rs = DM * 2u; hs = 128u * DM * 2u; base = (const char*)g.A + (size_t)u.pm * 256 * DM * 2; }
    }
    __device__ __forceinline__ void wmap(const Unit& u, const Gemm& g, const char*& base, unsigned& rs, unsigned& hs) const {
        rs = DM * 2u; hs = 128u * DM * 2u; base = (const char*)g.Bt + (size_t)u.pn * 256 * DM * 2;
    }
    __device__ __forceinline__ void amap(const Unit& u, const Gemm& g, const char*& base, unsigned& rs, unsigned& hs) const {
        if (in_swapped(u.pn)) wmap(u, g, base, rs, hs); else tokmap(u, false, g, base, rs, hs);
    }
    __device__ __forceinline__ void bmap(const Unit& u, const Gemm& g, const char*& base, unsigned& rs, unsigned& hs) const {
        if (in_swapped(u.pn)) tokmap(u, u.pn >= 16, g, base, rs, hs); else wmap(u, g, base, rs, hs);
    }
};
struct SchedFold : pg8::SchedBase {
    int G, c;
    __device__ bool next(int i, Unit& u) const { const int L = i * G + c; if (L >= 128) return false; const int l = L >> 5, r = L & 31; u.pm = l * 4 + (r >> 3); u.pn = l * 8 + (r & 7); return true; }
};
struct SchedFew : pg8::SchedBase {
    int n, G, c;
    __device__ bool next(int i, Unit& u) const { const int L = i * G + c; if (c < 0 || L >= n) return false; u.pm = 0; u.pn = L; return true; }
};

struct EpiIn {
    bf16_t *PROJ, *avT, *VT, *VTc, *ZT, *ZTc; const float2* rope;
    __device__ __forceinline__ void operator()(const f32x4 (&acc)[2][2][4][2], const Unit& u, int wr, int wc, int fr, int fq) const {
        if (in_swapped(u.pn)) {
#pragma unroll
            for (int ai = 0; ai < 2; ++ai) {
                const int nt = 2 * u.pn + ai;
#pragma unroll
                for (int m = 0; m < 4; ++m) {
                    const int ch = wr * 64 + m * 16 + lv(fr);
#pragma unroll
                    for (int bj = 0; bj < 2; ++bj) {
                        const f32x4 v0 = acc[ai][bj][m][0], v1 = acc[ai][bj][m][1];
                        const int tk = 32 * wc + 8 * fq;
                        bf16_t* dst;
                        u32x4 pk;
                        if (nt < 8) {
                            const int chunk = u.pm * 2 + bj;
                            dst = avT + ((size_t)chunk * 512 + (nt - 4) * 128 + ch) * 128 + tk;
                            pk.x = cvt_pk_bf16(gelu_t(v0[0]), gelu_t(v0[1])); pk.y = cvt_pk_bf16(gelu_t(v0[2]), gelu_t(v0[3])); pk.z = cvt_pk_bf16(gelu_t(v1[0]), gelu_t(v1[1])); pk.w = cvt_pk_bf16(gelu_t(v1[2]), gelu_t(v1[3]));
                        } else {
                            pk.x = cvt_pk_bf16(v0[0], v0[1]); pk.y = cvt_pk_bf16(v0[2], v0[3]); pk.z = cvt_pk_bf16(v1[0], v1[1]); pk.w = cvt_pk_bf16(v1[2], v1[3]);
                            if (nt < 24) {
                                const int kvh = nt - 22, row = u.pm * 256 + bj * 128 + tk;
                                if (row < MLAT) dst = VT + ((size_t)((row >> 13) * 2 + kvh) * 128 + ch) * SEQ + (row & 8191);
                                else { const int rc = row - MLAT; dst = VTc + ((size_t)((rc >> 8) * 2 + kvh) * 128 + ch) * CTXL + (rc & 255); }
                            } else {
                                const int ri = (nt - 32) >> 2, j = ((nt - 32) & 3) * 128 + ch;
                                if (u.pm < 64) { const int b = u.pm >> 5, t2 = 2 * (u.pm & 31) + bj; dst = ZT + (((size_t)(b * 512 + j) * 64 + t2) * 256) + ri * 128 + tk; }
                                else { const int rc = (u.pm - 64) * 256 + bj * 128 + tk; dst = ZTc + ((size_t)((rc >> 8) * 512 + j) * 512) + ri * 256 + (rc & 255); }
                            }
                        }
                        *(u32x4*)dst = pk;
                    }
                    asm volatile("" ::: "memory");
                }
            }
            return;
        }
#pragma unroll
        for (int bj = 0; bj < 2; ++bj) {
            const int nt = 2 * u.pn + bj;
            const int colt = nt * 128 + 32 * wc + 8 * fq;
            if (nt < 4 || (nt >= 8 && nt < 12) || (nt >= 24 && nt < 32) || nt >= 40) {
                const bool is_gelu = nt < 4;
#pragma unroll
                for (int ai = 0; ai < 2; ++ai)
#pragma unroll
                    for (int m = 0; m < 4; ++m) {
                        const size_t row = (size_t)u.pm * 256 + ai * 128 + wr * 64 + m * 16 + lv(fr);
                        const f32x4 v0 = acc[ai][bj][m][0], v1 = acc[ai][bj][m][1]; float o[8];
#pragma unroll
                        for (int i = 0; i < 4; ++i) { o[i] = is_gelu ? gelu_t(v0[i]) : silu_f(v0[i]); o[4 + i] = is_gelu ? gelu_t(v1[i]) : silu_f(v1[i]); }
                        u32x4 pk; pk.x = cvt_pk_bf16(o[0], o[1]); pk.y = cvt_pk_bf16(o[2], o[3]); pk.z = cvt_pk_bf16(o[4], o[5]); pk.w = cvt_pk_bf16(o[6], o[7]);
                        *(u32x4*)(PROJ + row * NCOL + colt) = pk;
                        asm volatile("" ::: "memory");
                    }
            } else if (nt < 8) {
#pragma unroll
                for (int ai = 0; ai < 2; ++ai)
#pragma unroll
                    for (int m = 0; m < 4; ++m) {
                        const int row = u.pm * 256 + ai * 128 + wr * 64 + m * 16 + lv(fr);
                        const int chunk = row >> 7, q = row & 127;
#pragma unroll
                        for (int n = 0; n < 2; ++n) {
                            f32x4 v = acc[ai][bj][m][n];
                            const int c0 = (nt - 4) * 128 + 32 * wc + 8 * fq + 4 * n;
#pragma unroll
                            for (int i = 0; i < 4; ++i) avT[((size_t)chunk * 512 + c0 + i) * 128 + q] = f2bf(gelu_t(v[i]));
                            asm volatile("" ::: "memory");
                        }
                    }
            } else if (nt < 22) {
                const bool isq = nt < 20; const float sc = isq ? QSCALE : 1.f;
                const bool lat = u.pm < 64;
                float frev[4];
#pragma unroll
                for (int i = 0; i < 4; ++i) frev[i] = __builtin_amdgcn_exp2f(-(float)((wc & 1) * 16 + fq * 4 + i) * (13.287712379549449f / 32.f)) * 0.15915494309189535f;
#pragma unroll
                for (int ai = 0; ai < 2; ++ai)
#pragma unroll
                    for (int m = 0; m < 4; ++m) {
                        const size_t row = (size_t)u.pm * 256 + ai * 128 + wr * 64 + m * 16 + lv(fr);
                        const int tpos = (int)(row & 8191);
                        const int pos = (wc < 2) ? (tpos >> 6) : (tpos & 63);
                        const f32x4 x0 = acc[ai][bj][m][0], x1 = acc[ai][bj][m][1];
                        float o0[4], o1[4];
                        if (lat) {
#pragma unroll
                            for (int i = 0; i < 4; ++i) { const float rev = (float)pos * frev[i]; const float cx = __builtin_amdgcn_cosf(rev), sx = __builtin_amdgcn_sinf(rev);
                                o0[i] = (x0[i] * cx - x1[i] * sx) * sc; o1[i] = (x1[i] * cx + x0[i] * sx) * sc; }
                        } else {
#pragma unroll
                            for (int i = 0; i < 4; ++i) { o0[i] = x0[i] * sc; o1[i] = x1[i] * sc; }
                        }
                        u32x4 pk; pk.x = cvt_pk_bf16(o0[0], o0[1]); pk.y = cvt_pk_bf16(o0[2], o0[3]); pk.z = cvt_pk_bf16(o1[0], o1[1]); pk.w = cvt_pk_bf16(o1[2], o1[3]);
                        *(u32x4*)(PROJ + row * NCOL + colt) = pk;
                        asm volatile("" ::: "memory");
                    }
            } else if (nt < 24) {
                const int kvh = nt - 22;
#pragma unroll
                for (int ai = 0; ai < 2; ++ai)
#pragma unroll
                    for (int m = 0; m < 4; ++m) {
                        const int row = u.pm * 256 + ai * 128 + wr * 64 + m * 16 + lv(fr);
#pragma unroll
                        for (int n = 0; n < 2; ++n) {
                            f32x4 v = acc[ai][bj][m][n];
                            const int d0 = 32 * wc + 8 * fq + 4 * n;
                            if (row < MLAT) { const int b = row >> 13, t = row & 8191;
#pragma unroll
                                for (int i = 0; i < 4; ++i) VT[((size_t)(b * 2 + kvh) * 128 + d0 + i) * SEQ + t] = f2bf(v[i]);
                            } else { const int rc = row - MLAT, b = rc >> 8, t = rc & 255;
#pragma unroll
                                for (int i = 0; i < 4; ++i) VTc[((size_t)(b * 2 + kvh) * 128 + d0 + i) * CTXL + t] = f2bf(v[i]);
                            }
                            asm volatile("" ::: "memory");
                        }
                    }
            } else {
                const int ri = (nt - 32) >> 2, jt = ((nt - 32) & 3) * 128;
#pragma unroll
                for (int ai = 0; ai < 2; ++ai)
#pragma unroll
                    for (int m = 0; m < 4; ++m) {
                        const int R = wr * 64 + m * 16 + lv(fr);
#pragma unroll
                        for (int n = 0; n < 2; ++n) {
                            f32x4 v = acc[ai][bj][m][n];
                            const int j0 = jt + 32 * wc + 8 * fq + 4 * n;
                            if (u.pm < 64) { const int b = u.pm >> 5, t2 = 2 * (u.pm & 31) + ai;
#pragma unroll
                                for (int i = 0; i < 4; ++i) ZT[(((size_t)(b * 512 + j0 + i) * 64 + t2) * 256) + ri * 128 + R] = f2bf(v[i]);
                            } else { const int rc = (u.pm - 64) * 256 + ai * 128 + R, b = rc >> 8, t = rc & 255;
#pragma unroll
                                for (int i = 0; i < 4; ++i) ZTc[((size_t)(b * 512 + j0 + i) * 512) + ri * 256 + t] = f2bf(v[i]);
                            }
                            asm volatile("" ::: "memory");
                        }
                    }
            }
        }
    }
};
struct EpiOut {
    bf16_t* Y;
    __device__ __forceinline__ void operator()(const f32x4 (&acc)[2][2][4][2], const Unit& u, int wr, int wc, int fr, int fq) const {
#pragma unroll
        for (int ai = 0; ai < 2; ++ai)
#pragma unroll
            for (int m = 0; m < 4; ++m) {
                const size_t row = (size_t)u.pm * 256 + ai * 128 + wr * 64 + m * 16 + fr;
#pragma unroll
                for (int bj = 0; bj < 2; ++bj) { const f32x4 v0 = acc[ai][bj][m][0], v1 = acc[ai][bj][m][1];
                    u32x4 pk; pk.x = cvt_pk_bf16(v0[0], v0[1]); pk.y = cvt_pk_bf16(v0[2], v0[3]); pk.z = cvt_pk_bf16(v1[0], v1[1]); pk.w = cvt_pk_bf16(v1[2], v1[3]);
                    *(u32x4*)(Y + row * DM + u.pn * 256 + bj * 128 + 32 * wc + 8 * fq) = pk; }
            }
    }
};
struct EpiFold {
    bf16_t* WinT;
    __device__ __forceinline__ void operator()(const f32x4 (&acc)[2][2][4][2], const Unit& u, int wr, int wc, int fr, int fq) const {
        const int l = u.pm >> 2;
#pragma unroll
        for (int ai = 0; ai < 2; ++ai)
#pragma unroll
            for (int m = 0; m < 4; ++m) {
                const size_t r = (size_t)(u.pm & 3) * 256 + ai * 128 + wr * 64 + m * 16 + fr;
#pragma unroll
                for (int bj = 0; bj < 2; ++bj) { const f32x4 v0 = acc[ai][bj][m][0], v1 = acc[ai][bj][m][1];
                    u32x4 pk; pk.x = cvt_pk_bf16(v0[0], v0[1]); pk.y = cvt_pk_bf16(v0[2], v0[3]); pk.z = cvt_pk_bf16(v1[0], v1[1]); pk.w = cvt_pk_bf16(v1[2], v1[3]);
                    *(u32x4*)(WinT + ((size_t)l * NCOL + C_ZR + r) * DM + (u.pn & 7) * 256 + bj * 128 + 32 * wc + 8 * fq) = pk; }
            }
    }
};
struct EpiS1 {
    bf16_t* Bint;
    __device__ __forceinline__ void operator()(const f32x4 (&acc)[2][2][4][2], const Unit& u, int wr, int wc, int fr, int fq) const {
#pragma unroll
        for (int m = 0; m < 4; ++m) {
            const int k1 = lv(wr * 64 + m * 16 + fr);
#pragma unroll
            for (int bj = 0; bj < 2; ++bj) {
                const int c = u.pn * 256 + bj * 128 + 32 * wc + 8 * fq;
                const int t2 = c & 63, bjx = c >> 6, b = bjx >> 9, j = bjx & 511;
                float br[8], bi[8];
#pragma unroll
                for (int n = 0; n < 2; ++n) {
                    const f32x4 ar = acc[0][bj][m][n], aim = acc[1][bj][m][n];
#pragma unroll
                    for (int i = 0; i < 4; ++i) { const float rev = (float)(k1 * (t2 + 4 * n + i)) * (1.f / 8192.f); const float cw = __builtin_amdgcn_cosf(rev), sw = __builtin_amdgcn_sinf(rev);
                        br[4 * n + i] = ar[i] * cw - aim[i] * sw; bi[4 * n + i] = ar[i] * sw + aim[i] * cw; }
                }
                const unsigned off = (unsigned)(((b * 128 + k1) * 512 + j) * 128 + t2);
                u32x4 p0, p1; p0.x = cvt_pk_bf16(br[0], br[1]); p0.y = cvt_pk_bf16(br[2], br[3]); p0.z = cvt_pk_bf16(br[4], br[5]); p0.w = cvt_pk_bf16(br[6], br[7]);
                p1.x = cvt_pk_bf16(bi[0], bi[1]); p1.y = cvt_pk_bf16(bi[2], bi[3]); p1.z = cvt_pk_bf16(bi[4], bi[5]); p1.w = cvt_pk_bf16(bi[6], bi[7]);
                *(u32x4*)(Bint + off) = p0; *(u32x4*)(Bint + off + 64) = p1;
            }
            asm volatile("" ::: "memory");
        }
    }
};
struct EpiCtxF {
    bf16_t* MIX; const bf16_t* PROJ; const float* bf;
    __device__ __forceinline__ void operator()(const f32x4 (&acc)[2][2][4][2], const Unit& u, int wr, int wc, int fr, int fq) const {
#pragma unroll
        for (int ai = 0; ai < 2; ++ai) {
            u32x4 gg[4][2];
#pragma unroll
            for (int m = 0; m < 4; ++m)
#pragma unroll
                for (int bj = 0; bj < 2; ++bj) { const int k = ai * 128 + wr * 64 + m * 16 + fr, col = u.pn * 256 + bj * 128 + 32 * wc + 8 * fq, b = col >> 9, j = col & 511;
                    gg[m][bj] = *(const u32x4*)(PROJ + ((size_t)MLAT + b * 256 + k) * NCOL + C_CG + j); }
#pragma unroll
            for (int m = 0; m < 4; ++m)
#pragma unroll
                for (int bj = 0; bj < 2; ++bj) { const int k = ai * 128 + wr * 64 + m * 16 + fr, col = u.pn * 256 + bj * 128 + 32 * wc + 8 * fq, b = col >> 9, j = col & 511;
                    const f32x4 v0 = acc[ai][bj][m][0], v1 = acc[ai][bj][m][1]; const f32x4 b0 = *(const f32x4*)(bf + j), b1 = *(const f32x4*)(bf + j + 4); const u32x4 g2 = gg[m][bj];
                    u32x4 pk; pk.x = cvt_pk_bf16((v0[0] + b0[0]) * bflo(g2.x), (v0[1] + b0[1]) * bfhi(g2.x)); pk.y = cvt_pk_bf16((v0[2] + b0[2]) * bflo(g2.y), (v0[3] + b0[3]) * bfhi(g2.y));
                    pk.z = cvt_pk_bf16((v1[0] + b1[0]) * bflo(g2.z), (v1[1] + b1[1]) * bfhi(g2.z)); pk.w = cvt_pk_bf16((v1[2] + b1[2]) * bflo(g2.w), (v1[3] + b1[3]) * bfhi(g2.w));
                    *(u32x4*)(MIX + ((size_t)MLAT + b * 256 + k) * DM + 1536 + j) = pk; }
            asm volatile("" ::: "memory");
        }
    }
};

__device__ __forceinline__ int qk_dperm(int p) {
    const int wc = p >> 5, fq = (p >> 3) & 3, n = (p >> 2) & 1, i = p & 3;
    return (wc >> 1) * 64 + n * 32 + (wc & 1) * 16 + fq * 4 + i;
}
struct TrTask { const float* src; bf16_t* dst; int sp, scol0, k0, nd0; bool perm; };
__device__ __forceinline__ TrTask tr_decode(const Params& P, bf16_t* WinT, bf16_t* WoutT, int task) {
    TrTask t;
    if (task < DEPTH * 18 * 32) {
        const int l = task / (18 * 32), r = task % (18 * 32), nb = r >> 5, kt = r & 31;
        t.nd0 = nb < 16 ? nb * 256 : (5120 + (nb - 16) * 256); t.scol0 = nb < 16 ? t.nd0 : t.nd0 - 512; t.perm = (t.nd0 >= C_Q && t.nd0 < C_V);
        t.src = P.w_in + (size_t)l * DM * 5120; t.sp = 5120; t.dst = WinT + (size_t)l * NCOL * DM; t.k0 = kt * 64;
    } else {
        const int q = task - DEPTH * 18 * 32, l = q >> 8, r = q & 255, nb = r >> 5, kt = r & 31;
        t.nd0 = nb * 256; t.scol0 = nb * 256; t.perm = false; t.src = P.w_out + (size_t)l * DM * DM; t.sp = DM; t.dst = WoutT + (size_t)l * DM * DM; t.k0 = kt * 64;
    }
    return t;
}
__device__ __forceinline__ void tr_load(const TrTask& t, int tid, f32x4 (&v)[8]) {
#pragma unroll
    for (int i = 0; i < 8; ++i) { const int k = (tid >> 6) + 8 * i, c4 = (tid & 63) * 4; v[i] = *(const f32x4*)(t.src + (size_t)(t.k0 + k) * t.sp + t.scol0 + c4); }
}
__device__ __forceinline__ void tr_store(const TrTask& t, int tid, const f32x4 (&v)[8], LAS float* scr) {
#pragma unroll
    for (int i = 0; i < 8; ++i) { const int k = (tid >> 6) + 8 * i, c4 = (tid & 63) * 4; LAS float* s = scr + k * 257 + c4; s[0] = v[i][0]; s[1] = v[i][1]; s[2] = v[i][2]; s[3] = v[i][3]; }
    __syncthreads();
#pragma unroll
    for (int i = 0; i < 4; ++i) { const int n = (tid >> 3) + 64 * i, kc = tid & 7;
      int sc = n;
      if (t.perm) { const int p = (t.nd0 + n) & 127; sc = (n & ~63) + (qk_dperm(p) & 63); }
      const LAS float* s = scr + (kc * 8) * 257 + sc;
      u32x4 o; o.x = cvt_pk_bf16(s[0], s[257]); o.y = cvt_pk_bf16(s[2 * 257], s[3 * 257]); o.z = cvt_pk_bf16(s[4 * 257], s[5 * 257]); o.w = cvt_pk_bf16(s[6 * 257], s[7 * 257]);
      *(u32x4*)(t.dst + (size_t)(t.nd0 + n) * DM + t.k0 + kc * 8) = o; }
    __syncthreads();
}

__device__ __forceinline__ void phase0a(const Params& P_unused, LAS unsigned char* lds, int G) {
    const Params P = load_params(); (void)P_unused;
    unsigned char* ws = ls(P.ws);
    bf16_t* WinT = (bf16_t*)(ws + O_WINT); bf16_t* WoutT = (bf16_t*)(ws + O_WOUTT); bf16_t* Wcx = (bf16_t*)(ws + O_WCX); bf16_t* MTf = (bf16_t*)(ws + O_MTF);
    float* modp = (float*)(ws + O_MODP); float2* rope = (float2*)(ws + O_ROPE); float2* twid = (float2*)(ws + O_TWID);
    bf16_t* F128 = (bf16_t*)(ws + O_F128); bf16_t* F64 = (bf16_t*)(ws + O_F64); bf16_t* Dctx = (bf16_t*)(ws + O_DCTX);
    LAS float* scr = (LAS float*)lds;
    const int tid = lv(threadIdx.x), bid = blockIdx.x;
    for (int task = bid; task < 384; task += G) {
        const int l = task / 96, s = (task / 3) & 31, nc = task % 3;
        __syncthreads();
        if (tid < 192) { const int r = tid >> 6, kk = tid & 63; const float v = (r < 2) ? P.c[r * DM + s * 64 + kk] : P.c_ctx[s * 64 + kk]; scr[r * 64 + kk] = silu_f(v); }
        __syncthreads();
        const int n = nc * 2048 + tid * 4;
        f32x4 a0 = {0, 0, 0, 0}, a1 = {0, 0, 0, 0}, a2 = {0, 0, 0, 0};
        const float* wp = P.w_mod + ((size_t)l * DM + s * 64) * 6144 + n;
#pragma unroll 16
        for (int kk = 0; kk < 64; ++kk) { const f32x4 w = *(const f32x4*)(wp + (size_t)kk * 6144); a0 += w * scr[kk]; a1 += w * scr[64 + kk]; a2 += w * scr[128 + kk]; }
        float* op = modp + ((size_t)(l * 32 + s) * 3) * 6144 + n;
        *(f32x4*)(op) = a0; *(f32x4*)(op + 6144) = a1; *(f32x4*)(op + 2 * 6144) = a2;
    }
    __syncthreads();
    {   constexpr int NTR = DEPTH * 18 * 32 + DEPTH * 8 * 32;
        const int tl = lv(tid);
        f32x4 va[8], vb[8];
        int task = bid;
        TrTask cur = tr_decode(P, WinT, WoutT, task < NTR ? task : 0);
        if (task < NTR) tr_load(cur, tl, va);
        for (; task < NTR; task += G) {
            const int nxt = task + G;
            TrTask nx = tr_decode(P, WinT, WoutT, nxt < NTR ? nxt : task);
            if (nxt < NTR) tr_load(nx, tl, vb);
            tr_store(cur, tl, va, scr);
#pragma unroll
            for (int i = 0; i < 8; ++i) va[i] = vb[i];
            cur = nx;
        }
    }
    if (tid < 128) { const float a = (float)tid * (1.f / 64.f); scr[tid] = cospif(a); scr[128 + tid] = sinpif(a); }
    __syncthreads();
    const size_t gt = (size_t)bid * 512 + tid, GT = (size_t)G * 512;
    for (size_t e = gt; e < (size_t)DEPTH * DM * 128; e += GT) {
        const size_t lk = e >> 7; const int j4 = (int)(e & 127) * 4;
        const f32x4 v = *(const f32x4*)(P.w_in + lk * 5120 + 4096 + j4);
        *(u32x2*)(Wcx + lk * 512 + j4) = pack4(v[0], v[1], v[2], v[3]);
    }
    for (size_t e = gt; e < (size_t)DEPTH * 1024 * 512; e += GT) {
        const int col = (int)(e & 511), row = (int)((e >> 9) & 1023), l = (int)(e >> 19);
        const int ri = row >> 9, g = (row >> 7) & 3, d = row & 127, g2 = col >> 7, c = col & 127;
        float v = 0.f;
        if (g == g2) {
            const float* wf = P.w_f + ((size_t)(l * 4 + g) * 128) * 128 + d;
            float s = 0.f;
            const LAS float* tb = scr + ri * 128;
#pragma unroll 8
            for (int c2 = 0; c2 < 128; ++c2) s += tb[(c * c2) & 127] * wf[(size_t)c2 * 128];
            v = s * (1.f / 1024.f);
        }
        MTf[e] = f2bf(v);
    }
    for (size_t e = gt; e < 128 * 32; e += GT) { const int pos = (int)(e >> 5), f = (int)(e & 31);
        const float fr = powf(10000.f, -(float)f / 32.f); const float ang = (float)pos * fr; float sn, cs; sincosf(ang, &sn, &cs); rope[e] = make_float2(cs, sn); }
    for (size_t e = gt; e < 8192; e += GT) { const float a = (float)e * (1.f / 4096.f); twid[e] = make_float2(cospif(a), sinpif(a)); }
    for (size_t e = gt; e < 256 * 256; e += GT) { const int n = (int)(e >> 8), kk = (int)(e & 255); const int ro = n >> 7, k1 = n & 127, rin = kk >> 7, t1 = kk & 127;
        const float a = (float)((k1 * t1) & 127) * (1.f / 64.f); const float cs = cospif(a), sn = sinpif(a);
        const float v = ro == 0 ? (rin == 0 ? cs : -sn) : (rin == 0 ? sn : cs); F128[e] = f2bf(v); }
    for (size_t e = gt; e < 64 * 128; e += GT) { const int k2 = (int)(e >> 7), kk = (int)(e & 127); const int rin = kk >> 6, t2 = kk & 63;
        const float a = (float)((k2 * t2) & 63) * (1.f / 32.f); F64[e] = f2bf(rin == 0 ? cospif(a) : -sinpif(a)); }
    for (size_t e = gt; e < 256 * 512; e += GT) { const int k = (int)(e >> 9), kk = (int)(e & 511); const int rin = kk >> 8, t = kk & 255;
        const float a = (float)((k * t) & 255) * (1.f / 128.f); Dctx[e] = f2bf((rin == 0 ? cospif(a) : -sinpif(a)) * 5.656854249492381f); }
}

__device__ __forceinline__ void row_phase(const Params& P_unused, int layer, int G) {
    const Params P = load_params(); (void)P_unused;
    unsigned char* ws = ls(P.ws);
    const float* mod = (const float*)(ws + O_MOD);
    float* XC = (float*)(ws + O_XC);
    bf16_t* XB = (bf16_t*)(ws + O_XB);
    bf16_t* H = (bf16_t*)(ws + O_HMIX);
    const bf16_t* Y = (const bf16_t*)(ws + O_PROJ); const bf16_t* Yc = (const bf16_t*)(ws + O_YC);
    const int tid = lv(threadIdx.x);
    const int lane = tid & 63, gw = blockIdx.x * 8 + (tid >> 6), NGW = G * 8;
    const int nrows = layer == DEPTH ? MLAT : MROWS;
    const bool xb_src = layer >= 2;
    const float* xctx = layer <= 1 ? P.ctx : XC;
    f32x4 vn[8]; u32x2 yn[8], xn[8];
#define ROW_LOAD(r) do { const int _r = (r); \
        if (_r < MLAT && xb_src) { _Pragma("unroll") for (int j = 0; j < 8; ++j) xn[j] = *(const u32x2*)(XB + (size_t)_r * DM + lane * 4 + 256 * j); } \
        else { const float* _x = _r < MLAT ? P.x + (size_t)_r * DM : xctx + (size_t)(_r - MLAT) * DM; _Pragma("unroll") for (int j = 0; j < 8; ++j) vn[j] = *(const f32x4*)(_x + lane * 4 + 256 * j); } \
        if (layer >= 1) { const bf16_t* _y = _r < MLAT ? Y + (size_t)_r * DM : Yc + (size_t)(_r - MLAT) * DM; _Pragma("unroll") for (int j = 0; j < 8; ++j) yn[j] = *(const u32x2*)(_y + lane * 4 + 256 * j); } } while (0)
    if (gw < nrows) ROW_LOAD(gw);
    for (int row = gw; row < nrows; row += NGW) {
        const bool lat = row < MLAT; const int mr = lat ? (row >> 13) : 2;
        f32x4 v[8]; u32x2 yw[8];
        if (lat && xb_src) {
#pragma unroll
            for (int j = 0; j < 8; ++j) v[j] = (f32x4){bflo(xn[j].x), bfhi(xn[j].x), bflo(xn[j].y), bfhi(xn[j].y)};
        } else {
#pragma unroll
            for (int j = 0; j < 8; ++j) v[j] = vn[j];
        }
#pragma unroll
        for (int j = 0; j < 8; ++j) yw[j] = yn[j];
        const int nr = row + NGW;
        if (nr < nrows) ROW_LOAD(nr);
        if (layer >= 1) {
            const float* mg = mod + ((size_t)(layer - 1) * 3 + mr) * 6144 + 4096;
            const float* gp = P.g_post + (size_t)(layer - 1) * DM;
            f32x4 y[8]; float ss = 0.f;
#pragma unroll
            for (int j = 0; j < 8; ++j) { const u32x2 w = yw[j];
                y[j] = (f32x4){bflo(w.x), bfhi(w.x), bflo(w.y), bfhi(w.y)}; ss += y[j][0] * y[j][0] + y[j][1] * y[j][1] + y[j][2] * y[j][2] + y[j][3] * y[j][3]; }
            const float rinv = rsqrtf(wave_sum(ss) * (1.f / DM) + EPS);
#pragma unroll
            for (int j = 0; j < 8; ++j) { const f32x4 g4 = *(const f32x4*)(mg + lane * 4 + 256 * j), p4 = *(const f32x4*)(gp + lane * 4 + 256 * j);
                v[j] = v[j] + g4 * (y[j] * rinv * p4); }
            if (!lat) {
#pragma unroll
                for (int j = 0; j < 8; ++j) *(f32x4*)(XC + (size_t)(row - MLAT) * DM + lane * 4 + 256 * j) = v[j];
            } else if (layer == DEPTH) {
#pragma unroll
                for (int j = 0; j < 8; ++j) *(f32x4*)(P.out + (size_t)row * DM + lane * 4 + 256 * j) = v[j];
            } else {
#pragma unroll
                for (int j = 0; j < 8; ++j) *(u32x2*)(XB + (size_t)row * DM + lane * 4 + 256 * j) = pack4(v[j][0], v[j][1], v[j][2], v[j][3]);
            }
        }
        if (layer < DEPTH) {
            float ss = 0.f;
#pragma unroll
            for (int j = 0; j < 8; ++j) ss += v[j][0] * v[j][0] + v[j][1] * v[j][1] + v[j][2] * v[j][2] + v[j][3] * v[j][3];
            const float rinv = rsqrtf(wave_sum(ss) * (1.f / DM) + EPS);
            const float* msh = mod + ((size_t)layer * 3 + mr) * 6144; const float* msc = msh + 2048;
            const float* gp = P.g_pre + (size_t)layer * DM;
#pragma unroll
            for (int j = 0; j < 8; ++j) { const f32x4 sh = *(const f32x4*)(msh + lane * 4 + 256 * j), sc = *(const f32x4*)(msc + lane * 4 + 256 * j), g4 = *(const f32x4*)(gp + lane * 4 + 256 * j);
                const f32x4 h = (v[j] * rinv * g4) * (sc + 1.f) + sh;
                *(u32x2*)(H + (size_t)row * DM + lane * 4 + 256 * j) = pack4(h[0], h[1], h[2], h[3]); }
        }
    }
#undef ROW_LOAD
}

__device__ __forceinline__ void attn_task(const Params& P_unused, int layer, int task, LAS unsigned char* lds) {
    const Params P = load_params(); (void)P_unused;
    unsigned char* ws = ls(P.ws);
    const bf16_t* PROJ = (const bf16_t*)(ws + O_PROJ);
    const bf16_t* VT = (const bf16_t*)(ws + O_VT); const bf16_t* VTc = (const bf16_t*)(ws + O_VTC);
    bf16_t* MIX = (bf16_t*)(ws + O_HMIX);
    const int tid = lv(threadIdx.x);
    const int lane = tid & 63, w = __builtin_amdgcn_readfirstlane(tid >> 6), fr = lane & 15, fq = lane >> 4;
    int b, blk, kvh, pair; bool isctx;
    if (task < 512) { isctx = false; b = task >> 8; const int rem = task & 255; blk = rem >> 2; kvh = (rem >> 1) & 1; pair = rem & 1; }
    else { isctx = true; const int t = task - 512; b = t >> 3; blk = (t >> 2) & 1; kvh = (t >> 1) & 1; pair = t & 1; }
    const int head = kvh * 4 + pair * 2 + (w >> 2);
    const int a0 = (w & 3) * 32;
    const size_t qrow0 = (isctx ? (size_t)MLAT + b * CTXL : (size_t)b * SEQ) + blk * 128 + a0;
    bf16x8 qf[2][4];
#pragma unroll
    for (int u = 0; u < 2; ++u)
#pragma unroll
        for (int c = 0; c < 4; ++c) qf[u][c] = *(const bf16x8*)(PROJ + (qrow0 + u * 16 + fr) * NCOL + C_Q + head * 128 + c * 32 + fq * 8);
    u32x2 gws[2][8];
#pragma unroll
    for (int u = 0; u < 2; ++u)
#pragma unroll
        for (int dt = 0; dt < 8; ++dt) gws[u][dt] = *(const u32x2*)(PROJ + (qrow0 + u * 16 + fr) * NCOL + C_BG + head * 128 + dt * 16 + 4 * fq);
    float mrun[2], lrun[2];
    const float sk = P.sink[layer * 8 + head] * LOG2E;
    mrun[0] = mrun[1] = sk; lrun[0] = lrun[1] = 1.f;
    f32x4 o[8][2];
#pragma unroll
    for (int dt = 0; dt < 8; ++dt) { o[dt][0] = (f32x4){0, 0, 0, 0}; o[dt][1] = (f32x4){0, 0, 0, 0}; }
    const int nprev = (!isctx && blk > 0) ? 4 : 0, nnext = (!isctx && blk < 63) ? 4 : 0;
    const int T = isctx ? 8 : 12 + nprev + nnext;
    const int lkey = tid >> 4, lkc = (tid & 15) ^ (((lkey >> 3) << 2) | (lkey & 3));
    const unsigned koff = (unsigned)(lkey * NCOL + lkc * 8) * 2u;
    const int ld = tid >> 2, lvc = (tid & 3) ^ ((ld >> 2) & 3);
    const unsigned voff_c = (unsigned)(ld * CTXL + lvc * 8) * 2u, voff_s = (unsigned)(ld * SEQ + lvc * 8) * 2u;
    const char* kctx = (const char*)(PROJ + ((size_t)MLAT + b * CTXL) * NCOL + C_K + kvh * 128);
    const char* klat = (const char*)(PROJ + ((size_t)b * SEQ) * NCOL + C_K + kvh * 128);
    const char* vctx = (const char*)(VTc + (size_t)(b * 2 + kvh) * 128 * CTXL);
    const char* vlat = (const char*)(VT + (size_t)(b * 2 + kvh) * 128 * SEQ);
#define ATT_ISSUE(tt) do { int _t = (tt) < T ? (tt) : T - 1; const char* _kp; const char* _vp; unsigned _vo; \
        if (_t < 8) { _kp = kctx + (size_t)(_t * 32) * NCOL * 2; _vp = vctx + _t * 64; _vo = voff_c; } \
        else { const int _r = _t - 8, _seg = _r < nprev ? 0 : (_r < nprev + 4 ? 1 : 2), _st = _seg == 0 ? _r : (_seg == 1 ? _r - nprev : _r - nprev - 4); \
               const int _kb = (blk - 1 + _seg) * 128 + _st * 32; _kp = klat + (size_t)_kb * NCOL * 2; _vp = vlat + _kb * 2; _vo = voff_s; } \
        LAS unsigned char* _dst = lds + ((tt) & 7) * 16384 + w * 1024; \
        __builtin_amdgcn_global_load_lds((const unsigned*)(_kp + koff), (LAS unsigned*)(_dst), 16, 0, 0); \
        __builtin_amdgcn_global_load_lds((const unsigned*)(_vp + _vo), (LAS unsigned*)(_dst + 8192), 16, 0, 0); } while (0)
    ATT_ISSUE(0); ATT_ISSUE(1); ATT_ISSUE(2); ATT_ISSUE(3); ATT_ISSUE(4); ATT_ISSUE(5);
    const int kfo = (8 * (fr >> 2) + (fr & 3)) * 256, vfo = fr * 64 + ((fq ^ ((fr >> 2) & 3)) * 16);
    int kofs[4];
#pragma unroll
    for (int c = 0; c < 4; ++c) kofs[c] = kfo + (((c * 4 + fq) ^ fr) * 16);
    const f32x4 zero4 = {0.f, 0.f, 0.f, 0.f};
    for (int tp = 0; tp < T; tp += 2) {
        asm volatile("s_waitcnt vmcnt(8) lgkmcnt(0)" ::: "memory");
        __builtin_amdgcn_s_barrier();
        asm volatile("" ::: "memory");
        ATT_ISSUE(tp + 6); ATT_ISSUE(tp + 7);
        int mtype = 0, st = 0;
        if (tp >= 8) { const int r = tp - 8; if (r < nprev) { mtype = 1; st = r; } else if (r >= nprev + 4) { mtype = 2; st = r - nprev - 4; } }
        const int k0 = st * 32;
        if (mtype == 1 && k0 + 63 < a0) continue;
        if (mtype == 2 && k0 > a0 + 31) continue;
        f32x4 s[2][2][2];
#pragma unroll
        for (int tl = 0; tl < 2; ++tl) {
            const LAS unsigned char* kb = lds + ((tp + tl) & 7) * 16384;
#pragma unroll
            for (int v = 0; v < 2; ++v)
#pragma unroll
                for (int c = 0; c < 4; ++c) {
                    const bf16x8 ka = *(const LAS bf16x8*)(kb + kofs[c] + v * 1024);
                    s[0][tl][v] = __builtin_amdgcn_mfma_f32_16x16x32_bf16(ka, qf[0][c], c == 0 ? zero4 : s[0][tl][v], 0, 0, 0);
                    s[1][tl][v] = __builtin_amdgcn_mfma_f32_16x16x32_bf16(ka, qf[1][c], c == 0 ? zero4 : s[1][tl][v], 0, 0, 0);
                }
        }
        bf16x8 pb[2][2];
#pragma unroll
        for (int u = 0; u < 2; ++u) {
            if (mtype == 1) {
                asm volatile("" ::: "memory");
                const int a = a0 + u * 16 + fr - k0 - 8 * fq;
#pragma unroll
                for (int tl = 0; tl < 2; ++tl)
#pragma unroll
                    for (int v = 0; v < 2; ++v)
#pragma unroll
                        for (int r = 0; r < 4; ++r) { if (32 * tl + 4 * v + r < a) s[u][tl][v][r] = -1e30f; }
            } else if (mtype == 2) {
                asm volatile("" ::: "memory");
                const int a = a0 + u * 16 + fr - k0 - 8 * fq;
#pragma unroll
                for (int tl = 0; tl < 2; ++tl)
#pragma unroll
                    for (int v = 0; v < 2; ++v)
#pragma unroll
                        for (int r = 0; r < 4; ++r) { if (32 * tl + 4 * v + r > a) s[u][tl][v][r] = -1e30f; }
            }
            float mx = -3e38f;
#pragma unroll
            for (int tl = 0; tl < 2; ++tl)
#pragma unroll
                for (int v = 0; v < 2; ++v) mx = fmaxf(mx, fmaxf(fmaxf(s[u][tl][v][0], s[u][tl][v][1]), fmaxf(s[u][tl][v][2], s[u][tl][v][3])));
            mx = xor16_max(mx); mx = xor32_max(mx);
            const float mn = fmaxf(mrun[u], mx);
            const float alpha = __builtin_amdgcn_exp2f(mrun[u] - mn);
            float p[16]; float ps = 0.f;
#pragma unroll
            for (int tl = 0; tl < 2; ++tl)
#pragma unroll
                for (int v = 0; v < 2; ++v)
#pragma unroll
                    for (int r = 0; r < 4; ++r) { const float e = __builtin_amdgcn_exp2f(s[u][tl][v][r] - mn); p[tl * 8 + v * 4 + r] = e; ps += e; }
            ps = xor16_sum(ps); ps = xor32_sum(ps);
            lrun[u] = lrun[u] * alpha + ps;
            if (__any(mn > mrun[u])) {
#pragma unroll
                for (int dt = 0; dt < 8; ++dt) o[dt][u] = o[dt][u] * alpha;
            }
            mrun[u] = mn;
#pragma unroll
            for (int tl = 0; tl < 2; ++tl) {
                u32x4 pk; pk.x = cvt_pk_bf16(p[tl * 8 + 0], p[tl * 8 + 1]); pk.y = cvt_pk_bf16(p[tl * 8 + 2], p[tl * 8 + 3]); pk.z = cvt_pk_bf16(p[tl * 8 + 4], p[tl * 8 + 5]); pk.w = cvt_pk_bf16(p[tl * 8 + 6], p[tl * 8 + 7]);
                pb[u][tl] = __builtin_bit_cast(bf16x8, pk);
            }
        }
#pragma unroll
        for (int tl = 0; tl < 2; ++tl) {
            const LAS unsigned char* vb = lds + ((tp + tl) & 7) * 16384 + 8192;
#pragma unroll
            for (int dt = 0; dt < 8; ++dt) {
                const bf16x8 va = *(const LAS bf16x8*)(vb + dt * 1024 + vfo);
                o[dt][0] = __builtin_amdgcn_mfma_f32_16x16x32_bf16(va, pb[0][tl], o[dt][0], 0, 0, 0);
                o[dt][1] = __builtin_amdgcn_mfma_f32_16x16x32_bf16(va, pb[1][tl], o[dt][1], 0, 0, 0);
            }
        }
    }
    asm volatile("s_waitcnt vmcnt(0) lgkmcnt(0)" ::: "memory");
    __builtin_amdgcn_s_barrier();
    asm volatile("" ::: "memory");
#undef ATT_ISSUE
#pragma unroll
    for (int u = 0; u < 2; ++u) {
        const float inv = 1.f / lrun[u];
        const size_t row = qrow0 + u * 16 + fr;
#pragma unroll
        for (int dt = 0; dt < 8; ++dt) {
            const int d0 = head * 128 + dt * 16 + 4 * fq;
            const u32x2 gw = gws[u][dt];
            const f32x4 ov = o[dt][u] * inv;
            *(u32x2*)(MIX + row * DM + 512 + d0) = pack4(ov[0] * bflo(gw.x), ov[1] * bfhi(gw.x), ov[2] * bflo(gw.y), ov[3] * bfhi(gw.y));
        }
    }
}

constexpr int GM_PART = 131072, GM_RQ = GM_PART + 32 * 128 * 4, GM_G = GM_RQ + 512, GM_B = GM_G + 2048, LDS_TOTAL = GM_B + 2048;
__device__ __forceinline__ void gmlp_task(const Params& P_unused, int layer, int chunk, LAS unsigned char* lds) {
    const Params P = load_params(); (void)P_unused;
    unsigned char* ws = ls(P.ws);
    const bf16_t* PROJ = (const bf16_t*)(ws + O_PROJ); const bf16_t* avT = (const bf16_t*)(ws + O_AVT) + (size_t)chunk * 512 * 128;
    bf16_t* MIX = (bf16_t*)(ws + O_HMIX);
    LAS float* part = (LAS float*)(lds + GM_PART);
    LAS float* rq = (LAS float*)(lds + GM_RQ);
    LAS float* gl = (LAS float*)(lds + GM_G);
    LAS float* bl = (LAS float*)(lds + GM_B);
    const int tid = lv(threadIdx.x), lane = tid & 63, w = __builtin_amdgcn_readfirstlane(tid >> 6), fr = lane & 15, fq = lane >> 4;
    __syncthreads();
    const int myc = (tid & 15) ^ ((tid >> 4) & 15);
    { const char* src = (const char*)avT + (size_t)(tid >> 4) * 256 + myc * 16;
#pragma unroll
      for (int i = 0; i < 16; ++i) __builtin_amdgcn_global_load_lds((const unsigned*)(src + (size_t)i * 32 * 256), (LAS unsigned*)(lds + i * 8192 + w * 1024), 16, 0, 0); }
    const int p = 16 * w + fr; const size_t row = (size_t)chunk * 128 + p;
    f32x4 wsn[8]; u32x2 uun[8], ggn[8];
#define GM_LOAD(h) do { const float* _wsr = P.w_sgu + (((size_t)layer * 4 + (h)) * 128 + p) * 128; \
        _Pragma("unroll") for (int c = 0; c < 4; ++c) { wsn[2 * c] = *(const f32x4*)(_wsr + c * 32 + 8 * fq); wsn[2 * c + 1] = *(const f32x4*)(_wsr + c * 32 + 8 * fq + 4); } \
        _Pragma("unroll") for (int dt = 0; dt < 8; ++dt) { const int _col = (h) * 128 + dt * 16 + 4 * fq; uun[dt] = *(const u32x2*)(PROJ + row * NCOL + C_AU + _col); ggn[dt] = *(const u32x2*)(PROJ + row * NCOL + C_AG + _col); } } while (0)
    GM_LOAD(0);
    if (tid < 128) *(LAS f32x4*)(gl + tid * 4) = *(const f32x4*)(P.g_sgu + (size_t)layer * 512 + tid * 4);
    else if (tid < 256) *(LAS f32x4*)(bl + (tid - 128) * 4) = *(const f32x4*)(P.b_sgu + (size_t)layer * 512 + (tid - 128) * 4);
    asm volatile("s_waitcnt vmcnt(0)" ::: "memory");
    __builtin_amdgcn_s_barrier();
    asm volatile("" ::: "memory");
    { float s8[8] = {0, 0, 0, 0, 0, 0, 0, 0};
#pragma unroll
      for (int i = 0; i < 16; ++i) { const u32x4 v = *(const LAS u32x4*)(lds + i * 8192 + tid * 16);
          float f; f = bflo(v.x); s8[0] += f * f; f = bfhi(v.x); s8[1] += f * f; f = bflo(v.y); s8[2] += f * f; f = bfhi(v.y); s8[3] += f * f;
          f = bflo(v.z); s8[4] += f * f; f = bfhi(v.z); s8[5] += f * f; f = bflo(v.w); s8[6] += f * f; f = bfhi(v.w); s8[7] += f * f; }
#pragma unroll
      for (int e = 0; e < 8; ++e) part[(tid >> 4) * 128 + myc * 8 + e] = s8[e]; }
    __syncthreads();
    if (tid < 128) { float s = 0.f; for (int i = 0; i < 32; ++i) s += part[i * 128 + tid]; rq[tid] = rsqrtf(s * (1.f / 512.f) + EPS); }
    __syncthreads();
    for (int h = 0; h < 4; ++h) {
        f32x4 wsc[8]; u32x2 uu[8], gg[8];
#pragma unroll
        for (int i = 0; i < 8; ++i) { wsc[i] = wsn[i]; uu[i] = uun[i]; gg[i] = ggn[i]; }
        if (h < 3) GM_LOAD(h + 1);
        bf16x8 bfr[4];
#pragma unroll
        for (int c = 0; c < 4; ++c) { const int q0 = c * 32 + 8 * fq; const f32x4 w0 = wsc[2 * c], w1 = wsc[2 * c + 1];
            u32x4 pk; pk.x = cvt_pk_bf16(w0[0] * rq[q0], w0[1] * rq[q0 + 1]); pk.y = cvt_pk_bf16(w0[2] * rq[q0 + 2], w0[3] * rq[q0 + 3]);
            pk.z = cvt_pk_bf16(w1[0] * rq[q0 + 4], w1[1] * rq[q0 + 5]); pk.w = cvt_pk_bf16(w1[2] * rq[q0 + 6], w1[3] * rq[q0 + 7]); bfr[c] = __builtin_bit_cast(bf16x8, pk); }
        f32x4 acc[8];
#pragma unroll
        for (int dt = 0; dt < 8; ++dt) { acc[dt] = (f32x4){0, 0, 0, 0};
#pragma unroll
            for (int c = 0; c < 4; ++c) { const bf16x8 a = *(const LAS bf16x8*)(lds + (h * 128 + dt * 16 + fr) * 256 + (((c * 4 + fq) ^ fr) * 16));
                acc[dt] = __builtin_amdgcn_mfma_f32_16x16x32_bf16(a, bfr[c], acc[dt], 0, 0, 0); } }
        const float bs = bl[h * 128 + p];
#pragma unroll
        for (int dt = 0; dt < 8; ++dt) { const int col = h * 128 + dt * 16 + 4 * fq;
            const f32x4 g4 = *(const LAS f32x4*)(gl + col);
            const u32x2 u2 = uu[dt], g2 = gg[dt];
            const float y0 = bflo(u2.x) * (acc[dt][0] * g4[0] + bs) * bflo(g2.x), y1 = bfhi(u2.x) * (acc[dt][1] * g4[1] + bs) * bfhi(g2.x);
            const float y2 = bflo(u2.y) * (acc[dt][2] * g4[2] + bs) * bflo(g2.y), y3 = bfhi(u2.y) * (acc[dt][3] * g4[3] + bs) * bfhi(g2.y);
            *(u32x2*)(MIX + row * DM + col) = pack4(y0, y1, y2, y3); }
    }
#undef GM_LOAD
    __syncthreads();
}

__device__ __forceinline__ void stage2_phase(const Params& P_unused, int layer, int G) {
    const Params P = load_params(); (void)P_unused;
    unsigned char* ws = ls(P.ws);
    const bf16_t* Bint = (const bf16_t*)(ws + O_BINT); const bf16_t* F64 = (const bf16_t*)(ws + O_F64); const bf16_t* PROJ = (const bf16_t*)(ws + O_PROJ);
    bf16_t* MIX = (bf16_t*)(ws + O_HMIX);
    const int tid = lv(threadIdx.x);
    const int lane = tid & 63, w = __builtin_amdgcn_readfirstlane(tid >> 6), fr = lane & 15, fq = lane >> 4;
    bf16x8 ff[4][4];
#pragma unroll
    for (int nt = 0; nt < 4; ++nt)
#pragma unroll
        for (int c = 0; c < 4; ++c) ff[nt][c] = *(const bf16x8*)(F64 + (size_t)(nt * 16 + fr) * 128 + c * 32 + fq * 8);
    for (int task = blockIdx.x; task < 256; task += G) {
        const int b = task >> 7, k1 = task & 127;
        bf16x8 af[4][4]; u32x2 gg[4][4]; f32x4 bias[4];
#pragma unroll
        for (int mi = 0; mi < 4; ++mi) {
            const int j0 = (w * 4 + mi) * 16, jc = j0 + 4 * fq;
#pragma unroll
            for (int c = 0; c < 4; ++c) af[mi][c] = *(const bf16x8*)(Bint + (((size_t)(b * 128 + k1) * 512 + j0 + fr) * 128) + c * 32 + fq * 8);
            bias[mi] = *(const f32x4*)(P.b_f + (size_t)layer * 512 + jc);
#pragma unroll
            for (int nt = 0; nt < 4; ++nt) gg[mi][nt] = *(const u32x2*)(PROJ + ((size_t)b * SEQ + k1 + 128 * (nt * 16 + fr)) * NCOL + C_CG + jc);
        }
#pragma unroll
        for (int mi = 0; mi < 4; ++mi) {
            const int jc = (w * 4 + mi) * 16 + 4 * fq;
#pragma unroll
            for (int nt = 0; nt < 4; ++nt) {
                f32x4 acc = {0, 0, 0, 0};
#pragma unroll
                for (int c = 0; c < 4; ++c) acc = __builtin_amdgcn_mfma_f32_16x16x32_bf16(af[mi][c], ff[nt][c], acc, 0, 0, 0);
                const int k2 = nt * 16 + fr; const size_t row = (size_t)b * SEQ + k1 + 128 * k2;
                const u32x2 g2 = gg[mi][nt];
                *(u32x2*)(MIX + row * DM + 1536 + jc) = pack4((acc[0] + bias[mi][0]) * bflo(g2.x), (acc[1] + bias[mi][1]) * bfhi(g2.x), (acc[2] + bias[mi][2]) * bflo(g2.y), (acc[3] + bias[mi][3]) * bfhi(g2.y));
            }
        }
    }
}

__device__ __forceinline__ void ctx_outproj_tile(const Params& P_unused, int layer, int tile, LAS unsigned char* lds) {
    const Params P = load_params(); (void)P_unused;
    unsigned char* ws = ls(P.ws);
    const bf16_t* A = (const bf16_t*)(ws + O_HMIX) + (size_t)MLAT * DM;
    const bf16_t* Bt = (const bf16_t*)(ws + O_WOUTT) + (size_t)layer * DM * DM;
    bf16_t* Yc = (bf16_t*)(ws + O_YC);
    const int tid = lv(threadIdx.x);
    const int lane = tid & 63, w = __builtin_amdgcn_readfirstlane(tid >> 6), fr = lane & 15, fq = lane >> 4;
    const int m0 = (tile >> 5) * 64, n0 = (tile & 31) * 64;
    f32x4 acc[4][4];
#pragma unroll
    for (int i = 0; i < 4; ++i)
#pragma unroll
        for (int j = 0; j < 4; ++j) acc[i][j] = (f32x4){0, 0, 0, 0};
    const bf16_t* ap = A + (size_t)(m0 + fr) * DM + w * 256 + fq * 8;
    const bf16_t* bp = Bt + (size_t)(n0 + fr) * DM + w * 256 + fq * 8;
#pragma unroll 4
    for (int ks = 0; ks < 8; ++ks) {
        bf16x8 af[4], bv[4];
#pragma unroll
        for (int i = 0; i < 4; ++i) { af[i] = *(const bf16x8*)(ap + (size_t)i * 16 * DM + ks * 32); bv[i] = *(const bf16x8*)(bp + (size_t)i * 16 * DM + ks * 32); }
#pragma unroll
        for (int i = 0; i < 4; ++i)
#pragma unroll
            for (int j = 0; j < 4; ++j) acc[i][j] = __builtin_amdgcn_mfma_f32_16x16x32_bf16(af[i], bv[j], acc[i][j], 0, 0, 0);
    }
    __syncthreads();
    LAS float* red = (LAS float*)lds + w * 4096;
#pragma unroll
    for (int i = 0; i < 4; ++i)
#pragma unroll
        for (int j = 0; j < 4; ++j)
#pragma unroll
            for (int r = 0; r < 4; ++r) red[(i * 16 + 4 * fq + r) * 64 + j * 16 + fr] = acc[i][j][r];
    __syncthreads();
    { const int e0 = tid * 8, row = e0 >> 6, col = e0 & 63;
      f32x4 s0 = {0, 0, 0, 0}, s1 = {0, 0, 0, 0};
#pragma unroll
      for (int wv = 0; wv < 8; ++wv) { const LAS f32x4* p = (const LAS f32x4*)((LAS float*)lds + wv * 4096 + e0); s0 += p[0]; s1 += p[1]; }
      u32x4 o; o.x = cvt_pk_bf16(s0[0], s0[1]); o.y = cvt_pk_bf16(s0[2], s0[3]); o.z = cvt_pk_bf16(s1[0], s1[1]); o.w = cvt_pk_bf16(s1[2], s1[3]);
      *(u32x4*)(Yc + (size_t)(m0 + row) * DM + n0 + col) = o; }
    __syncthreads();
}

#define XB_TMO      128
#define XB_XCNT(j)  (256  + 64 * (j))
#define XB_XSUB(j)  (1280 + 64 * (j))
#define XB_XGEN(j)  (2304 + 64 * (j))
#define XB_TOP      3328
#define XB_TOPGEN   3392
#define XCD_BAR_WORDS 3456
#define XB_SPIN_CAP (1u << 18)
__device__ __forceinline__ unsigned xb_ld(unsigned* p)              { return __hip_atomic_load(p, __ATOMIC_RELAXED, __HIP_MEMORY_SCOPE_AGENT); }
__device__ __forceinline__ unsigned xb_add(unsigned* p, unsigned v) { return __hip_atomic_fetch_add(p, v, __ATOMIC_RELAXED, __HIP_MEMORY_SCOPE_AGENT); }
__device__ __forceinline__ unsigned xb_xcc_id() { return (unsigned)__builtin_amdgcn_s_getreg((3 << 11) | 20) & 0xFu; }
#define XB_SPIN(cond, bar) do { unsigned _sp = 0; while (cond) { __builtin_amdgcn_s_sleep(1); \
    if ((++_sp & 255u) == 0u) { if (xb_ld(&(bar)[XB_TMO])) break; if (_sp > XB_SPIN_CAP) { atomicAdd(&(bar)[XB_TMO], 1u); break; } } } } while (0)
struct XcdBarrier { unsigned* bar; unsigned x; volatile LAS unsigned* st; };
__device__ __forceinline__ XcdBarrier xcd_barrier_post(unsigned* bar, volatile LAS unsigned* st) {
    XcdBarrier b; b.bar = bar; b.x = xb_xcc_id(); b.st = st;
    if (threadIdx.x == 0) (void)xb_add(&bar[XB_XCNT(b.x)], 1u);
    return b;
}
__device__ __forceinline__ void xcd_barrier_complete(unsigned* bar, unsigned x, unsigned& nloc, unsigned& nx) {
    const unsigned G = gridDim.x * gridDim.y * gridDim.z;
    unsigned sum, cnt, mine, sp = 0u;
    for (;;) {
        sum = 0u; cnt = 0u; mine = 0u;
#pragma unroll
        for (unsigned j = 0; j < 16; ++j) { const unsigned c = xb_ld(&bar[XB_XCNT(j)]); sum += c; cnt += (c > 0u) ? 1u : 0u; mine = (j == x) ? c : mine; }
        if (sum == G) break;
        __builtin_amdgcn_s_sleep(1);
        if ((++sp & 255u) == 0u) { if (xb_ld(&bar[XB_TMO])) break; if (sp > XB_SPIN_CAP) { atomicAdd(&bar[XB_TMO], 1u); break; } }
    }
    nloc = mine > 0u ? mine : 1u; nx = cnt > 0u ? cnt : 1u;
}
__device__ __forceinline__ void xcd_barrier(const XcdBarrier& b) {
    asm volatile("s_waitcnt vmcnt(0)" ::: "memory");
    __syncthreads();
    if (threadIdx.x == 0) {
        unsigned* bar = b.bar;
        __builtin_amdgcn_s_waitcnt(0);
        unsigned nloc = b.st[0], nx = b.st[1];
        if (nloc == 0u) { xcd_barrier_complete(bar, b.x, nloc, nx); b.st[0] = nloc; b.st[1] = nx; }
        const unsigned old = xb_add(&bar[XB_XSUB(b.x)], 1u);
        const unsigned gen = old / nloc;
        if (old + 1u == (gen + 1u) * nloc) {
            __builtin_amdgcn_fence(__ATOMIC_RELEASE, "agent");
            asm volatile("s_waitcnt vmcnt(0)" ::: "memory");
            const unsigned og = xb_add(&bar[XB_TOP], 1u);
            const unsigned tg = og / nx;
            if (og + 1u == (tg + 1u) * nx) xb_add(&bar[XB_TOPGEN], 1u);
            else XB_SPIN(xb_ld(&bar[XB_TOPGEN]) == tg, bar);
            __builtin_amdgcn_fence(__ATOMIC_ACQUIRE, "agent");
            xb_add(&bar[XB_XGEN(b.x)], 1u);
            asm volatile("s_waitcnt vmcnt(0)" ::: "memory");
        } else {
            XB_SPIN(xb_ld(&bar[XB_XGEN(b.x)]) == gen, bar);
            __builtin_amdgcn_fence(__ATOMIC_ACQUIRE, "agent");
            asm volatile("s_waitcnt vmcnt(0)" ::: "memory");
        }
    }
    __syncthreads();
}

__global__ void __launch_bounds__(512) fwd_megakernel(Params P_arg) {
    const Params& P = P_arg;
    extern __shared__ __attribute__((aligned(16))) unsigned char shm[];
    LAS unsigned char* lds = (LAS unsigned char*)shm;
    cg::grid_group grid = cg::this_grid();
    const int G = gridDim.x, bid = blockIdx.x;
    __shared__ uint4 xb_words;
    if (threadIdx.x == 0) xb_words = make_uint4(0u, 0u, 0u, 0u);
    __syncthreads();
    const XcdBarrier xb = xcd_barrier_post((unsigned*)(P.ws + O_BAR), (volatile LAS unsigned*)&xb_words);
#define WSP() const Params P = load_params(); unsigned char* ws = ls(P.ws); bf16_t* WinT = (bf16_t*)(ws + O_WINT); bf16_t* WoutT = (bf16_t*)(ws + O_WOUTT); bf16_t* HMIX = (bf16_t*)(ws + O_HMIX); bf16_t* PROJ = (bf16_t*)(ws + O_PROJ); (void)WinT; (void)WoutT; (void)HMIX; (void)PROJ

    phase0a(P, lds, G);
    grid.sync();
    {
        WSP();
        SchedFold S; S.G = G; S.c = bid;
        EpiFold E; E.WinT = WinT;
        Gemm g; g.A = (const bf16_t*)(ws + O_MTF); g.Bt = (const bf16_t*)(ws + O_WCX); g.K = 512;
        pg8::gemm_phase(lds, g, S, E);
        const float* modp = (const float*)(ws + O_MODP); float* mod = (float*)(ws + O_MOD);
        for (int e = bid * 512 + threadIdx.x; e < DEPTH * 3 * 1536; e += G * 512) {
            const int n4 = (e % 1536) * 4, lr = e / 1536, l = lr / 3, r = lr % 3;
            f32x4 a = *(const f32x4*)(P.b_mod + (size_t)l * 6144 + n4);
            for (int s = 0; s < 32; ++s) a += *(const f32x4*)(modp + ((size_t)(l * 32 + s) * 3 + r) * 6144 + n4);
            *(f32x4*)(mod + (size_t)lr * 6144 + n4) = a;
        }
    }
    xcd_barrier(xb);
#pragma unroll 1
    for (int layer = 0; layer < DEPTH; ++layer) {
        const bool lastl = layer == DEPTH - 1;
        row_phase(P, layer, G);
        xcd_barrier(xb);
        {
            WSP();
            SchedIn S; S.init(66, 22, G, bid);
            EpiIn E; E.PROJ = PROJ; E.avT = (bf16_t*)(ws + O_AVT); E.VT = (bf16_t*)(ws + O_VT); E.VTc = (bf16_t*)(ws + O_VTC); E.ZT = (bf16_t*)(ws + O_ZT); E.ZTc = (bf16_t*)(ws + O_ZTC); E.rope = (const float2*)(ws + O_ROPE);
            Gemm g; g.A = HMIX; g.Bt = WinT + (size_t)layer * NCOL * DM; g.K = DM;
            pg8::gemm_phase(lds, g, S, E);
        }
        xcd_barrier(xb);
        {
            WSP();
            for (int task = bid; task < 512; task += G) attn_task(P, layer, task, lds);
            {   SchedFew S; S.n = 256; S.G = G; S.c = bid;
                EpiS1 E; E.Bint = (bf16_t*)(ws + O_BINT);
                Gemm g; g.A = (const bf16_t*)(ws + O_F128); g.Bt = (const bf16_t*)(ws + O_ZT); g.K = 256;
                pg8::gemm_phase(lds, g, S, E); }
            const int nch = lastl ? 128 : 132;
            for (int ch = bid; ch < nch; ch += G) gmlp_task(P, layer, ch, lds);
            if (!lastl) {
                const int c2 = (bid - 132 + G) % G;
                for (int t = c2; t < 16; t += G) attn_task(P, layer, 512 + t, lds);
                __syncthreads();
                SchedFew S; S.n = 4; S.G = G; S.c = (bid - 148 + G) % G;
                EpiCtxF E; E.MIX = HMIX; E.PROJ = PROJ; E.bf = P.b_f + (size_t)layer * 512;
                Gemm g; g.A = (const bf16_t*)(ws + O_DCTX); g.Bt = (const bf16_t*)(ws + O_ZTC); g.K = 512;
                pg8::gemm_phase(lds, g, S, E);
            }
        }
        xcd_barrier(xb);
        stage2_phase(P, layer, G);
        if (!lastl) for (int tile = bid; tile < 256; tile += G) ctx_outproj_tile(P, layer, tile, lds);
        xcd_barrier(xb);
        {
            WSP();
            pg8::StaticOrder S; S.init(64, 8, G, bid);
            EpiOut E; E.Y = PROJ;
            Gemm g; g.A = HMIX; g.Bt = WoutT + (size_t)layer * DM * DM; g.K = DM;
            pg8::gemm_phase(lds, g, S, E);
        }
        xcd_barrier(xb);
    }
    row_phase(P, DEPTH, G);
}

extern "C" void kernel_launch(void* const* d_in, const int* in_sizes, int n_in, void* d_out, int out_size, void* d_ws, size_t ws_size, hipStream_t stream) {
    constexpr size_t kDynLds = LDS_TOTAL;
    static int grid_blocks = 0;
    if (!grid_blocks) {
        if (ws_size < WS_END) { fprintf(stderr, "kernel_launch: workspace too small: %zu < %zu\n", ws_size, (size_t)WS_END); grid_blocks = -1; return; }
        int dev = 0, cus = 0, per_cu = 0;
        hipGetDevice(&dev);
        hipDeviceGetAttribute(&cus, hipDeviceAttributeMultiprocessorCount, dev);
        hipFuncSetAttribute((const void*)fwd_megakernel, hipFuncAttributeMaxDynamicSharedMemorySize, (int)kDynLds);
        hipOccupancyMaxActiveBlocksPerMultiprocessor(&per_cu, (const void*)fwd_megakernel, 512, kDynLds);
        if (per_cu < 1) { fprintf(stderr, "kernel_launch: occupancy query says %d blocks/CU\n", per_cu); per_cu = 1; }
        grid_blocks = cus * 1;
    }
    if (grid_blocks < 0) return;
    Params p{};
    p.x = (const float*)d_in[0]; p.c = (const float*)d_in[1]; p.ctx = (const float*)d_in[2]; p.c_ctx = (const float*)d_in[3];
    p.w_mod = (const float*)d_in[4]; p.b_mod = (const float*)d_in[5]; p.g_pre = (const float*)d_in[6]; p.g_post = (const float*)d_in[7];
    p.w_in = (const float*)d_in[8]; p.w_out = (const float*)d_in[9]; p.g_sgu = (const float*)d_in[10]; p.w_sgu = (const float*)d_in[11];
    p.b_sgu = (const float*)d_in[12]; p.sink = (const float*)d_in[13]; p.w_f = (const float*)d_in[14]; p.b_f = (const float*)d_in[15];
    p.out = (float*)d_out; p.ws = (unsigned char*)d_ws;
    (void)hipMemsetAsync((unsigned char*)d_ws + O_BAR, 0, XCD_BAR_WORDS * 4, stream);
    void* args[] = {&p};
    hipError_t e = hipLaunchCooperativeKernel((const void*)fwd_megakernel, dim3(grid_blocks), dim3(512), args, kDynLds, stream);
    if (e != hipSuccess) fprintf(stderr, "cooperative launch failed: %s (grid %d)\n", hipGetErrorString(e), grid_blocks);
}
```

```cpp
#include <hip/hip_runtime.h>
#include <hip/hip_cooperative_groups.h>
#include <cstdio>
#include <cstdint>
namespace cg = cooperative_groups;

#define LAS __attribute__((address_space(3)))
typedef unsigned short bf16_t;
typedef short bf16x8 __attribute__((ext_vector_type(8)));
typedef short bf16x4 __attribute__((ext_vector_type(4)));
typedef float f32x4 __attribute__((ext_vector_type(4)));
typedef unsigned u32x2 __attribute__((ext_vector_type(2)));
typedef unsigned u32x4 __attribute__((ext_vector_type(4)));

constexpr int DM = 2048, SEQ = 8192, NB = 2, DEPTH = 4, CTXL = 256;
constexpr int MLAT = NB * SEQ;
constexpr int MROWS = MLAT + NB * CTXL;
constexpr int NCOL = 5632;
constexpr int C_AU = 0, C_AV = 512, C_AG = 1024, C_Q = 1536, C_K = 2560, C_V = 2816, C_BG = 3072, C_ZR = 4096, C_CG = 5120;
constexpr float EPS = 1e-6f;
constexpr float QSCALE = 0.08838834764831845f * 1.4426950408889634f;
constexpr float LOG2E = 1.4426950408889634f;

constexpr size_t AL(size_t x) { return (x + 255) & ~(size_t)255; }
constexpr size_t O_WINT = 0;
constexpr size_t O_WOUTT = O_WINT + AL((size_t)DEPTH * NCOL * DM * 2);
constexpr size_t O_MOD = O_WOUTT + AL((size_t)DEPTH * DM * DM * 2);
constexpr size_t O_ROPE = O_MOD + AL((size_t)DEPTH * 3 * 6144 * 4);
constexpr size_t O_TWID = O_ROPE + AL((size_t)128 * 32 * 8);
constexpr size_t O_F128 = O_TWID + AL((size_t)8192 * 8);
constexpr size_t O_F64 = O_F128 + AL((size_t)256 * 256 * 2);
constexpr size_t O_DCTX = O_F64 + AL((size_t)64 * 128 * 2);
constexpr size_t O_XC = O_DCTX + AL((size_t)256 * 512 * 2);
constexpr size_t O_HMIX = O_XC + AL((size_t)512 * DM * 4);
constexpr size_t O_PROJ = O_HMIX + AL((size_t)MROWS * DM * 2);
constexpr size_t O_AVT = O_PROJ + AL((size_t)MROWS * NCOL * 2);
constexpr size_t O_VT = O_AVT + AL((size_t)132 * 512 * 128 * 2);
constexpr size_t O_VTC = O_VT + AL((size_t)NB * 2 * 128 * SEQ * 2);
constexpr size_t O_ZT = O_VTC + AL((size_t)NB * 2 * 128 * CTXL * 2);
constexpr size_t O_ZTC = O_ZT + AL((size_t)NB * 512 * 64 * 256 * 2);
constexpr size_t O_BINT = O_ZTC + AL((size_t)NB * 512 * 512 * 2);
constexpr size_t O_YC = O_BINT + AL((size_t)NB * 128 * 512 * 128 * 2);
constexpr size_t O_BAR = O_YC + AL((size_t)512 * DM * 2);
constexpr size_t O_WCX = O_BAR + 16384;
constexpr size_t O_MTF = O_WCX + AL((size_t)DEPTH * DM * 512 * 2);
constexpr size_t O_MODP = O_MTF + AL((size_t)DEPTH * 1024 * 512 * 2);
constexpr size_t O_P0END = O_MODP + AL((size_t)DEPTH * 32 * 3 * 6144 * 4);
constexpr size_t O_XB = O_WCX;
constexpr size_t WS_END = (O_XB + (size_t)MLAT * DM * 2 > O_P0END) ? O_XB + (size_t)MLAT * DM * 2 : O_P0END;

struct Params {
    const float *x, *c, *ctx, *c_ctx, *w_mod, *b_mod, *g_pre, *g_post, *w_in, *w_out, *g_sgu, *w_sgu, *b_sgu, *sink, *w_f, *b_f;
    float* out;
    unsigned char* ws;
};

__device__ __forceinline__ Params load_params() {
#if defined(__HIP_DEVICE_COMPILE__)
    auto p = __builtin_amdgcn_kernarg_segment_ptr(); asm volatile("" : "+s"(p));
    return *(const __attribute__((address_space(4))) Params*)p;
#else
    return Params{};
#endif
}
__device__ __forceinline__ int lv(int x) { asm volatile("" : "+v"(x)); return x; }
template <class T> __device__ __forceinline__ T* ls(T* p) { asm volatile("" : "+s"(p)); return p; }
__device__ __forceinline__ unsigned cvt_pk_bf16(float lo, float hi) { unsigned r; asm volatile("v_cvt_pk_bf16_f32 %0, %1, %2" : "=v"(r) : "v"(lo), "v"(hi)); return r; }
__device__ __forceinline__ bf16_t f2bf(float v) { return (bf16_t)(cvt_pk_bf16(v, 0.f) & 0xffffu); }
__device__ __forceinline__ float bf2f(unsigned b) { return __uint_as_float(b << 16); }
__device__ __forceinline__ float bflo(unsigned w) { return __uint_as_float(w << 16); }
__device__ __forceinline__ float bfhi(unsigned w) { return __uint_as_float(w & 0xffff0000u); }
__device__ __forceinline__ float gelu_t(float x) { const float u2 = x * (x * x * (-2.f * 0.7978845608028654f * 0.044715f * 1.4426950408889634f) + (-2.f * 0.7978845608028654f * 1.4426950408889634f)); return x * __builtin_amdgcn_rcpf(1.f + __builtin_amdgcn_exp2f(u2)); }
__device__ __forceinline__ float silu_f(float x) { return x * __builtin_amdgcn_rcpf(1.f + __builtin_amdgcn_exp2f(x * -1.4426950408889634f)); }
__device__ __forceinline__ float wave_sum(float v) {
#pragma unroll
    for (int o = 1; o < 64; o <<= 1) v += __shfl_xor(v, o);
    return v;
}
__device__ __forceinline__ float xor16_max(float x) { auto r = __builtin_amdgcn_permlane16_swap(__float_as_uint(x), __float_as_uint(x), false, false); return fmaxf(__uint_as_float(r[0]), __uint_as_float(r[1])); }
__device__ __forceinline__ float xor32_max(float x) { auto r = __builtin_amdgcn_permlane32_swap(__float_as_uint(x), __float_as_uint(x), false, false); return fmaxf(__uint_as_float(r[0]), __uint_as_float(r[1])); }
__device__ __forceinline__ float xor16_sum(float x) { auto r = __builtin_amdgcn_permlane16_swap(__float_as_uint(x), __float_as_uint(x), false, false); return __uint_as_float(r[0]) + __uint_as_float(r[1]); }
__device__ __forceinline__ float xor32_sum(float x) { auto r = __builtin_amdgcn_permlane32_swap(__float_as_uint(x), __float_as_uint(x), false, false); return __uint_as_float(r[0]) + __uint_as_float(r[1]); }
__device__ __forceinline__ u32x2 pack4(float a, float b, float c, float d) { u32x2 r; r.x = cvt_pk_bf16(a, b); r.y = cvt_pk_bf16(c, d); return r; }

namespace pg8 {
constexpr int BM = 256, BK = 64, HALF = 128, HTB = HALF * BK * 2, STAGE_BYTES = 8 * HTB, NXCD = 8, WGM = 8;
__host__ __device__ __forceinline__ int lds_byte(int r, int c) { const int st = (r >> 4) * 2 + (c >> 5), rr = r & 15, cc = c & 31, ob = rr * 64 + cc * 2; return st * 1024 + (ob ^ (((ob >> 9) & 1) << 5)); }
__host__ __device__ __forceinline__ void stage_rc(int b, int& R, int& C) { const int st = b / 1024, sb = b % 1024, swz = sb ^ (((sb >> 9) & 1) << 5); R = (st >> 1) * 16 + swz / 64; C = (st & 1) * 32 + (swz % 64) / 2; }
__host__ __device__ __forceinline__ int perm32(int rho) { const int n = rho >> 4, i = rho & 15; return 8 * (i >> 2) + 4 * n + (i & 3); }
struct Unit { int pm, pn; };
struct Gemm { const bf16_t* A; const bf16_t* Bt; int K; };

struct SchedBase {
    __device__ __forceinline__ void amap(const Unit& u, const Gemm& g, const char*& base, unsigned& rs, unsigned& hs) const {
        rs = (unsigned)g.K * 2u; hs = (unsigned)HALF * g.K * 2u; base = (const char*)g.A + (size_t)u.pm * BM * g.K * 2;
    }
    __device__ __forceinline__ void bmap(const Unit& u, const Gemm& g, const char*& base, unsigned& rs, unsigned& hs) const {
        rs = (unsigned)g.K * 2u; hs = (unsigned)HALF * g.K * 2u; base = (const char*)g.Bt + (size_t)u.pn * BM * g.K * 2;
    }
};
struct StaticOrder : SchedBase {
    int nM, nN, nwg, G, c;
    __device__ void init(int nM_, int nN_, int G_, int c_) { nM = nM_; nN = nN_; nwg = nM * nN; G = G_; c = c_; }
    __device__ bool next(int i, Unit& u) const {
        const long L = (long)i * G + c; if (L >= nwg) return false;
        int wgid = (int)L; { const int q = nwg / NXCD, r = nwg % NXCD, xcd = wgid % NXCD, off = wgid / NXCD; wgid = (xcd < r ? xcd * (q + 1) : r * (q + 1) + (xcd - r) * q) + off; }
        const int nig = WGM * nN, gid = wgid / nig, fm = gid * WGM, gsz = (nM - fm) < WGM ? (nM - fm) : WGM;
        u.pm = fm + ((wgid % nig) % gsz); u.pn = (wgid % nig) / gsz; return true;
    }
};

template <class Epi, class Sched>
__device__ __forceinline__ void gemm_phase(LAS unsigned char* lds, const Gemm g, const Sched& S, const Epi& E) {
    const int tid = lv(threadIdx.x), wid = __builtin_amdgcn_readfirstlane(tid >> 6), lane = tid & 63, wr = wid >> 2, wc = wid & 3, fr = lane & 15, fq = lane >> 4;
    int K = g.K; asm volatile("" : "+s"(K));
    const int nt = K / BK;
#define PG8_VOFFB(dst, rs) do { const int _t = lv(tid); _Pragma("unroll") for (int _i = 0; _i < 2; ++_i) { int _R, _C; stage_rc(_t * 16 + _i * 8192, _R, _C); const int _Rb = (_R & ~31) + perm32(_R & 31); dst[_i] = (unsigned)_Rb * (rs) + (unsigned)_C * 2u; } } while (0)
#define PG8_VOFFA(dst, rs) do { const int _t = lv(tid); _Pragma("unroll") for (int _i = 0; _i < 2; ++_i) { int _R, _C; stage_rc(_t * 16 + _i * 8192, _R, _C); dst[_i] = (unsigned)_R * (rs) + (unsigned)_C * 2u; } } while (0)
    const size_t kstep = (size_t)(BK * 2);
    const unsigned ldsw = (unsigned)wid * 1024u;
    const int aoff = lds_byte(wr * 64 + fr, fq * 8), boff = lds_byte(wc * 32 + fr, fq * 8);
#define PG8_SA(b, h) (((b) * 2 + (h)) * HTB)
#define PG8_SB(b, h) ((4 + (b) * 2 + (h)) * HTB)
#define PG8_STAGE(bufoff, gbase, voff) do { _Pragma("unroll") for (int _i = 0; _i < 2; ++_i) \
        __builtin_amdgcn_global_load_lds((const unsigned*)((const char*)(gbase) + (voff)[_i]), (LAS unsigned*)(lds + (bufoff) + ldsw + _i * 8192), 16, 0, 0); } while (0)
#define PG8_LDA(dst, b, h) do { _Pragma("unroll") for (int m = 0; m < 4; ++m) _Pragma("unroll") for (int k = 0; k < 2; ++k) dst[m][k] = *(const LAS bf16x8*)(lds + PG8_SA(b, h) + aoff + m * 2048 + k * 1024); } while (0)
#define PG8_LDB(dst, b, h) do { _Pragma("unroll") for (int n = 0; n < 2; ++n) _Pragma("unroll") for (int k = 0; k < 2; ++k) dst[n][k] = *(const LAS bf16x8*)(lds + PG8_SB(b, h) + boff + n * 2048 + k * 1024); } while (0)
#define PG8_MMA(ai, bj, At, Bt) do { __builtin_amdgcn_s_setprio(1); _Pragma("unroll") for (int m = 0; m < 4; ++m) _Pragma("unroll") for (int n = 0; n < 2; ++n) _Pragma("unroll") for (int k = 0; k < 2; ++k) \
        acc[ai][bj][m][n] = __builtin_amdgcn_mfma_f32_16x16x32_bf16(Bt[n][k], At[m][k], acc[ai][bj][m][n], 0, 0, 0); __builtin_amdgcn_s_setprio(0); } while (0)
#define PG8_WAIT_V(n) asm volatile("s_waitcnt vmcnt(" #n ")" ::: "memory")
#define PG8_WAIT_L(n) asm volatile("s_waitcnt lgkmcnt(" #n ")" ::: "memory")
#define PG8_BAR __builtin_amdgcn_s_barrier()
#define PG8_SCHED __builtin_amdgcn_sched_barrier(0)
    Unit cur, nxt; int ui = 0;
    if (!S.next(0, cur)) return;
    f32x4 acc[2][2][4][2];
#pragma unroll
    for (int a = 0; a < 2; ++a)
#pragma unroll
        for (int b = 0; b < 2; ++b)
#pragma unroll
            for (int m = 0; m < 4; ++m)
#pragma unroll
                for (int n = 0; n < 2; ++n) acc[a][b][m][n] = (f32x4){0.f, 0.f, 0.f, 0.f};
    bf16x8 At[4][2], B0[2][2], B1[2][2];
    const char* cA; unsigned cRS, cHS; S.amap(cur, g, cA, cRS, cHS);
    unsigned vAc[2]; PG8_VOFFA(vAc, cRS);
    const char* cB; unsigned cRSB, cHSB; S.bmap(cur, g, cB, cRSB, cHSB);
    unsigned vBc[2]; PG8_VOFFB(vBc, cRSB);
    PG8_STAGE(PG8_SB(0, 0), cB, vBc); PG8_STAGE(PG8_SB(0, 1), cB + cHSB, vBc); PG8_STAGE(PG8_SA(0, 0), cA, vAc); PG8_STAGE(PG8_SA(0, 1), cA + cHS, vAc);
    if (wr == 1) PG8_BAR;
    PG8_WAIT_V(2); PG8_BAR;
    PG8_STAGE(PG8_SB(1, 0), cB + kstep, vBc); PG8_STAGE(PG8_SA(1, 0), cA + kstep, vAc); PG8_STAGE(PG8_SB(1, 1), cB + cHSB + kstep, vBc);
    PG8_WAIT_V(6); PG8_BAR;
    for (;;) {
        const bool has_next = S.next(ui + 1, nxt);
        const char* nA = cA; unsigned nRS = cRS, nHS = cHS; const char* nB = cB; unsigned nRSB = cRSB, nHSB = cHSB;
        if (has_next) { S.amap(nxt, g, nA, nRS, nHS); S.bmap(nxt, g, nB, nRSB, nHSB); }
        for (int t = 0; t < nt; t += 2) {
            const bool last = (t == nt - 2);
            const char* a1 = cA + (size_t)(t + 1) * kstep;
            const char* a2 = last ? nA : cA + (size_t)(t + 2) * kstep; const char* b2 = last ? nB : cB + (size_t)(t + 2) * kstep;
            const char* a3 = a2 + kstep; const char* b3 = b2 + kstep;
            const unsigned hs2 = last ? nHS : cHS;
            unsigned v2[2] = {vAc[0], vAc[1]}; if (last) PG8_VOFFA(v2, nRS);
            const unsigned hsB2 = last ? nHSB : cHSB;
            unsigned vB2[2] = {vBc[0], vBc[1]}; if (last) PG8_VOFFB(vB2, nRSB);
            PG8_LDB(B0, 0, 0); PG8_LDB(B1, 0, 1); PG8_SCHED; PG8_LDA(At, 0, 0); PG8_STAGE(PG8_SA(1, 1), a1 + cHS, vAc);
            PG8_WAIT_V(8); PG8_WAIT_L(0); PG8_BAR; PG8_MMA(0, 0, At, B0); PG8_MMA(0, 1, At, B1); PG8_BAR; PG8_SCHED;
            PG8_LDA(At, 0, 1); PG8_STAGE(PG8_SB(0, 0), b2, vB2); PG8_STAGE(PG8_SB(0, 1), b2 + hsB2, vB2); PG8_STAGE(PG8_SA(0, 0), a2, v2);
            PG8_WAIT_V(8); PG8_WAIT_L(0); PG8_BAR; PG8_MMA(1, 0, At, B0); PG8_MMA(1, 1, At, B1); PG8_BAR; PG8_SCHED;
            PG8_LDB(B0, 1, 0); PG8_LDB(B1, 1, 1); PG8_SCHED; PG8_LDA(At, 1, 0); PG8_STAGE(PG8_SA(0, 1), a2 + hs2, v2);
            PG8_WAIT_V(8); PG8_WAIT_L(0); PG8_BAR; PG8_MMA(0, 0, At, B0); PG8_MMA(0, 1, At, B1); PG8_BAR; PG8_SCHED;
            PG8_LDA(At, 1, 1); PG8_STAGE(PG8_SB(1, 0), b3, vB2); PG8_STAGE(PG8_SB(1, 1), b3 + hsB2, vB2); PG8_STAGE(PG8_SA(1, 0), a3, v2);
            PG8_WAIT_V(8); PG8_WAIT_L(0); PG8_BAR; PG8_MMA(1, 0, At, B0); PG8_MMA(1, 1, At, B1); PG8_BAR; PG8_SCHED;
        }
        if (wr == 0) PG8_BAR;
        { const int l2 = lv(threadIdx.x) & 63; E(acc, cur, wr, wc, l2 & 15, l2 >> 4); }
        if (!has_next) break;
#pragma unroll
        for (int a = 0; a < 2; ++a)
#pragma unroll
            for (int b = 0; b < 2; ++b)
#pragma unroll
                for (int m = 0; m < 4; ++m)
#pragma unroll
                    for (int n = 0; n < 2; ++n) acc[a][b][m][n] = (f32x4){0.f, 0.f, 0.f, 0.f};
        cur = nxt; cA = nA; cRS = nRS; cHS = nHS; PG8_VOFFA(vAc, cRS); cB = nB; cRSB = nRSB; cHSB = nHSB; PG8_VOFFB(vBc, cRSB); ++ui;
        if (wr == 1) PG8_BAR;
    }
    PG8_WAIT_V(0);
    PG8_BAR;
#undef PG8_VOFFA
#undef PG8_VOFFB
#undef PG8_SA
#undef PG8_SB
#undef PG8_STAGE
#undef PG8_LDA
#undef PG8_LDB
#undef PG8_MMA
#undef PG8_WAIT_V
#undef PG8_WAIT_L
#undef PG8_BAR
#undef PG8_SCHED
}
}
using pg8::Unit;
using pg8::Gemm;

__device__ __forceinline__ bool in_swapped(int pn) { return pn == 2 || pn == 3 || pn == 11 || (pn >= 16 && pn < 20); }
struct SchedIn : pg8::StaticOrder {
    __device__ __forceinline__ void tokmap(const Unit& u, bool gather, const Gemm& g, const char*& base, unsigned& rs, unsigned& hs) const {
        if (gather && u.pm < 64) { const int b = u.pm >> 5, t20 = 2 * (u.pm & 31); rs = 64u * DM * 2u; hs = DM * 2u; base = (const char*)g.A + ((size_t)b * SEQ + t20) * DM * 2; }
        else { rs = DM * 2u; hs = 128u * DM * 2u; base = (const char*)g.A + (size_t)u.pm * 256 * DM * 2; }
    }
    __device__ __forceinline__ void wmap(const Unit& u, const Gemm& g, const char*& base, unsigned& rs, unsigned& hs) const {
        rs = DM * 2u; hs = 128u * DM * 2u; base = (const char*)g.Bt + (size_t)u.pn * 256 * DM * 2;
    }
    __device__ __forceinline__ void amap(const Unit& u, const Gemm& g, const char*& base, unsigned& rs, unsigned& hs) const {
        if (in_swapped(u.pn)) wmap(u, g, base, rs, hs); else tokmap(u, false, g, base, rs, hs);
    }
    __device__ __forceinline__ void bmap(const Unit& u, const Gemm& g, const char*& base, unsigned& rs, unsigned& hs) const {
        if (in_swapped(u.pn)) tokmap(u, u.pn >= 16, g, base, rs, hs); else wmap(u, g, base, rs, hs);
    }
};
struct SchedFold : pg8::SchedBase {
    int G, c;
    __device__ bool next(int i, Unit& u) const { const int L = i * G + c; if (L >= 128) return false; const int l = L >> 5, r = L & 31; u.pm = l * 4 + (r >> 3); u.pn = l * 8 + (r & 7); return true; }
};
struct SchedFew : pg8::SchedBase {
    int n, G, c;
    __device__ bool next(int i, Unit& u) const { const int L = i * G + c; if (c < 0 || L >= n) return false; u.pm = 0; u.pn = L; return true; }
};

struct EpiIn {
    bf16_t *PROJ, *avT, *VT, *VTc, *ZT, *ZTc; const float2* rope;
    __device__ __forceinline__ void operator()(const f32x4 (&acc)[2][2][4][2], const Unit& u, int wr, int wc, int fr, int fq) const {
        if (in_swapped(u.pn)) {
#pragma unroll
            for (int ai = 0; ai < 2; ++ai) {
                const int nt = 2 * u.pn + ai;
#pragma unroll
                for (int m = 0; m < 4; ++m) {
                    const int ch = wr * 64 + m * 16 + lv(fr);
#pragma unroll
                    for (int bj = 0; bj < 2; ++bj) {
                        const f32x4 v0 = acc[ai][bj][m][0], v1 = acc[ai][bj][m][1];
                        const int tk = 32 * wc + 8 * fq;
                        bf16_t* dst;
                        u32x4 pk;
                        if (nt < 8) {
                            const int chunk = u.pm * 2 + bj;
                            dst = avT + ((size_t)chunk * 512 + (nt - 4) * 128 + ch) * 128 + tk;
                            pk.x = cvt_pk_bf16(gelu_t(v0[0]), gelu_t(v0[1])); pk.y = cvt_pk_bf16(gelu_t(v0[2]), gelu_t(v0[3])); pk.z = cvt_pk_bf16(gelu_t(v1[0]), gelu_t(v1[1])); pk.w = cvt_pk_bf16(gelu_t(v1[2]), gelu_t(v1[3]));
                        } else {
                            pk.x = cvt_pk_bf16(v0[0], v0[1]); pk.y = cvt_pk_bf16(v0[2], v0[3]); pk.z = cvt_pk_bf16(v1[0], v1[1]); pk.w = cvt_pk_bf16(v1[2], v1[3]);
                            if (nt < 24) {
                                const int kvh = nt - 22, row = u.pm * 256 + bj * 128 + tk;
                                if (row < MLAT) dst = VT + ((size_t)((row >> 13) * 2 + kvh) * 128 + ch) * SEQ + (row & 8191);
                                else { const int rc = row - MLAT; dst = VTc + ((size_t)((rc >> 8) * 2 + kvh) * 128 + ch) * CTXL + (rc & 255); }
                            } else {
                                const int ri = (nt - 32) >> 2, j = ((nt - 32) & 3) * 128 + ch;
                                if (u.pm < 64) { const int b = u.pm >> 5, t2 = 2 * (u.pm & 31) + bj; dst = ZT + (((size_t)(b * 512 + j) * 64 + t2) * 256) + ri * 128 + tk; }
                                else { const int rc = (u.pm - 64) * 256 + bj * 128 + tk; dst = ZTc + ((size_t)((rc >> 8) * 512 + j) * 512) + ri * 256 + (rc & 255); }
                            }
                        }
                        *(u32x4*)dst = pk;
                    }
                    asm volatile("" ::: "memory");
                }
            }
            return;
        }
#pragma unroll
        for (int bj = 0; bj < 2; ++bj) {
            const int nt = 2 * u.pn + bj;
            const int colt = nt * 128 + 32 * wc + 8 * fq;
            if (nt < 4 || (nt >= 8 && nt < 12) || (nt >= 24 && nt < 32) || nt >= 40) {
                const bool is_gelu = nt < 4;
#pragma unroll
                for (int ai = 0; ai < 2; ++ai)
#pragma unroll
                    for (int m = 0; m < 4; ++m) {
                        const size_t row = (size_t)u.pm * 256 + ai * 128 + wr * 64 + m * 16 + lv(fr);
                        const f32x4 v0 = acc[ai][bj][m][0], v1 = acc[ai][bj][m][1]; float o[8];
#pragma unroll
                        for (int i = 0; i < 4; ++i) { o[i] = is_gelu ? gelu_t(v0[i]) : silu_f(v0[i]); o[4 + i] = is_gelu ? gelu_t(v1[i]) : silu_f(v1[i]); }
                        u32x4 pk; pk.x = cvt_pk_bf16(o[0], o[1]); pk.y = cvt_pk_bf16(o[2], o[3]); pk.z = cvt_pk_bf16(o[4], o[5]); pk.w = cvt_pk_bf16(o[6], o[7]);
                        *(u32x4*)(PROJ + row * NCOL + colt) = pk;
                        asm volatile("" ::: "memory");
                    }
            } else if (nt < 8) {
#pragma unroll
                for (int ai = 0; ai < 2; ++ai)
#pragma unroll
                    for (int m = 0; m < 4; ++m) {
                        const int row = u.pm * 256 + ai * 128 + wr * 64 + m * 16 + lv(fr);
                        const int chunk = row >> 7, q = row & 127;
#pragma unroll
                        for (int n = 0; n < 2; ++n) {
                            f32x4 v = acc[ai][bj][m][n];
                            const int c0 = (nt - 4) * 128 + 32 * wc + 8 * fq + 4 * n;
#pragma unroll
                            for (int i = 0; i < 4; ++i) avT[((size_t)chunk * 512 + c0 + i) * 128 + q] = f2bf(gelu_t(v[i]));
                            asm volatile("" ::: "memory");
                        }
                    }
            } else if (nt < 22) {
                const bool isq = nt < 20; const float sc = isq ? QSCALE : 1.f;
                const bool lat = u.pm < 64;
                float frev[4];
#pragma unroll
                for (int i = 0; i < 4; ++i) frev[i] = __builtin_amdgcn_exp2f(-(float)((wc & 1) * 16 + fq * 4 + i) * (13.287712379549449f / 32.f)) * 0.15915494309189535f;
#pragma unroll
                for (int ai = 0; ai < 2; ++ai)
#pragma unroll
                    for (int m = 0; m < 4; ++m) {
                        const size_t row = (size_t)u.pm * 256 + ai * 128 + wr * 64 + m * 16 + lv(fr);
                        const int tpos = (int)(row & 8191);
                        const int pos = (wc < 2) ? (tpos >> 6) : (tpos & 63);
                        const f32x4 x0 = acc[ai][bj][m][0], x1 = acc[ai][bj][m][1];
                        float o0[4], o1[4];
                        if (lat) {
#pragma unroll
                            for (int i = 0; i < 4; ++i) { const float rev = (float)pos * frev[i]; const float cx = __builtin_amdgcn_cosf(rev), sx = __builtin_amdgcn_sinf(rev);
                                o0[i] = (x0[i] * cx - x1[i] * sx) * sc; o1[i] = (x1[i] * cx + x0[i] * sx) * sc; }
                        } else {
#pragma unroll
                            for (int i = 0; i < 4; ++i) { o0[i] = x0[i] * sc; o1[i] = x1[i] * sc; }
                        }
                        u32x4 pk; pk.x = cvt_pk_bf16(o0[0], o0[1]); pk.y = cvt_pk_bf16(o0[2], o0[3]); pk.z = cvt_pk_bf16(o1[0], o1[1]); pk.w = cvt_pk_bf16(o1[2], o1[3]);
                        *(u32x4*)(PROJ + row * NCOL + colt) = pk;
                        asm volatile("" ::: "memory");
                    }
            } else if (nt < 24) {
                const int kvh = nt - 22;
#pragma unroll
                for (int ai = 0; ai < 2; ++ai)
#pragma unroll
                    for (int m = 0; m < 4; ++m) {
                        const int row = u.pm * 256 + ai * 128 + wr * 64 + m * 16 + lv(fr);
#pragma unroll
                        for (int n = 0; n < 2; ++n) {
                            f32x4 v = acc[ai][bj][m][n];
                            const int d0 = 32 * wc + 8 * fq + 4 * n;
                            if (row < MLAT) { const int b = row >> 13, t = row & 8191;
#pragma unroll
                                for (int i = 0; i < 4; ++i) VT[((size_t)(b * 2 + kvh) * 128 + d0 + i) * SEQ + t] = f2bf(v[i]);
                            } else { const int rc = row - MLAT, b = rc >> 8, t = rc & 255;
#pragma unroll
                                for (int i = 0; i < 4; ++i) VTc[((size_t)(b * 2 + kvh) * 128 + d0 + i) * CTXL + t] = f2bf(v[i]);
                            }
                            asm volatile("" ::: "memory");
                        }
                    }
            } else {
                const int ri = (nt - 32) >> 2, jt = ((nt - 32) & 3) * 128;
#pragma unroll
                for (int ai = 0; ai < 2; ++ai)
#pragma unroll
                    for (int m = 0; m < 4; ++m) {
                        const int R = wr * 64 + m * 16 + lv(fr);
#pragma unroll
                        for (int n = 0; n < 2; ++n) {
                            f32x4 v = acc[ai][bj][m][n];
                            const int j0 = jt + 32 * wc + 8 * fq + 4 * n;
                            if (u.pm < 64) { const int b = u.pm >> 5, t2 = 2 * (u.pm & 31) + ai;
#pragma unroll
                                for (int i = 0; i < 4; ++i) ZT[(((size_t)(b * 512 + j0 + i) * 64 + t2) * 256) + ri * 128 + R] = f2bf(v[i]);
                            } else { const int rc = (u.pm - 64) * 256 + ai * 128 + R, b = rc >> 8, t = rc & 255;
#pragma unroll
                                for (int i = 0; i < 4; ++i) ZTc[((size_t)(b * 512 + j0 + i) * 512) + ri * 256 + t] = f2bf(v[i]);
                            }
                            asm volatile("" ::: "memory");
                        }
                    }
            }
        }
    }
};
struct EpiOut {
    bf16_t* Y;
    __device__ __forceinline__ void operator()(const f32x4 (&acc)[2][2][4][2], const Unit& u, int wr, int wc, int fr, int fq) const {
#pragma unroll
        for (int ai = 0; ai < 2; ++ai)
#pragma unroll
            for (int m = 0; m < 4; ++m) {
                const size_t row = (size_t)u.pm * 256 + ai * 128 + wr * 64 + m * 16 + fr;
#pragma unroll
                for (int bj = 0; bj < 2; ++bj) { const f32x4 v0 = acc[ai][bj][m][0], v1 = acc[ai][bj][m][1];
                    u32x4 pk; pk.x = cvt_pk_bf16(v0[0], v0[1]); pk.y = cvt_pk_bf16(v0[2], v0[3]); pk.z = cvt_pk_bf16(v1[0], v1[1]); pk.w = cvt_pk_bf16(v1[2], v1[3]);
                    *(u32x4*)(Y + row * DM + u.pn * 256 + bj * 128 + 32 * wc + 8 * fq) = pk; }
            }
    }
};
struct EpiFold {
    bf16_t* WinT;
    __device__ __forceinline__ void operator()(const f32x4 (&acc)[2][2][4][2], const Unit& u, int wr, int wc, int fr, int fq) const {
        const int l = u.pm >> 2;
#pragma unroll
        for (int ai = 0; ai < 2; ++ai)
#pragma unroll
            for (int m = 0; m < 4; ++m) {
                const size_t r = (size_t)(u.pm & 3) * 256 + ai * 128 + wr * 64 + m * 16 + fr;
#pragma unroll
                for (int bj = 0; bj < 2; ++bj) { const f32x4 v0 = acc[ai][bj][m][0], v1 = acc[ai][bj][m][1];
                    u32x4 pk; pk.x = cvt_pk_bf16(v0[0], v0[1]); pk.y = cvt_pk_bf16(v0[2], v0[3]); pk.z = cvt_pk_bf16(v1[0], v1[1]); pk.w = cvt_pk_bf16(v1[2], v1[3]);
                    *(u32x4*)(WinT + ((size_t)l * NCOL + C_ZR + r) * DM + (u.pn & 7) * 256 + bj * 128 + 32 * wc + 8 * fq) = pk; }
            }
    }
};
struct EpiS1 {
    bf16_t* Bint;
    __device__ __forceinline__ void operator()(const f32x4 (&acc)[2][2][4][2], const Unit& u, int wr, int wc, int fr, int fq) const {
#pragma unroll
        for (int m = 0; m < 4; ++m) {
            const int k1 = lv(wr * 64 + m * 16 + fr);
#pragma unroll
            for (int bj = 0; bj < 2; ++bj) {
                const int c = u.pn * 256 + bj * 128 + 32 * wc + 8 * fq;
                const int t2 = c & 63, bjx = c >> 6, b = bjx >> 9, j = bjx & 511;
                float br[8], bi[8];
#pragma unroll
                for (int n = 0; n < 2; ++n) {
                    const f32x4 ar = acc[0][bj][m][n], aim = acc[1][bj][m][n];
#pragma unroll
                    for (int i = 0; i < 4; ++i) { const float rev = (float)(k1 * (t2 + 4 * n + i)) * (1.f / 8192.f); const float cw = __builtin_amdgcn_cosf(rev), sw = __builtin_amdgcn_sinf(rev);
                        br[4 * n + i] = ar[i] * cw - aim[i] * sw; bi[4 * n + i] = ar[i] * sw + aim[i] * cw; }
                }
                const unsigned off = (unsigned)(((b * 128 + k1) * 512 + j) * 128 + t2);
                u32x4 p0, p1; p0.x = cvt_pk_bf16(br[0], br[1]); p0.y = cvt_pk_bf16(br[2], br[3]); p0.z = cvt_pk_bf16(br[4], br[5]); p0.w = cvt_pk_bf16(br[6], br[7]);
                p1.x = cvt_pk_bf16(bi[0], bi[1]); p1.y = cvt_pk_bf16(bi[2], bi[3]); p1.z = cvt_pk_bf16(bi[4], bi[5]); p1.w = cvt_pk_bf16(bi[6], bi[7]);
                *(u32x4*)(Bint + off) = p0; *(u32x4*)(Bint + off + 64) = p1;
            }
            asm volatile("" ::: "memory");
        }
    }
};
struct EpiCtxF {
    bf16_t* MIX; const bf16_t* PROJ; const float* bf;
    __device__ __forceinline__ void operator()(const f32x4 (&acc)[2][2][4][2], const Unit& u, int wr, int wc, int fr, int fq) const {
#pragma unroll
        for (int ai = 0; ai < 2; ++ai) {
            u32x4 gg[4][2];
#pragma unroll
            for (int m = 0; m < 4; ++m)
#pragma unroll
                for (int bj = 0; bj < 2; ++bj) { const int k = ai * 128 + wr * 64 + m * 16 + fr, col = u.pn * 256 + bj * 128 + 32 * wc + 8 * fq, b = col >> 9, j = col & 511;
                    gg[m][bj] = *(const u32x4*)(PROJ + ((size_t)MLAT + b * 256 + k) * NCOL + C_CG + j); }
#pragma unroll
            for (int m = 0; m < 4; ++m)
#pragma unroll
                for (int bj = 0; bj < 2; ++bj) { const int k = ai * 128 + wr * 64 + m * 16 + fr, col = u.pn * 256 + bj * 128 + 32 * wc + 8 * fq, b = col >> 9, j = col & 511;
                    const f32x4 v0 = acc[ai][bj][m][0], v1 = acc[ai][bj][m][1]; const f32x4 b0 = *(const f32x4*)(bf + j), b1 = *(const f32x4*)(bf + j + 4); const u32x4 g2 = gg[m][bj];
                    u32x4 pk; pk.x = cvt_pk_bf16((v0[0] + b0[0]) * bflo(g2.x), (v0[1] + b0[1]) * bfhi(g2.x)); pk.y = cvt_pk_bf16((v0[2] + b0[2]) * bflo(g2.y), (v0[3] + b0[3]) * bfhi(g2.y));
                    pk.z = cvt_pk_bf16((v1[0] + b1[0]) * bflo(g2.z), (v1[1] + b1[1]) * bfhi(g2.z)); pk.w = cvt_pk_bf16((v1[2] + b1[2]) * bflo(g2.w), (v1[3] + b1[3]) * bfhi(g2.w));
                    *(u32x4*)(MIX + ((size_t)MLAT + b * 256 + k) * DM + 1536 + j) = pk; }
            asm volatile("" ::: "memory");
        }
    }
};

__device__ __forceinline__ int qk_dperm(int p) {
    const int wc = p >> 5, fq = (p >> 3) & 3, n = (p >> 2) & 1, i = p & 3;
    return (wc >> 1) * 64 + n * 32 + (wc & 1) * 16 + fq * 4 + i;
}
struct TrTask { const float* src; bf16_t* dst; int sp, scol0, k0, nd0; bool perm; };
__device__ __forceinline__ TrTask tr_decode(const Params& P, bf16_t* WinT, bf16_t* WoutT, int task) {
    TrTask t;
    if (task < DEPTH * 18 * 32) {
        const int l = task / (18 * 32), r = task % (18 * 32), nb = r >> 5, kt = r & 31;
        t.nd0 = nb < 16 ? nb * 256 : (5120 + (nb - 16) * 256); t.scol0 = nb < 16 ? t.nd0 : t.nd0 - 512; t.perm = (t.nd0 >= C_Q && t.nd0 < C_V);
        t.src = P.w_in + (size_t)l * DM * 5120; t.sp = 5120; t.dst = WinT + (size_t)l * NCOL * DM; t.k0 = kt * 64;
    } else {
        const int q = task - DEPTH * 18 * 32, l = q >> 8, r = q & 255, nb = r >> 5, kt = r & 31;
        t.nd0 = nb * 256; t.scol0 = nb * 256; t.perm = false; t.src = P.w_out + (size_t)l * DM * DM; t.sp = DM; t.dst = WoutT + (size_t)l * DM * DM; t.k0 = kt * 64;
    }
    return t;
}
__device__ __forceinline__ void tr_load(const TrTask& t, int tid, f32x4 (&v)[8]) {
#pragma unroll
    for (int i = 0; i < 8; ++i) { const int k = (tid >> 6) + 8 * i, c4 = (tid & 63) * 4; v[i] = *(const f32x4*)(t.src + (size_t)(t.k0 + k) * t.sp + t.scol0 + c4); }
}
__device__ __forceinline__ void tr_store(const TrTask& t, int tid, const f32x4 (&v)[8], LAS float* scr) {
#pragma unroll
    for (int i = 0; i < 8; ++i) { const int k = (tid >> 6) + 8 * i, c4 = (tid & 63) * 4; LAS float* s = scr + k * 257 + c4; s[0] = v[i][0]; s[1] = v[i][1]; s[2] = v[i][2]; s[3] = v[i][3]; }
    __syncthreads();
#pragma unroll
    for (int i = 0; i < 4; ++i) { const int n = (tid >> 3) + 64 * i, kc = tid & 7;
      int sc = n;
      if (t.perm) { const int p = (t.nd0 + n) & 127; sc = (n & ~63) + (qk_dperm(p) & 63); }
      const LAS float* s = scr + (kc * 8) * 257 + sc;
      u32x4 o; o.x = cvt_pk_bf16(s[0], s[257]); o.y = cvt_pk_bf16(s[2 * 257], s[3 * 257]); o.z = cvt_pk_bf16(s[4 * 257], s[5 * 257]); o.w = cvt_pk_bf16(s[6 * 257], s[7 * 257]);
      *(u32x4*)(t.dst + (size_t)(t.nd0 + n) * DM + t.k0 + kc * 8) = o; }
    __syncthreads();
}

__device__ __forceinline__ void phase0a(const Params& P_unused, LAS unsigned char* lds, int G) {
    const Params P = load_params(); (void)P_unused;
    unsigned char* ws = ls(P.ws);
    bf16_t* WinT = (bf16_t*)(ws + O_WINT); bf16_t* WoutT = (bf16_t*)(ws + O_WOUTT); bf16_t* Wcx = (bf16_t*)(ws + O_WCX); bf16_t* MTf = (bf16_t*)(ws + O_MTF);
    float* modp = (float*)(ws + O_MODP); float2* rope = (float2*)(ws + O_ROPE); float2* twid = (float2*)(ws + O_TWID);
    bf16_t* F128 = (bf16_t*)(ws + O_F128); bf16_t* F64 = (bf16_t*)(ws + O_F64); bf16_t* Dctx = (bf16_t*)(ws + O_DCTX);
    LAS float* scr = (LAS float*)lds;
    const int tid = lv(threadIdx.x), bid = blockIdx.x;
    for (int task = bid; task < 384; task += G) {
        const int l = task / 96, s = (task / 3) & 31, nc = task % 3;
        __syncthreads();
        if (tid < 192) { const int r = tid >> 6, kk = tid & 63; const float v = (r < 2) ? P.c[r * DM + s * 64 + kk] : P.c_ctx[s * 64 + kk]; scr[r * 64 + kk] = silu_f(v); }
        __syncthreads();
        const int n = nc * 2048 + tid * 4;
        f32x4 a0 = {0, 0, 0, 0}, a1 = {0, 0, 0, 0}, a2 = {0, 0, 0, 0};
        const float* wp = P.w_mod + ((size_t)l * DM + s * 64) * 6144 + n;
#pragma unroll 16
        for (int kk = 0; kk < 64; ++kk) { const f32x4 w = *(const f32x4*)(wp + (size_t)kk * 6144); a0 += w * scr[kk]; a1 += w * scr[64 + kk]; a2 += w * scr[128 + kk]; }
        float* op = modp + ((size_t)(l * 32 + s) * 3) * 6144 + n;
        *(f32x4*)(op) = a0; *(f32x4*)(op + 6144) = a1; *(f32x4*)(op + 2 * 6144) = a2;
    }
    __syncthreads();
    {   constexpr int NTR = DEPTH * 18 * 32 + DEPTH * 8 * 32;
        const int tl = lv(tid);
        f32x4 va[8], vb[8];
        int task = bid;
        TrTask cur = tr_decode(P, WinT, WoutT, task < NTR ? task : 0);
        if (task < NTR) tr_load(cur, tl, va);
        for (; task < NTR; task += G) {
            const int nxt = task + G;
            TrTask nx = tr_decode(P, WinT, WoutT, nxt < NTR ? nxt : task);
            if (nxt < NTR) tr_load(nx, tl, vb);
            tr_store(cur, tl, va, scr);
#pragma unroll
            for (int i = 0; i < 8; ++i) va[i] = vb[i];
            cur = nx;
        }
    }
    if (tid < 128) { const float a = (float)tid * (1.f / 64.f); scr[tid] = cospif(a); scr[128 + tid] = sinpif(a); }
    __syncthreads();
    const size_t gt = (size_t)bid * 512 + tid, GT = (size_t)G * 512;
    for (size_t e = gt; e < (size_t)DEPTH * DM * 128; e += GT) {
        const size_t lk = e >> 7; const int j4 = (int)(e & 127) * 4;
        const f32x4 v = *(const f32x4*)(P.w_in + lk * 5120 + 4096 + j4);
        *(u32x2*)(Wcx + lk * 512 + j4) = pack4(v[0], v[1], v[2], v[3]);
    }
    for (size_t e = gt; e < (size_t)DEPTH * 1024 * 512; e += GT) {
        const int col = (int)(e & 511), row = (int)((e >> 9) & 1023), l = (int)(e >> 19);
        const int ri = row >> 9, g = (row >> 7) & 3, d = row & 127, g2 = col >> 7, c = col & 127;
        float v = 0.f;
        if (g == g2) {
            const float* wf = P.w_f + ((size_t)(l * 4 + g) * 128) * 128 + d;
            float s = 0.f;
            const LAS float* tb = scr + ri * 128;
#pragma unroll 8
            for (int c2 = 0; c2 < 128; ++c2) s += tb[(c * c2) & 127] * wf[(size_t)c2 * 128];
            v = s * (1.f / 1024.f);
        }
        MTf[e] = f2bf(v);
    }
    for (size_t e = gt; e < 128 * 32; e += GT) { const int pos = (int)(e >> 5), f = (int)(e & 31);
        const float fr = powf(10000.f, -(float)f / 32.f); const float ang = (float)pos * fr; float sn, cs; sincosf(ang, &sn, &cs); rope[e] = make_float2(cs, sn); }
    for (size_t e = gt; e < 8192; e += GT) { const float a = (float)e * (1.f / 4096.f); twid[e] = make_float2(cospif(a), sinpif(a)); }
    for (size_t e = gt; e < 256 * 256; e += GT) { const int n = (int)(e >> 8), kk = (int)(e & 255); const int ro = n >> 7, k1 = n & 127, rin = kk >> 7, t1 = kk & 127;
        const float a = (float)((k1 * t1) & 127) * (1.f / 64.f); const float cs = cospif(a), sn = sinpif(a);
        const float v = ro == 0 ? (rin == 0 ? cs : -sn) : (rin == 0 ? sn : cs); F128[e] = f2bf(v); }
    for (size_t e = gt; e < 64 * 128; e += GT) { const int k2 = (int)(e >> 7), kk = (int)(e & 127); const int rin = kk >> 6, t2 = kk & 63;
        const float a = (float)((k2 * t2) & 63) * (1.f / 32.f); F64[e] = f2bf(rin == 0 ? cospif(a) : -sinpif(a)); }
    for (size_t e = gt; e < 256 * 512; e += GT) { const int k = (int)(e >> 9), kk = (int)(e & 511); const int rin = kk >> 8, t = kk & 255;
        const float a = (float)((k * t) & 255) * (1.f / 128.f); Dctx[e] = f2bf((rin == 0 ? cospif(a) : -sinpif(a)) * 5.656854249492381f); }
}

__device__ __forceinline__ void row_phase(const Params& P_unused, int layer, int G) {
    const Params P = load_params(); (void)P_unused;
    unsigned char* ws = ls(P.ws);
    const float* mod = (const float*)(ws + O_MOD);
    float* XC = (float*)(ws + O_XC);
    bf16_t* XB = (bf16_t*)(ws + O_XB);
    bf16_t* H = (bf16_t*)(ws + O_HMIX);
    const bf16_t* Y = (const bf16_t*)(ws + O_PROJ); const bf16_t* Yc = (const bf16_t*)(ws + O_YC);
    const int tid = lv(threadIdx.x);
    const int lane = tid & 63, gw = blockIdx.x * 8 + (tid >> 6), NGW = G * 8;
    const int nrows = layer == DEPTH ? MLAT : MROWS;
    const bool xb_src = layer >= 2;
    const float* xctx = layer <= 1 ? P.ctx : XC;
    f32x4 vn[8]; u32x2 yn[8], xn[8];
#define ROW_LOAD(r) do { const int _r = (r); \
        if (_r < MLAT && xb_src) { _Pragma("unroll") for (int j = 0; j < 8; ++j) xn[j] = *(const u32x2*)(XB + (size_t)_r * DM + lane * 4 + 256 * j); } \
        else { const float* _x = _r < MLAT ? P.x + (size_t)_r * DM : xctx + (size_t)(_r - MLAT) * DM; _Pragma("unroll") for (int j = 0; j < 8; ++j) vn[j] = *(const f32x4*)(_x + lane * 4 + 256 * j); } \
        if (layer >= 1) { const bf16_t* _y = _r < MLAT ? Y + (size_t)_r * DM : Yc + (size_t)(_r - MLAT) * DM; _Pragma("unroll") for (int j = 0; j < 8; ++j) yn[j] = *(const u32x2*)(_y + lane * 4 + 256 * j); } } while (0)
    if (gw < nrows) ROW_LOAD(gw);
    for (int row = gw; row < nrows; row += NGW) {
        const bool lat = row < MLAT; const int mr = lat ? (row >> 13) : 2;
        f32x4 v[8]; u32x2 yw[8];
        if (lat && xb_src) {
#pragma unroll
            for (int j = 0; j < 8; ++j) v[j] = (f32x4){bflo(xn[j].x), bfhi(xn[j].x), bflo(xn[j].y), bfhi(xn[j].y)};
        } else {
#pragma unroll
            for (int j = 0; j < 8; ++j) v[j] = vn[j];
        }
#pragma unroll
        for (int j = 0; j < 8; ++j) yw[j] = yn[j];
        const int nr = row + NGW;
        if (nr < nrows) ROW_LOAD(nr);
        if (layer >= 1) {
            const float* mg = mod + ((size_t)(layer - 1) * 3 + mr) * 6144 + 4096;
            const float* gp = P.g_post + (size_t)(layer - 1) * DM;
            f32x4 y[8]; float ss = 0.f;
#pragma unroll
            for (int j = 0; j < 8; ++j) { const u32x2 w = yw[j];
                y[j] = (f32x4){bflo(w.x), bfhi(w.x), bflo(w.y), bfhi(w.y)}; ss += y[j][0] * y[j][0] + y[j][1] * y[j][1] + y[j][2] * y[j][2] + y[j][3] * y[j][3]; }
            const float rinv = rsqrtf(wave_sum(ss) * (1.f / DM) + EPS);
#pragma unroll
            for (int j = 0; j < 8; ++j) { const f32x4 g4 = *(const f32x4*)(mg + lane * 4 + 256 * j), p4 = *(const f32x4*)(gp + lane * 4 + 256 * j);
                v[j] = v[j] + g4 * (y[j] * rinv * p4); }
            if (!lat) {
#pragma unroll
                for (int j = 0; j < 8; ++j) *(f32x4*)(XC + (size_t)(row - MLAT) * DM + lane * 4 + 256 * j) = v[j];
            } else if (layer == DEPTH) {
#pragma unroll
                for (int j = 0; j < 8; ++j) *(f32x4*)(P.out + (size_t)row * DM + lane * 4 + 256 * j) = v[j];
            } else {
#pragma unroll
                for (int j = 0; j < 8; ++j) *(u32x2*)(XB + (size_t)row * DM + lane * 4 + 256 * j) = pack4(v[j][0], v[j][1], v[j][2], v[j][3]);
            }
        }
        if (layer < DEPTH) {
            float ss = 0.f;
#pragma unroll
            for (int j = 0; j < 8; ++j) ss += v[j][0] * v[j][0] + v[j][1] * v[j][1] + v[j][2] * v[j][2] + v[j][3] * v[j][3];
            const float rinv = rsqrtf(wave_sum(ss) * (1.f / DM) + EPS);
            const float* msh = mod + ((size_t)layer * 3 + mr) * 6144; const float* msc = msh + 2048;
            const float* gp = P.g_pre + (size_t)layer * DM;
#pragma unroll
            for (int j = 0; j < 8; ++j) { const f32x4 sh = *(const f32x4*)(msh + lane * 4 + 256 * j), sc = *(const f32x4*)(msc + lane * 4 + 256 * j), g4 = *(const f32x4*)(gp + lane * 4 + 256 * j);
                const f32x4 h = (v[j] * rinv * g4) * (sc + 1.f) + sh;
                *(u32x2*)(H + (size_t)row * DM + lane * 4 + 256 * j) = pack4(h[0], h[1], h[2], h[3]); }
        }
    }
#undef ROW_LOAD
}

__device__ __forceinline__ void attn_task(const Params& P_unused, int layer, int task, LAS unsigned char* lds) {
    const Params P = load_params(); (void)P_unused;
    unsigned char* ws = ls(P.ws);
    const bf16_t* PROJ = (const bf16_t*)(ws + O_PROJ);
    const bf16_t* VT = (const bf16_t*)(ws + O_VT); const bf16_t* VTc = (const bf16_t*)(ws + O_VTC);
    bf16_t* MIX = (bf16_t*)(ws + O_HMIX);
    const int tid = lv(threadIdx.x);
    const int lane = tid & 63, w = __builtin_amdgcn_readfirstlane(tid >> 6), fr = lane & 15, fq = lane >> 4;
    int b, blk, kvh, pair; bool isctx;
    if (task < 512) { isctx = false; b = task >> 8; const int rem = task & 255; blk = rem >> 2; kvh = (rem >> 1) & 1; pair = rem & 1; }
    else { isctx = true; const int t = task - 512; b = t >> 3; blk = (t >> 2) & 1; kvh = (t >> 1) & 1; pair = t & 1; }
    const int head = kvh * 4 + pair * 2 + (w >> 2);
    const int a0 = (w & 3) * 32;
    const size_t qrow0 = (isctx ? (size_t)MLAT + b * CTXL : (size_t)b * SEQ) + blk * 128 + a0;
    bf16x8 qf[2][4];
#pragma unroll
    for (int u = 0; u < 2; ++u)
#pragma unroll
        for (int c = 0; c < 4; ++c) qf[u][c] = *(const bf16x8*)(PROJ + (qrow0 + u * 16 + fr) * NCOL + C_Q + head * 128 + c * 32 + fq * 8);
    u32x2 gws[2][8];
#pragma unroll
    for (int u = 0; u < 2; ++u)
#pragma unroll
        for (int dt = 0; dt < 8; ++dt) gws[u][dt] = *(const u32x2*)(PROJ + (qrow0 + u * 16 + fr) * NCOL + C_BG + head * 128 + dt * 16 + 4 * fq);
    float mrun[2], lrun[2];
    const float sk = P.sink[layer * 8 + head] * LOG2E;
    mrun[0] = mrun[1] = sk; lrun[0] = lrun[1] = 1.f;
    f32x4 o[8][2];
#pragma unroll
    for (int dt = 0; dt < 8; ++dt) { o[dt][0] = (f32x4){0, 0, 0, 0}; o[dt][1] = (f32x4){0, 0, 0, 0}; }
    const int nprev = (!isctx && blk > 0) ? 4 : 0, nnext = (!isctx && blk < 63) ? 4 : 0;
    const int T = isctx ? 8 : 12 + nprev + nnext;
    const int lkey = tid >> 4, lkc = (tid & 15) ^ (((lkey >> 3) << 2) | (lkey & 3));
    const unsigned koff = (unsigned)(lkey * NCOL + lkc * 8) * 2u;
    const int ld = tid >> 2, lvc = (tid & 3) ^ ((ld >> 2) & 3);
    const unsigned voff_c = (unsigned)(ld * CTXL + lvc * 8) * 2u, voff_s = (unsigned)(ld * SEQ + lvc * 8) * 2u;
    const char* kctx = (const char*)(PROJ + ((size_t)MLAT + b * CTXL) * NCOL + C_K + kvh * 128);
    const char* klat = (const char*)(PROJ + ((size_t)b * SEQ) * NCOL + C_K + kvh * 128);
    const char* vctx = (const char*)(VTc + (size_t)(b * 2 + kvh) * 128 * CTXL);
    const char* vlat = (const char*)(VT + (size_t)(b * 2 + kvh) * 128 * SEQ);
#define ATT_ISSUE(tt) do { int _t = (tt) < T ? (tt) : T - 1; const char* _kp; const char* _vp; unsigned _vo; \
        if (_t < 8) { _kp = kctx + (size_t)(_t * 32) * NCOL * 2; _vp = vctx + _t * 64; _vo = voff_c; } \
        else { const int _r = _t - 8, _seg = _r < nprev ? 0 : (_r < nprev + 4 ? 1 : 2), _st = _seg == 0 ? _r : (_seg == 1 ? _r - nprev : _r - nprev - 4); \
               const int _kb = (blk - 1 + _seg) * 128 + _st * 32; _kp = klat + (size_t)_kb * NCOL * 2; _vp = vlat + _kb * 2; _vo = voff_s; } \
        LAS unsigned char* _dst = lds + ((tt) & 7) * 16384 + w * 1024; \
        __builtin_amdgcn_global_load_lds((const unsigned*)(_kp + koff), (LAS unsigned*)(_dst), 16, 0, 0); \
        __builtin_amdgcn_global_load_lds((const unsigned*)(_vp + _vo), (LAS unsigned*)(_dst + 8192), 16, 0, 0); } while (0)
    ATT_ISSUE(0); ATT_ISSUE(1); ATT_ISSUE(2); ATT_ISSUE(3); ATT_ISSUE(4); ATT_ISSUE(5);
    const int kfo = (8 * (fr >> 2) + (fr & 3)) * 256, vfo = fr * 64 + ((fq ^ ((fr >> 2) & 3)) * 16);
    int kofs[4];
#pragma unroll
    for (int c = 0; c < 4; ++c) kofs[c] = kfo + (((c * 4 + fq) ^ fr) * 16);
    const f32x4 zero4 = {0.f, 0.f, 0.f, 0.f};
    for (int tp = 0; tp < T; tp += 2) {
        asm volatile("s_waitcnt vmcnt(8) lgkmcnt(0)" ::: "memory");
        __builtin_amdgcn_s_barrier();
        asm volatile("" ::: "memory");
        ATT_ISSUE(tp + 6); ATT_ISSUE(tp + 7);
        int mtype = 0, st = 0;
        if (tp >= 8) { const int r = tp - 8; if (r < nprev) { mtype = 1; st = r; } else if (r >= nprev + 4) { mtype = 2; st = r - nprev - 4; } }
        const int k0 = st * 32;
        if (mtype == 1 && k0 + 63 < a0) continue;
        if (mtype == 2 && k0 > a0 + 31) continue;
        f32x4 s[2][2][2];
#pragma unroll
        for (int tl = 0; tl < 2; ++tl) {
            const LAS unsigned char* kb = lds + ((tp + tl) & 7) * 16384;
#pragma unroll
            for (int v = 0; v < 2; ++v)
#pragma unroll
                for (int c = 0; c < 4; ++c) {
                    const bf16x8 ka = *(const LAS bf16x8*)(kb + kofs[c] + v * 1024);
                    s[0][tl][v] = __builtin_amdgcn_mfma_f32_16x16x32_bf16(ka, qf[0][c], c == 0 ? zero4 : s[0][tl][v], 0, 0, 0);
                    s[1][tl][v] = __builtin_amdgcn_mfma_f32_16x16x32_bf16(ka, qf[1][c], c == 0 ? zero4 : s[1][tl][v], 0, 0, 0);
                }
        }
        bf16x8 pb[2][2];
#pragma unroll
        for (int u = 0; u < 2; ++u) {
            if (mtype == 1) {
                asm volatile("" ::: "memory");
                const int a = a0 + u * 16 + fr - k0 - 8 * fq;
#pragma unroll
                for (int tl = 0; tl < 2; ++tl)
#pragma unroll
                    for (int v = 0; v < 2; ++v)
#pragma unroll
                        for (int r = 0; r < 4; ++r) { if (32 * tl + 4 * v + r < a) s[u][tl][v][r] = -1e30f; }
            } else if (mtype == 2) {
                asm volatile("" ::: "memory");
                const int a = a0 + u * 16 + fr - k0 - 8 * fq;
#pragma unroll
                for (int tl = 0; tl < 2; ++tl)
#pragma unroll
                    for (int v = 0; v < 2; ++v)
#pragma unroll
                        for (int r = 0; r < 4; ++r) { if (32 * tl + 4 * v + r > a) s[u][tl][v][r] = -1e30f; }
            }
            float mx = -3e38f;
#pragma unroll
            for (int tl = 0; tl < 2; ++tl)
#pragma unroll
                for (int v = 0; v < 2; ++v) mx = fmaxf(mx, fmaxf(fmaxf(s[u][tl][v][0], s[u][tl][v][1]), fmaxf(s[u][tl][v][2], s[u][tl][v][3])));
            mx = xor16_max(mx); mx = xor32_max(mx);
            float mn = mrun[u], alpha = 1.f;
            const bool grow = __any(mx > mrun[u] + 8.f);
            if (grow) { mn = fmaxf(mrun[u], mx); alpha = __builtin_amdgcn_exp2f(mrun[u] - mn); }
            float p[16]; float ps = 0.f;
#pragma unroll
            for (int tl = 0; tl < 2; ++tl)
#pragma unroll
                for (int v = 0; v < 2; ++v)
#pragma unroll
                    for (int r = 0; r < 4; ++r) { const float e = __builtin_amdgcn_exp2f(s[u][tl][v][r] - mn); p[tl * 8 + v * 4 + r] = e; ps += e; }
            ps = xor16_sum(ps); ps = xor32_sum(ps);
            lrun[u] = lrun[u] * alpha + ps;
            if (grow) {
#pragma unroll
                for (int dt = 0; dt < 8; ++dt) o[dt][u] = o[dt][u] * alpha;
            }
            mrun[u] = mn;
#pragma unroll
            for (int tl = 0; tl < 2; ++tl) {
                u32x4 pk; pk.x = cvt_pk_bf16(p[tl * 8 + 0], p[tl * 8 + 1]); pk.y = cvt_pk_bf16(p[tl * 8 + 2], p[tl * 8 + 3]); pk.z = cvt_pk_bf16(p[tl * 8 + 4], p[tl * 8 + 5]); pk.w = cvt_pk_bf16(p[tl * 8 + 6], p[tl * 8 + 7]);
                pb[u][tl] = __builtin_bit_cast(bf16x8, pk);
            }
        }
#pragma unroll
        for (int tl = 0; tl < 2; ++tl) {
            const LAS unsigned char* vb = lds + ((tp + tl) & 7) * 16384 + 8192;
#pragma unroll
            for (int dt = 0; dt < 8; ++dt) {
                const bf16x8 va = *(const LAS bf16x8*)(vb + dt * 1024 + vfo);
                o[dt][0] = __builtin_amdgcn_mfma_f32_16x16x32_bf16(va, pb[0][tl], o[dt][0], 0, 0, 0);
                o[dt][1] = __builtin_amdgcn_mfma_f32_16x16x32_bf16(va, pb[1][tl], o[dt][1], 0, 0, 0);
            }
        }
    }
    asm volatile("s_waitcnt vmcnt(0) lgkmcnt(0)" ::: "memory");
    __builtin_amdgcn_s_barrier();
    asm volatile("" ::: "memory");
#undef ATT_ISSUE
#pragma unroll
    for (int u = 0; u < 2; ++u) {
        const float inv = 1.f / lrun[u];
        const size_t row = qrow0 + u * 16 + fr;
#pragma unroll
        for (int dt = 0; dt < 8; ++dt) {
            const int d0 = head * 128 + dt * 16 + 4 * fq;
            const u32x2 gw = gws[u][dt];
            const f32x4 ov = o[dt][u] * inv;
            *(u32x2*)(MIX + row * DM + 512 + d0) = pack4(ov[0] * bflo(gw.x), ov[1] * bfhi(gw.x), ov[2] * bflo(gw.y), ov[3] * bfhi(gw.y));
        }
    }
}

constexpr int GM_PART = 131072, GM_RQ = GM_PART + 32 * 128 * 4, GM_G = GM_RQ + 512, GM_B = GM_G + 2048, LDS_TOTAL = GM_B + 2048;
__device__ __forceinline__ void gmlp_task(const Params& P_unused, int layer, int chunk, LAS unsigned char* lds) {
    const Params P = load_params(); (void)P_unused;
    unsigned char* ws = ls(P.ws);
    const bf16_t* PROJ = (const bf16_t*)(ws + O_PROJ); const bf16_t* avT = (const bf16_t*)(ws + O_AVT) + (size_t)chunk * 512 * 128;
    bf16_t* MIX = (bf16_t*)(ws + O_HMIX);
    LAS float* part = (LAS float*)(lds + GM_PART);
    LAS float* rq = (LAS float*)(lds + GM_RQ);
    LAS float* gl = (LAS float*)(lds + GM_G);
    LAS float* bl = (LAS float*)(lds + GM_B);
    const int tid = lv(threadIdx.x), lane = tid & 63, w = __builtin_amdgcn_readfirstlane(tid >> 6), fr = lane & 15, fq = lane >> 4;
    __syncthreads();
    const int myc = (tid & 15) ^ ((tid >> 4) & 15);
    { const char* src = (const char*)avT + (size_t)(tid >> 4) * 256 + myc * 16;
#pragma unroll
      for (int i = 0; i < 16; ++i) __builtin_amdgcn_global_load_lds((const unsigned*)(src + (size_t)i * 32 * 256), (LAS unsigned*)(lds + i * 8192 + w * 1024), 16, 0, 0); }
    const int p = 16 * w + fr; const size_t row = (size_t)chunk * 128 + p;
    f32x4 wsn[8]; u32x2 uun[8], ggn[8];
#define GM_LOAD(h) do { const float* _wsr = P.w_sgu + (((size_t)layer * 4 + (h)) * 128 + p) * 128; \
        _Pragma("unroll") for (int c = 0; c < 4; ++c) { wsn[2 * c] = *(const f32x4*)(_wsr + c * 32 + 8 * fq); wsn[2 * c + 1] = *(const f32x4*)(_wsr + c * 32 + 8 * fq + 4); } \
        _Pragma("unroll") for (int dt = 0; dt < 8; ++dt) { const int _col = (h) * 128 + dt * 16 + 4 * fq; uun[dt] = *(const u32x2*)(PROJ + row * NCOL + C_AU + _col); ggn[dt] = *(const u32x2*)(PROJ + row * NCOL + C_AG + _col); } } while (0)
    GM_LOAD(0);
    if (tid < 128) *(LAS f32x4*)(gl + tid * 4) = *(const f32x4*)(P.g_sgu + (size_t)layer * 512 + tid * 4);
    else if (tid < 256) *(LAS f32x4*)(bl + (tid - 128) * 4) = *(const f32x4*)(P.b_sgu + (size_t)layer * 512 + (tid - 128) * 4);
    asm volatile("s_waitcnt vmcnt(0)" ::: "memory");
    __builtin_amdgcn_s_barrier();
    asm volatile("" ::: "memory");
    { float s8[8] = {0, 0, 0, 0, 0, 0, 0, 0};
#pragma unroll
      for (int i = 0; i < 16; ++i) { const u32x4 v = *(const LAS u32x4*)(lds + i * 8192 + tid * 16);
          float f; f = bflo(v.x); s8[0] += f * f; f = bfhi(v.x); s8[1] += f * f; f = bflo(v.y); s8[2] += f * f; f = bfhi(v.y); s8[3] += f * f;
          f = bflo(v.z); s8[4] += f * f; f = bfhi(v.z); s8[5] += f * f; f = bflo(v.w); s8[6] += f * f; f = bfhi(v.w); s8[7] += f * f; }
#pragma unroll
      for (int e = 0; e < 8; ++e) part[(tid >> 4) * 128 + myc * 8 + e] = s8[e]; }
    __syncthreads();
    if (tid < 128) { float s = 0.f; for (int i = 0; i < 32; ++i) s += part[i * 128 + tid]; rq[tid] = rsqrtf(s * (1.f / 512.f) + EPS); }
    __syncthreads();
    for (int h = 0; h < 4; ++h) {
        f32x4 wsc[8]; u32x2 uu[8], gg[8];
#pragma unroll
        for (int i = 0; i < 8; ++i) { wsc[i] = wsn[i]; uu[i] = uun[i]; gg[i] = ggn[i]; }
        if (h < 3) GM_LOAD(h + 1);
        bf16x8 bfr[4];
#pragma unroll
        for (int c = 0; c < 4; ++c) { const int q0 = c * 32 + 8 * fq; const f32x4 w0 = wsc[2 * c], w1 = wsc[2 * c + 1];
            u32x4 pk; pk.x = cvt_pk_bf16(w0[0] * rq[q0], w0[1] * rq[q0 + 1]); pk.y = cvt_pk_bf16(w0[2] * rq[q0 + 2], w0[3] * rq[q0 + 3]);
            pk.z = cvt_pk_bf16(w1[0] * rq[q0 + 4], w1[1] * rq[q0 + 5]); pk.w = cvt_pk_bf16(w1[2] * rq[q0 + 6], w1[3] * rq[q0 + 7]); bfr[c] = __builtin_bit_cast(bf16x8, pk); }
        f32x4 acc[8];
#pragma unroll
        for (int dt = 0; dt < 8; ++dt) { acc[dt] = (f32x4){0, 0, 0, 0};
#pragma unroll
            for (int c = 0; c < 4; ++c) { const bf16x8 a = *(const LAS bf16x8*)(lds + (h * 128 + dt * 16 + fr) * 256 + (((c * 4 + fq) ^ fr) * 16));
                acc[dt] = __builtin_amdgcn_mfma_f32_16x16x32_bf16(a, bfr[c], acc[dt], 0, 0, 0); } }
        const float bs = bl[h * 128 + p];
#pragma unroll
        for (int dt = 0; dt < 8; ++dt) { const int col = h * 128 + dt * 16 + 4 * fq;
            const f32x4 g4 = *(const LAS f32x4*)(gl + col);
            const u32x2 u2 = uu[dt], g2 = gg[dt];
            const float y0 = bflo(u2.x) * (acc[dt][0] * g4[0] + bs) * bflo(g2.x), y1 = bfhi(u2.x) * (acc[dt][1] * g4[1] + bs) * bfhi(g2.x);
            const float y2 = bflo(u2.y) * (acc[dt][2] * g4[2] + bs) * bflo(g2.y), y3 = bfhi(u2.y) * (acc[dt][3] * g4[3] + bs) * bfhi(g2.y);
            *(u32x2*)(MIX + row * DM + col) = pack4(y0, y1, y2, y3); }
    }
#undef GM_LOAD
    __syncthreads();
}

__device__ __forceinline__ void stage2_phase(const Params& P_unused, int layer, int G) {
    const Params P = load_params(); (void)P_unused;
    unsigned char* ws = ls(P.ws);
    const bf16_t* Bint = (const bf16_t*)(ws + O_BINT); const bf16_t* F64 = (const bf16_t*)(ws + O_F64); const bf16_t* PROJ = (const bf16_t*)(ws + O_PROJ);
    bf16_t* MIX = (bf16_t*)(ws + O_HMIX);
    const int tid = lv(threadIdx.x);
    const int lane = tid & 63, w = __builtin_amdgcn_readfirstlane(tid >> 6), fr = lane & 15, fq = lane >> 4;
    bf16x8 ff[4][4];
#pragma unroll
    for (int nt = 0; nt < 4; ++nt)
#pragma unroll
        for (int c = 0; c < 4; ++c) ff[nt][c] = *(const bf16x8*)(F64 + (size_t)(nt * 16 + fr) * 128 + c * 32 + fq * 8);
    for (int task = blockIdx.x; task < 256; task += G) {
        const int b = task >> 7, k1 = task & 127;
        bf16x8 af[4][4]; u32x2 gg[4][4]; f32x4 bias[4];
#pragma unroll
        for (int mi = 0; mi < 4; ++mi) {
            const int j0 = (w * 4 + mi) * 16, jc = j0 + 4 * fq;
#pragma unroll
            for (int c = 0; c < 4; ++c) af[mi][c] = *(const bf16x8*)(Bint + (((size_t)(b * 128 + k1) * 512 + j0 + fr) * 128) + c * 32 + fq * 8);
            bias[mi] = *(const f32x4*)(P.b_f + (size_t)layer * 512 + jc);
#pragma unroll
            for (int nt = 0; nt < 4; ++nt) gg[mi][nt] = *(const u32x2*)(PROJ + ((size_t)b * SEQ + k1 + 128 * (nt * 16 + fr)) * NCOL + C_CG + jc);
        }
#pragma unroll
        for (int mi = 0; mi < 4; ++mi) {
            const int jc = (w * 4 + mi) * 16 + 4 * fq;
#pragma unroll
            for (int nt = 0; nt < 4; ++nt) {
                f32x4 acc = {0, 0, 0, 0};
#pragma unroll
                for (int c = 0; c < 4; ++c) acc = __builtin_amdgcn_mfma_f32_16x16x32_bf16(af[mi][c], ff[nt][c], acc, 0, 0, 0);
                const int k2 = nt * 16 + fr; const size_t row = (size_t)b * SEQ + k1 + 128 * k2;
                const u32x2 g2 = gg[mi][nt];
                *(u32x2*)(MIX + row * DM + 1536 + jc) = pack4((acc[0] + bias[mi][0]) * bflo(g2.x), (acc[1] + bias[mi][1]) * bfhi(g2.x), (acc[2] + bias[mi][2]) * bflo(g2.y), (acc[3] + bias[mi][3]) * bfhi(g2.y));
            }
        }
    }
}

__device__ __forceinline__ void ctx_outproj_tile(const Params& P_unused, int layer, int tile, LAS unsigned char* lds) {
    const Params P = load_params(); (void)P_unused;
    unsigned char* ws = ls(P.ws);
    const bf16_t* A = (const bf16_t*)(ws + O_HMIX) + (size_t)MLAT * DM;
    const bf16_t* Bt = (const bf16_t*)(ws + O_WOUTT) + (size_t)layer * DM * DM;
    bf16_t* Yc = (bf16_t*)(ws + O_YC);
    const int tid = lv(threadIdx.x);
    const int lane = tid & 63, w = __builtin_amdgcn_readfirstlane(tid >> 6), fr = lane & 15, fq = lane >> 4;
    const int m0 = (tile >> 5) * 64, n0 = (tile & 31) * 64;
    f32x4 acc[4][4];
#pragma unroll
    for (int i = 0; i < 4; ++i)
#pragma unroll
        for (int j = 0; j < 4; ++j) acc[i][j] = (f32x4){0, 0, 0, 0};
    const bf16_t* ap = A + (size_t)(m0 + fr) * DM + w * 256 + fq * 8;
    const bf16_t* bp = Bt + (size_t)(n0 + fr) * DM + w * 256 + fq * 8;
#pragma unroll 4
    for (int ks = 0; ks < 8; ++ks) {
        bf16x8 af[4], bv[4];
#pragma unroll
        for (int i = 0; i < 4; ++i) { af[i] = *(const bf16x8*)(ap + (size_t)i * 16 * DM + ks * 32); bv[i] = *(const bf16x8*)(bp + (size_t)i * 16 * DM + ks * 32); }
#pragma unroll
        for (int i = 0; i < 4; ++i)
#pragma unroll
            for (int j = 0; j < 4; ++j) acc[i][j] = __builtin_amdgcn_mfma_f32_16x16x32_bf16(af[i], bv[j], acc[i][j], 0, 0, 0);
    }
    __syncthreads();
    LAS float* red = (LAS float*)lds + w * 4096;
#pragma unroll
    for (int i = 0; i < 4; ++i)
#pragma unroll
        for (int j = 0; j < 4; ++j)
#pragma unroll
            for (int r = 0; r < 4; ++r) red[(i * 16 + 4 * fq + r) * 64 + j * 16 + fr] = acc[i][j][r];
    __syncthreads();
    { const int e0 = tid * 8, row = e0 >> 6, col = e0 & 63;
      f32x4 s0 = {0, 0, 0, 0}, s1 = {0, 0, 0, 0};
#pragma unroll
      for (int wv = 0; wv < 8; ++wv) { const LAS f32x4* p = (const LAS f32x4*)((LAS float*)lds + wv * 4096 + e0); s0 += p[0]; s1 += p[1]; }
      u32x4 o; o.x = cvt_pk_bf16(s0[0], s0[1]); o.y = cvt_pk_bf16(s0[2], s0[3]); o.z = cvt_pk_bf16(s1[0], s1[1]); o.w = cvt_pk_bf16(s1[2], s1[3]);
      *(u32x4*)(Yc + (size_t)(m0 + row) * DM + n0 + col) = o; }
    __syncthreads();
}

#define XB_TMO      128
#define XB_XCNT(j)  (256  + 64 * (j))
#define XB_XSUB(j)  (1280 + 64 * (j))
#define XB_XGEN(j)  (2304 + 64 * (j))
#define XB_TOP      3328
#define XB_TOPGEN   3392
#define XCD_BAR_WORDS 3456
#define XB_SPIN_CAP (1u << 18)
__device__ __forceinline__ unsigned xb_ld(unsigned* p)              { return __hip_atomic_load(p, __ATOMIC_RELAXED, __HIP_MEMORY_SCOPE_AGENT); }
__device__ __forceinline__ unsigned xb_add(unsigned* p, unsigned v) { return __hip_atomic_fetch_add(p, v, __ATOMIC_RELAXED, __HIP_MEMORY_SCOPE_AGENT); }
__device__ __forceinline__ unsigned xb_xcc_id() { return (unsigned)__builtin_amdgcn_s_getreg((3 << 11) | 20) & 0xFu; }
#define XB_SPIN(cond, bar) do { unsigned _sp = 0; while (cond) { __builtin_amdgcn_s_sleep(1); \
    if ((++_sp & 255u) == 0u) { if (xb_ld(&(bar)[XB_TMO])) break; if (_sp > XB_SPIN_CAP) { atomicAdd(&(bar)[XB_TMO], 1u); break; } } } } while (0)
struct XcdBarrier { unsigned* bar; unsigned x; volatile LAS unsigned* st; };
__device__ __forceinline__ XcdBarrier xcd_barrier_post(unsigned* bar, volatile LAS unsigned* st) {
    XcdBarrier b; b.bar = bar; b.x = xb_xcc_id(); b.st = st;
    if (threadIdx.x == 0) (void)xb_add(&bar[XB_XCNT(b.x)], 1u);
    return b;
}
__device__ __forceinline__ void xcd_barrier_complete(unsigned* bar, unsigned x, unsigned& nloc, unsigned& nx) {
    const unsigned G = gridDim.x * gridDim.y * gridDim.z;
    unsigned sum, cnt, mine, sp = 0u;
    for (;;) {
        sum = 0u; cnt = 0u; mine = 0u;
#pragma unroll
        for (unsigned j = 0; j < 16; ++j) { const unsigned c = xb_ld(&bar[XB_XCNT(j)]); sum += c; cnt += (c > 0u) ? 1u : 0u; mine = (j == x) ? c : mine; }
        if (sum == G) break;
        __builtin_amdgcn_s_sleep(1);
        if ((++sp & 255u) == 0u) { if (xb_ld(&bar[XB_TMO])) break; if (sp > XB_SPIN_CAP) { atomicAdd(&bar[XB_TMO], 1u); break; } }
    }
    nloc = mine > 0u ? mine : 1u; nx = cnt > 0u ? cnt : 1u;
}
__device__ __forceinline__ void xcd_barrier(const XcdBarrier& b) {
    asm volatile("s_waitcnt vmcnt(0)" ::: "memory");
    __syncthreads();
    if (threadIdx.x == 0) {
        unsigned* bar = b.bar;
        __builtin_amdgcn_s_waitcnt(0);
        unsigned nloc = b.st[0], nx = b.st[1];
        if (nloc == 0u) { xcd_barrier_complete(bar, b.x, nloc, nx); b.st[0] = nloc; b.st[1] = nx; }
        const unsigned old = xb_add(&bar[XB_XSUB(b.x)], 1u);
        const unsigned gen = old / nloc;
        if (old + 1u == (gen + 1u) * nloc) {
            __builtin_amdgcn_fence(__ATOMIC_RELEASE, "agent");
            asm volatile("s_waitcnt vmcnt(0)" ::: "memory");
            const unsigned og = xb_add(&bar[XB_TOP], 1u);
            const unsigned tg = og / nx;
            if (og + 1u == (tg + 1u) * nx) xb_add(&bar[XB_TOPGEN], 1u);
            else XB_SPIN(xb_ld(&bar[XB_TOPGEN]) == tg, bar);
            __builtin_amdgcn_fence(__ATOMIC_ACQUIRE, "agent");
            xb_add(&bar[XB_XGEN(b.x)], 1u);
            asm volatile("s_waitcnt vmcnt(0)" ::: "memory");
        } else {
            XB_SPIN(xb_ld(&bar[XB_XGEN(b.x)]) == gen, bar);
            __builtin_amdgcn_fence(__ATOMIC_ACQUIRE, "agent");
            asm volatile("s_waitcnt vmcnt(0)" ::: "memory");
        }
    }
    __syncthreads();
}

__global__ void __launch_bounds__(512) fwd_megakernel(Params P_arg) {
    const Params& P = P_arg;
    extern __shared__ __attribute__((aligned(16))) unsigned char shm[];
    LAS unsigned char* lds = (LAS unsigned char*)shm;
    cg::grid_group grid = cg::this_grid();
    const int G = gridDim.x, bid = blockIdx.x;
    __shared__ uint4 xb_words;
    if (threadIdx.x == 0) xb_words = make_uint4(0u, 0u, 0u, 0u);
    __syncthreads();
    const XcdBarrier xb = xcd_barrier_post((unsigned*)(P.ws + O_BAR), (volatile LAS unsigned*)&xb_words);
#define WSP() const Params P = load_params(); unsigned char* ws = ls(P.ws); bf16_t* WinT = (bf16_t*)(ws + O_WINT); bf16_t* WoutT = (bf16_t*)(ws + O_WOUTT); bf16_t* HMIX = (bf16_t*)(ws + O_HMIX); bf16_t* PROJ = (bf16_t*)(ws + O_PROJ); (void)WinT; (void)WoutT; (void)HMIX; (void)PROJ

    phase0a(P, lds, G);
    grid.sync();
    {
        WSP();
        SchedFold S; S.G = G; S.c = bid;
        EpiFold E; E.WinT = WinT;
        Gemm g; g.A = (const bf16_t*)(ws + O_MTF); g.Bt = (const bf16_t*)(ws + O_WCX); g.K = 512;
        pg8::gemm_phase(lds, g, S, E);
        const float* modp = (const float*)(ws + O_MODP); float* mod = (float*)(ws + O_MOD);
        for (int e = bid * 512 + threadIdx.x; e < DEPTH * 3 * 1536; e += G * 512) {
            const int n4 = (e % 1536) * 4, lr = e / 1536, l = lr / 3, r = lr % 3;
            f32x4 a = *(const f32x4*)(P.b_mod + (size_t)l * 6144 + n4);
            for (int s = 0; s < 32; ++s) a += *(const f32x4*)(modp + ((size_t)(l * 32 + s) * 3 + r) * 6144 + n4);
            *(f32x4*)(mod + (size_t)lr * 6144 + n4) = a;
        }
    }
    xcd_barrier(xb);
#pragma unroll 1
    for (int layer = 0; layer < DEPTH; ++layer) {
        const bool lastl = layer == DEPTH - 1;
        row_phase(P, layer, G);
        xcd_barrier(xb);
        {
            WSP();
            SchedIn S; S.init(66, 22, G, bid);
            EpiIn E; E.PROJ = PROJ; E.avT = (bf16_t*)(ws + O_AVT); E.VT = (bf16_t*)(ws + O_VT); E.VTc = (bf16_t*)(ws + O_VTC); E.ZT = (bf16_t*)(ws + O_ZT); E.ZTc = (bf16_t*)(ws + O_ZTC); E.rope = (const float2*)(ws + O_ROPE);
            Gemm g; g.A = HMIX; g.Bt = WinT + (size_t)layer * NCOL * DM; g.K = DM;
            pg8::gemm_phase(lds, g, S, E);
        }
        xcd_barrier(xb);
        {
            WSP();
            for (int task = bid; task < 512; task += G) attn_task(P, layer, task, lds);
            {   SchedFew S; S.n = 256; S.G = G; S.c = bid;
                EpiS1 E; E.Bint = (bf16_t*)(ws + O_BINT);
                Gemm g; g.A = (const bf16_t*)(ws + O_F128); g.Bt = (const bf16_t*)(ws + O_ZT); g.K = 256;
                pg8::gemm_phase(lds, g, S, E); }
            const int nch = lastl ? 128 : 132;
            for (int ch = bid; ch < nch; ch += G) gmlp_task(P, layer, ch, lds);
            if (!lastl) {
                const int c2 = (bid - 132 + G) % G;
                for (int t = c2; t < 16; t += G) attn_task(P, layer, 512 + t, lds);
                __syncthreads();
                SchedFew S; S.n = 4; S.G = G; S.c = (bid - 148 + G) % G;
                EpiCtxF E; E.MIX = HMIX; E.PROJ = PROJ; E.bf = P.b_f + (size_t)layer * 512;
                Gemm g; g.A = (const bf16_t*)(ws + O_DCTX); g.Bt = (const bf16_t*)(ws + O_ZTC); g.K = 512;
                pg8::gemm_phase(lds, g, S, E);
            }
        }
        xcd_barrier(xb);
        stage2_phase(P, layer, G);
        if (!lastl) for (int tile = bid; tile < 256; tile += G) ctx_outproj_tile(P, layer, tile, lds);
        xcd_barrier(xb);
        {
            WSP();
            pg8::StaticOrder S; S.init(64, 8, G, bid);
            EpiOut E; E.Y = PROJ;
            Gemm g; g.A = HMIX; g.Bt = WoutT + (size_t)layer * DM * DM; g.K = DM;
            pg8::gemm_phase(lds, g, S, E);
        }
        xcd_barrier(xb);
    }
    row_phase(P, DEPTH, G);
}

extern "C" void kernel_launch(void* const* d_in, const int* in_sizes, int n_in, void* d_out, int out_size, void* d_ws, size_t ws_size, hipStream_t stream) {
    constexpr size_t kDynLds = LDS_TOTAL;
    static int grid_blocks = 0;
    if (!grid_blocks) {
        if (ws_size < WS_END) { fprintf(stderr, "kernel_launch: workspace too small: %zu < %zu\n", ws_size, (size_t)WS_END); grid_blocks = -1; return; }
        int dev = 0, cus = 0, per_cu = 0;
        hipGetDevice(&dev);
        hipDeviceGetAttribute(&cus, hipDeviceAttributeMultiprocessorCount, dev);
        hipFuncSetAttribute((const void*)fwd_megakernel, hipFuncAttributeMaxDynamicSharedMemorySize, (int)kDynLds);
        hipOccupancyMaxActiveBlocksPerMultiprocessor(&per_cu, (const void*)fwd_megakernel, 512, kDynLds);
        if (per_cu < 1) { fprintf(stderr, "kernel_launch: occupancy query says %d blocks/CU\n", per_cu); per_cu = 1; }
        grid_blocks = cus * 1;
    }
    if (grid_blocks < 0) return;
    Params p{};
    p.x = (const float*)d_in[0]; p.c = (const float*)d_in[1]; p.ctx = (const float*)d_in[2]; p.c_ctx = (const float*)d_in[3];
    p.w_mod = (const float*)d_in[4]; p.b_mod = (const float*)d_in[5]; p.g_pre = (const float*)d_in[6]; p.g_post = (const float*)d_in[7];
    p.w_in = (const float*)d_in[8]; p.w_out = (const float*)d_in[9]; p.g_sgu = (const float*)d_in[10]; p.w_sgu = (const float*)d_in[11];
    p.b_sgu = (const float*)d_in[12]; p.sink = (const float*)d_in[13]; p.w_f = (const float*)d_in[14]; p.b_f = (const float*)d_in[15];
    p.out = (float*)d_out; p.ws = (unsigned char*)d_ws;
    (void)hipMemsetAsync((unsigned char*)d_ws + O_BAR, 0, XCD_BAR_WORDS * 4, stream);
    void* args[] = {&p};
    hipError_t e = hipLaunchCooperativeKernel((const void*)fwd_megakernel, dim3(grid_blocks), dim3(512), args, kDynLds, stream);
    if (e != hipSuccess) fprintf(stderr, "cooperative launch failed: %s (grid %d)\n", hipGetErrorString(e), grid_blocks);
}
```

```cpp
#include <hip/hip_runtime.h>
#include <hip/hip_cooperative_groups.h>
#include <cstdio>
#include <cstdint>
namespace cg = cooperative_groups;

#define LAS __attribute__((address_space(3)))
typedef unsigned short bf16_t;
typedef short bf16x8 __attribute__((ext_vector_type(8)));
typedef short bf16x4 __attribute__((ext_vector_type(4)));
typedef float f32x4 __attribute__((ext_vector_type(4)));
typedef unsigned u32x2 __attribute__((ext_vector_type(2)));
typedef unsigned u32x4 __attribute__((ext_vector_type(4)));

constexpr int DM = 2048, SEQ = 8192, NB = 2, DEPTH = 4, CTXL = 256;
constexpr int MLAT = NB * SEQ;
constexpr int MROWS = MLAT + NB * CTXL;
constexpr int NCOL = 5632;
constexpr int C_AU = 0, C_AV = 512, C_AG = 1024, C_Q = 1536, C_K = 2560, C_V = 2816, C_BG = 3072, C_ZR = 4096, C_CG = 5120;
constexpr float EPS = 1e-6f;
constexpr float QSCALE = 0.08838834764831845f * 1.4426950408889634f;
constexpr float LOG2E = 1.4426950408889634f;

constexpr size_t AL(size_t x) { return (x + 255) & ~(size_t)255; }
constexpr size_t O_WINT = 0;
constexpr size_t O_WOUTT = O_WINT + AL((size_t)DEPTH * NCOL * DM * 2);
constexpr size_t O_MOD = O_WOUTT + AL((size_t)DEPTH * DM * DM * 2);
constexpr size_t O_ROPE = O_MOD + AL((size_t)DEPTH * 3 * 6144 * 4);
constexpr size_t O_TWID = O_ROPE + AL((size_t)128 * 32 * 8);
constexpr size_t O_F128 = O_TWID + AL((size_t)8192 * 8);
constexpr size_t O_F64 = O_F128 + AL((size_t)256 * 256 * 2);
constexpr size_t O_DCTX = O_F64 + AL((size_t)64 * 128 * 2);
constexpr size_t O_XC = O_DCTX + AL((size_t)256 * 512 * 2);
constexpr size_t O_HMIX = O_XC + AL((size_t)512 * DM * 4);
constexpr size_t O_PROJ = O_HMIX + AL((size_t)MROWS * DM * 2);
constexpr size_t O_AVT = O_PROJ + AL((size_t)MROWS * NCOL * 2);
constexpr size_t O_VT = O_AVT + AL((size_t)132 * 512 * 128 * 2);
constexpr size_t O_VTC = O_VT + AL((size_t)NB * 2 * 128 * SEQ * 2);
constexpr size_t O_ZT = O_VTC + AL((size_t)NB * 2 * 128 * CTXL * 2);
constexpr size_t O_ZTC = O_ZT + AL((size_t)NB * 512 * 64 * 256 * 2);
constexpr size_t O_BINT = O_ZTC + AL((size_t)NB * 512 * 512 * 2);
constexpr size_t O_YC = O_BINT + AL((size_t)NB * 128 * 512 * 128 * 2);
constexpr size_t O_BAR = O_YC + AL((size_t)512 * DM * 2);
constexpr size_t O_WCX = O_BAR + 16384;
constexpr size_t O_MTF = O_WCX + AL((size_t)DEPTH * DM * 512 * 2);
constexpr size_t O_MODP = O_MTF + AL((size_t)DEPTH * 1024 * 512 * 2);
constexpr size_t O_P0END = O_MODP + AL((size_t)DEPTH * 32 * 3 * 6144 * 4);
constexpr size_t O_XB = O_WCX;
constexpr size_t WS_END = (O_XB + (size_t)MLAT * DM * 2 > O_P0END) ? O_XB + (size_t)MLAT * DM * 2 : O_P0END;

struct Params {
    const float *x, *c, *ctx, *c_ctx, *w_mod, *b_mod, *g_pre, *g_post, *w_in, *w_out, *g_sgu, *w_sgu, *b_sgu, *sink, *w_f, *b_f;
    float* out;
    unsigned char* ws;
};

__device__ __forceinline__ Params load_params() {
#if defined(__HIP_DEVICE_COMPILE__)
    auto p = __builtin_amdgcn_kernarg_segment_ptr(); asm volatile("" : "+s"(p));
    return *(const __attribute__((address_space(4))) Params*)p;
#else
    return Params{};
#endif
}
__device__ __forceinline__ int lv(int x) { asm volatile("" : "+v"(x)); return x; }
template <class T> __device__ __forceinline__ T* ls(T* p) { asm volatile("" : "+s"(p)); return p; }
__device__ __forceinline__ unsigned cvt_pk_bf16(float lo, float hi) { unsigned r; asm volatile("v_cvt_pk_bf16_f32 %0, %1, %2" : "=v"(r) : "v"(lo), "v"(hi)); return r; }
__device__ __forceinline__ bf16_t f2bf(float v) { return (bf16_t)(cvt_pk_bf16(v, 0.f) & 0xffffu); }
__device__ __forceinline__ float bf2f(unsigned b) { return __uint_as_float(b << 16); }
__device__ __forceinline__ float bflo(unsigned w) { return __uint_as_float(w << 16); }
__device__ __forceinline__ float bfhi(unsigned w) { return __uint_as_float(w & 0xffff0000u); }
__device__ __forceinline__ float gelu_t(float x) { const float u2 = x * (x * x * (-2.f * 0.7978845608028654f * 0.044715f * 1.4426950408889634f) + (-2.f * 0.7978845608028654f * 1.4426950408889634f)); return x * __builtin_amdgcn_rcpf(1.f + __builtin_amdgcn_exp2f(u2)); }
__device__ __forceinline__ float silu_f(float x) { return x * __builtin_amdgcn_rcpf(1.f + __builtin_amdgcn_exp2f(x * -1.4426950408889634f)); }
__device__ __forceinline__ float wave_sum(float v) {
#pragma unroll
    for (int o = 1; o < 64; o <<= 1) v += __shfl_xor(v, o);
    return v;
}
__device__ __forceinline__ float xor16_max(float x) { auto r = __builtin_amdgcn_permlane16_swap(__float_as_uint(x), __float_as_uint(x), false, false); return fmaxf(__uint_as_float(r[0]), __uint_as_float(r[1])); }
__device__ __forceinline__ float xor32_max(float x) { auto r = __builtin_amdgcn_permlane32_swap(__float_as_uint(x), __float_as_uint(x), false, false); return fmaxf(__uint_as_float(r[0]), __uint_as_float(r[1])); }
__device__ __forceinline__ float xor16_sum(float x) { auto r = __builtin_amdgcn_permlane16_swap(__float_as_uint(x), __float_as_uint(x), false, false); return __uint_as_float(r[0]) + __uint_as_float(r[1]); }
__device__ __forceinline__ float xor32_sum(float x) { auto r = __builtin_amdgcn_permlane32_swap(__float_as_uint(x), __float_as_uint(x), false, false); return __uint_as_float(r[0]) + __uint_as_float(r[1]); }
__device__ __forceinline__ u32x2 pack4(float a, float b, float c, float d) { u32x2 r; r.x = cvt_pk_bf16(a, b); r.y = cvt_pk_bf16(c, d); return r; }

namespace pg8 {
constexpr int BM = 256, BK = 64, HALF = 128, HTB = HALF * BK * 2, STAGE_BYTES = 8 * HTB, NXCD = 8, WGM = 8;
__host__ __device__ __forceinline__ int lds_byte(int r, int c) { const int st = (r >> 4) * 2 + (c >> 5), rr = r & 15, cc = c & 31, ob = rr * 64 + cc * 2; return st * 1024 + (ob ^ (((ob >> 9) & 1) << 5)); }
__host__ __device__ __forceinline__ void stage_rc(int b, int& R, int& C) { const int st = b / 1024, sb = b % 1024, swz = sb ^ (((sb >> 9) & 1) << 5); R = (st >> 1) * 16 + swz / 64; C = (st & 1) * 32 + (swz % 64) / 2; }
__host__ __device__ __forceinline__ int perm32(int rho) { const int n = rho >> 4, i = rho & 15; return 8 * (i >> 2) + 4 * n + (i & 3); }
struct Unit { int pm, pn; };
struct Gemm { const bf16_t* A; const bf16_t* Bt; int K; };

struct SchedBase {
    __device__ __forceinline__ void amap(const Unit& u, const Gemm& g, const char*& base, unsigned& rs, unsigned& hs) const {
        rs = (unsigned)g.K * 2u; hs = (unsigned)HALF * g.K * 2u; base = (const char*)g.A + (size_t)u.pm * BM * g.K * 2;
    }
    __device__ __forceinline__ void bmap(const Unit& u, const Gemm& g, const char*& base, unsigned& rs, unsigned& hs) const {
        rs = (unsigned)g.K * 2u; hs = (unsigned)HALF * g.K * 2u; base = (const char*)g.Bt + (size_t)u.pn * BM * g.K * 2;
    }
};
struct StaticOrder : SchedBase {
    int nM, nN, nwg, G, c;
    __device__ void init(int nM_, int nN_, int G_, int c_) { nM = nM_; nN = nN_; nwg = nM * nN; G = G_; c = c_; }
    __device__ bool next(int i, Unit& u) const {
        const long L = (long)i * G + c; if (L >= nwg) return false;
        int wgid = (int)L; { const int q = nwg / NXCD, r = nwg % NXCD, xcd = wgid % NXCD, off = wgid / NXCD; wgid = (xcd < r ? xcd * (q + 1) : r * (q + 1) + (xcd - r) * q) + off; }
        const int nig = WGM * nN, gid = wgid / nig, fm = gid * WGM, gsz = (nM - fm) < WGM ? (nM - fm) : WGM;
        u.pm = fm + ((wgid % nig) % gsz); u.pn = (wgid % nig) / gsz; return true;
    }
};

template <class Epi, class Sched>
__device__ __forceinline__ void gemm_phase(LAS unsigned char* lds, const Gemm g, const Sched& S, const Epi& E) {
    const int tid = lv(threadIdx.x), wid = __builtin_amdgcn_readfirstlane(tid >> 6), lane = tid & 63, wr = wid >> 2, wc = wid & 3, fr = lane & 15, fq = lane >> 4;
    int K = g.K; asm volatile("" : "+s"(K));
    const int nt = K / BK;
#define PG8_VOFFB(dst, rs) do { const int _t = lv(tid); _Pragma("unroll") for (int _i = 0; _i < 2; ++_i) { int _R, _C; stage_rc(_t * 16 + _i * 8192, _R, _C); const int _Rb = (_R & ~31) + perm32(_R & 31); dst[_i] = (unsigned)_Rb * (rs) + (unsigned)_C * 2u; } } while (0)
#define PG8_VOFFA(dst, rs) do { const int _t = lv(tid); _Pragma("unroll") for (int _i = 0; _i < 2; ++_i) { int _R, _C; stage_rc(_t * 16 + _i * 8192, _R, _C); dst[_i] = (unsigned)_R * (rs) + (unsigned)_C * 2u; } } while (0)
    const size_t kstep = (size_t)(BK * 2);
    const unsigned ldsw = (unsigned)wid * 1024u;
    const int aoff = lds_byte(wr * 64 + fr, fq * 8), boff = lds_byte(wc * 32 + fr, fq * 8);
#define PG8_SA(b, h) (((b) * 2 + (h)) * HTB)
#define PG8_SB(b, h) ((4 + (b) * 2 + (h)) * HTB)
#define PG8_STAGE(bufoff, gbase, voff) do { _Pragma("unroll") for (int _i = 0; _i < 2; ++_i) \
        __builtin_amdgcn_global_load_lds((const unsigned*)((const char*)(gbase) + (voff)[_i]), (LAS unsigned*)(lds + (bufoff) + ldsw + _i * 8192), 16, 0, 0); } while (0)
#define PG8_LDA(dst, b, h) do { _Pragma("unroll") for (int m = 0; m < 4; ++m) _Pragma("unroll") for (int k = 0; k < 2; ++k) dst[m][k] = *(const LAS bf16x8*)(lds + PG8_SA(b, h) + aoff + m * 2048 + k * 1024); } while (0)
#define PG8_LDB(dst, b, h) do { _Pragma("unroll") for (int n = 0; n < 2; ++n) _Pragma("unroll") for (int k = 0; k < 2; ++k) dst[n][k] = *(const LAS bf16x8*)(lds + PG8_SB(b, h) + boff + n * 2048 + k * 1024); } while (0)
#define PG8_MMA(ai, bj, At, Bt) do { __builtin_amdgcn_s_setprio(1); _Pragma("unroll") for (int m = 0; m < 4; ++m) _Pragma("unroll") for (int n = 0; n < 2; ++n) _Pragma("unroll") for (int k = 0; k < 2; ++k) \
        acc[ai][bj][m][n] = __builtin_amdgcn_mfma_f32_16x16x32_bf16(Bt[n][k], At[m][k], acc[ai][bj][m][n], 0, 0, 0); __builtin_amdgcn_s_setprio(0); } while (0)
#define PG8_WAIT_V(n) asm volatile("s_waitcnt vmcnt(" #n ")" ::: "memory")
#define PG8_WAIT_L(n) asm volatile("s_waitcnt lgkmcnt(" #n ")" ::: "memory")
#define PG8_BAR __builtin_amdgcn_s_barrier()
#define PG8_SCHED __builtin_amdgcn_sched_barrier(0)
    Unit cur, nxt; int ui = 0;
    if (!S.next(0, cur)) return;
    f32x4 acc[2][2][4][2];
#pragma unroll
    for (int a = 0; a < 2; ++a)
#pragma unroll
        for (int b = 0; b < 2; ++b)
#pragma unroll
            for (int m = 0; m < 4; ++m)
#pragma unroll
                for (int n = 0; n < 2; ++n) acc[a][b][m][n] = (f32x4){0.f, 0.f, 0.f, 0.f};
    bf16x8 At[4][2], B0[2][2], B1[2][2];
    const char* cA; unsigned cRS, cHS; S.amap(cur, g, cA, cRS, cHS);
    unsigned vAc[2]; PG8_VOFFA(vAc, cRS);
    const char* cB; unsigned cRSB, cHSB; S.bmap(cur, g, cB, cRSB, cHSB);
    unsigned vBc[2]; PG8_VOFFB(vBc, cRSB);
    PG8_STAGE(PG8_SB(0, 0), cB, vBc); PG8_STAGE(PG8_SB(0, 1), cB + cHSB, vBc); PG8_STAGE(PG8_SA(0, 0), cA, vAc); PG8_STAGE(PG8_SA(0, 1), cA + cHS, vAc);
    if (wr == 1) PG8_BAR;
    PG8_WAIT_V(2); PG8_BAR;
    PG8_STAGE(PG8_SB(1, 0), cB + kstep, vBc); PG8_STAGE(PG8_SA(1, 0), cA + kstep, vAc); PG8_STAGE(PG8_SB(1, 1), cB + cHSB + kstep, vBc);
    PG8_WAIT_V(6); PG8_BAR;
    for (;;) {
        const bool has_next = S.next(ui + 1, nxt);
        const char* nA = cA; unsigned nRS = cRS, nHS = cHS; const char* nB = cB; unsigned nRSB = cRSB, nHSB = cHSB;
        if (has_next) { S.amap(nxt, g, nA, nRS, nHS); S.bmap(nxt, g, nB, nRSB, nHSB); }
        for (int t = 0; t < nt; t += 2) {
            const bool last = (t == nt - 2);
            const char* a1 = cA + (size_t)(t + 1) * kstep;
            const char* a2 = last ? nA : cA + (size_t)(t + 2) * kstep; const char* b2 = last ? nB : cB + (size_t)(t + 2) * kstep;
            const char* a3 = a2 + kstep; const char* b3 = b2 + kstep;
            const unsigned hs2 = last ? nHS : cHS;
            unsigned v2[2] = {vAc[0], vAc[1]}; if (last) PG8_VOFFA(v2, nRS);
            const unsigned hsB2 = last ? nHSB : cHSB;
            unsigned vB2[2] = {vBc[0], vBc[1]}; if (last) PG8_VOFFB(vB2, nRSB);
            PG8_LDB(B0, 0, 0); PG8_LDB(B1, 0, 1); PG8_SCHED; PG8_LDA(At, 0, 0); PG8_STAGE(PG8_SA(1, 1), a1 + cHS, vAc);
            PG8_WAIT_V(8); PG8_WAIT_L(0); PG8_BAR; PG8_MMA(0, 0, At, B0); PG8_MMA(0, 1, At, B1); PG8_BAR; PG8_SCHED;
            PG8_LDA(At, 0, 1); PG8_STAGE(PG8_SB(0, 0), b2, vB2); PG8_STAGE(PG8_SB(0, 1), b2 + hsB2, vB2); PG8_STAGE(PG8_SA(0, 0), a2, v2);
            PG8_WAIT_V(8); PG8_WAIT_L(0); PG8_BAR; PG8_MMA(1, 0, At, B0); PG8_MMA(1, 1, At, B1); PG8_BAR; PG8_SCHED;
            PG8_LDB(B0, 1, 0); PG8_LDB(B1, 1, 1); PG8_SCHED; PG8_LDA(At, 1, 0); PG8_STAGE(PG8_SA(0, 1), a2 + hs2, v2);
            PG8_WAIT_V(8); PG8_WAIT_L(0); PG8_BAR; PG8_MMA(0, 0, At, B0); PG8_MMA(0, 1, At, B1); PG8_BAR; PG8_SCHED;
            PG8_LDA(At, 1, 1); PG8_STAGE(PG8_SB(1, 0), b3, vB2); PG8_STAGE(PG8_SB(1, 1), b3 + hsB2, vB2); PG8_STAGE(PG8_SA(1, 0), a3, v2);
            PG8_WAIT_V(8); PG8_WAIT_L(0); PG8_BAR; PG8_MMA(1, 0, At, B0); PG8_MMA(1, 1, At, B1); PG8_BAR; PG8_SCHED;
        }
        if (wr == 0) PG8_BAR;
        { const int l2 = lv(threadIdx.x) & 63; E(acc, cur, wr, wc, l2 & 15, l2 >> 4); }
        if (!has_next) break;
#pragma unroll
        for (int a = 0; a < 2; ++a)
#pragma unroll
            for (int b = 0; b < 2; ++b)
#pragma unroll
                for (int m = 0; m < 4; ++m)
#pragma unroll
                    for (int n = 0; n < 2; ++n) acc[a][b][m][n] = (f32x4){0.f, 0.f, 0.f, 0.f};
        cur = nxt; cA = nA; cRS = nRS; cHS = nHS; PG8_VOFFA(vAc, cRS); cB = nB; cRSB = nRSB; cHSB = nHSB; PG8_VOFFB(vBc, cRSB); ++ui;
        if (wr == 1) PG8_BAR;
    }
    PG8_WAIT_V(0);
    PG8_BAR;
#undef PG8_VOFFA
#undef PG8_VOFFB
#undef PG8_SA
#undef PG8_SB
#undef PG8_STAGE
#undef PG8_LDA
#undef PG8_LDB
#undef PG8_MMA
#undef PG8_WAIT_V
#undef PG8_WAIT_L
#undef PG8_BAR
#undef PG8_SCHED
}
}
using pg8::Unit;
using pg8::Gemm;

__device__ __forceinline__ bool in_swapped(int pn) { return pn == 2 || pn == 3 || pn == 11 || (pn >= 16 && pn < 20); }
struct SchedIn : pg8::StaticOrder {
    __device__ __forceinline__ void tokmap(const Unit& u, bool gather, const Gemm& g, const char*& base, unsigned& rs, unsigned& hs) const {
        if (gather && u.pm < 64) { const int b = u.pm >> 5, t20 = 2 * (u.pm & 31); rs = 64u * DM * 2u; hs = DM * 2u; base = (const char*)g.A + ((size_t)b * SEQ + t20) * DM * 2; }
        else { rs = DM * 2u; hs = 128u * DM * 2u; base = (const char*)g.A + (size_t)u.pm * 256 * DM * 2; }
    }
    __device__ __forceinline__ void wmap(const Unit& u, const Gemm& g, const char*& base, unsigned& rs, unsigned& hs) const {
        rs = DM * 2u; hs = 128u * DM * 2u; base = (const char*)g.Bt + (size_t)u.pn * 256 * DM * 2;
    }
    __device__ __forceinline__ void amap(const Unit& u, const Gemm& g, const char*& base, unsigned& rs, unsigned& hs) const {
        if (in_swapped(u.pn)) wmap(u, g, base, rs, hs); else tokmap(u, false, g, base, rs, hs);
    }
    __device__ __forceinline__ void bmap(const Unit& u, const Gemm& g, const char*& base, unsigned& rs, unsigned& hs) const {
        if (in_swapped(u.pn)) tokmap(u, u.pn >= 16, g, base, rs, hs); else wmap(u, g, base, rs, hs);
    }
};
struct SchedFold : pg8::SchedBase {
    int G, c;
    __device__ bool next(int i, Unit& u) const { const int L = i * G + c; if (L >= 128) return false; const int l = L >> 5, r = L & 31; u.pm = l * 4 + (r >> 3); u.pn = l * 8 + (r & 7); return true; }
};
struct SchedFew : pg8::SchedBase {
    int n, G, c;
    __device__ bool next(int i, Unit& u) const { const int L = i * G + c; if (c < 0 || L >= n) return false; u.pm = 0; u.pn = L; return true; }
};

struct EpiIn {
    bf16_t *PROJ, *avT, *VT, *VTc, *ZT, *ZTc; const float2* rope;
    __device__ __forceinline__ void operator()(const f32x4 (&acc)[2][2][4][2], const Unit& u, int wr, int wc, int fr, int fq) const {
        if (in_swapped(u.pn)) {
#pragma unroll
            for (int ai = 0; ai < 2; ++ai) {
                const int nt = 2 * u.pn + ai;
#pragma unroll
                for (int m = 0; m < 4; ++m) {
                    const int ch = wr * 64 + m * 16 + lv(fr);
#pragma unroll
                    for (int bj = 0; bj < 2; ++bj) {
                        const f32x4 v0 = acc[ai][bj][m][0], v1 = acc[ai][bj][m][1];
                        const int tk = 32 * wc + 8 * fq;
                        bf16_t* dst;
                        u32x4 pk;
                        if (nt < 8) {
                            const int chunk = u.pm * 2 + bj;
                            dst = avT + ((size_t)chunk * 512 + (nt - 4) * 128 + ch) * 128 + tk;
                            pk.x = cvt_pk_bf16(gelu_t(v0[0]), gelu_t(v0[1])); pk.y = cvt_pk_bf16(gelu_t(v0[2]), gelu_t(v0[3])); pk.z = cvt_pk_bf16(gelu_t(v1[0]), gelu_t(v1[1])); pk.w = cvt_pk_bf16(gelu_t(v1[2]), gelu_t(v1[3]));
                        } else {
                            pk.x = cvt_pk_bf16(v0[0], v0[1]); pk.y = cvt_pk_bf16(v0[2], v0[3]); pk.z = cvt_pk_bf16(v1[0], v1[1]); pk.w = cvt_pk_bf16(v1[2], v1[3]);
                            if (nt < 24) {
                                const int kvh = nt - 22, row = u.pm * 256 + bj * 128 + tk;
                                if (row < MLAT) dst = VT + ((size_t)((row >> 13) * 2 + kvh) * 128 + ch) * SEQ + (row & 8191);
                                else { const int rc = row - MLAT; dst = VTc + ((size_t)((rc >> 8) * 2 + kvh) * 128 + ch) * CTXL + (rc & 255); }
                            } else {
                                const int ri = (nt - 32) >> 2, j = ((nt - 32) & 3) * 128 + ch;
                                if (u.pm < 64) { const int b = u.pm >> 5, t2 = 2 * (u.pm & 31) + bj; dst = ZT + (((size_t)(b * 512 + j) * 64 + t2) * 256) + ri * 128 + tk; }
                                else { const int rc = (u.pm - 64) * 256 + bj * 128 + tk; dst = ZTc + ((size_t)((rc >> 8) * 512 + j) * 512) + ri * 256 + (rc & 255); }
                            }
                        }
                        *(u32x4*)dst = pk;
                    }
                    asm volatile("" ::: "memory");
                }
            }
            return;
        }
#pragma unroll
        for (int bj = 0; bj < 2; ++bj) {
            const int nt = 2 * u.pn + bj;
            const int colt = nt * 128 + 32 * wc + 8 * fq;
            if (nt < 4 || (nt >= 8 && nt < 12) || (nt >= 24 && nt < 32) || nt >= 40) {
                const bool is_gelu = nt < 4;
#pragma unroll
                for (int ai = 0; ai < 2; ++ai)
#pragma unroll
                    for (int m = 0; m < 4; ++m) {
                        const size_t row = (size_t)u.pm * 256 + ai * 128 + wr * 64 + m * 16 + lv(fr);
                        const f32x4 v0 = acc[ai][bj][m][0], v1 = acc[ai][bj][m][1]; float o[8];
#pragma unroll
                        for (int i = 0; i < 4; ++i) { o[i] = is_gelu ? gelu_t(v0[i]) : silu_f(v0[i]); o[4 + i] = is_gelu ? gelu_t(v1[i]) : silu_f(v1[i]); }
                        u32x4 pk; pk.x = cvt_pk_bf16(o[0], o[1]); pk.y = cvt_pk_bf16(o[2], o[3]); pk.z = cvt_pk_bf16(o[4], o[5]); pk.w = cvt_pk_bf16(o[6], o[7]);
                        *(u32x4*)(PROJ + row * NCOL + colt) = pk;
                        asm volatile("" ::: "memory");
                    }
            } else if (nt < 8) {
#pragma unroll
                for (int ai = 0; ai < 2; ++ai)
#pragma unroll
                    for (int m = 0; m < 4; ++m) {
                        const int row = u.pm * 256 + ai * 128 + wr * 64 + m * 16 + lv(fr);
                        const int chunk = row >> 7, q = row & 127;
#pragma unroll
                        for (int n = 0; n < 2; ++n) {
                            f32x4 v = acc[ai][bj][m][n];
                            const int c0 = (nt - 4) * 128 + 32 * wc + 8 * fq + 4 * n;
#pragma unroll
                            for (int i = 0; i < 4; ++i) avT[((size_t)chunk * 512 + c0 + i) * 128 + q] = f2bf(gelu_t(v[i]));
                            asm volatile("" ::: "memory");
                        }
                    }
            } else if (nt < 22) {
                const bool isq = nt < 20; const float sc = isq ? QSCALE : 1.f;
                const bool lat = u.pm < 64;
                float frev[4];
#pragma unroll
                for (int i = 0; i < 4; ++i) frev[i] = __builtin_amdgcn_exp2f(-(float)((wc & 1) * 16 + fq * 4 + i) * (13.287712379549449f / 32.f)) * 0.15915494309189535f;
#pragma unroll
                for (int ai = 0; ai < 2; ++ai)
#pragma unroll
                    for (int m = 0; m < 4; ++m) {
                        const size_t row = (size_t)u.pm * 256 + ai * 128 + wr * 64 + m * 16 + lv(fr);
                        const int tpos = (int)(row & 8191);
                        const int pos = (wc < 2) ? (tpos >> 6) : (tpos & 63);
                        const f32x4 x0 = acc[ai][bj][m][0], x1 = acc[ai][bj][m][1];
                        float o0[4], o1[4];
                        if (lat) {
#pragma unroll
                            for (int i = 0; i < 4; ++i) { const float rev = (float)pos * frev[i]; const float cx = __builtin_amdgcn_cosf(rev), sx = __builtin_amdgcn_sinf(rev);
                                o0[i] = (x0[i] * cx - x1[i] * sx) * sc; o1[i] = (x1[i] * cx + x0[i] * sx) * sc; }
                        } else {
#pragma unroll
                            for (int i = 0; i < 4; ++i) { o0[i] = x0[i] * sc; o1[i] = x1[i] * sc; }
                        }
                        u32x4 pk; pk.x = cvt_pk_bf16(o0[0], o0[1]); pk.y = cvt_pk_bf16(o0[2], o0[3]); pk.z = cvt_pk_bf16(o1[0], o1[1]); pk.w = cvt_pk_bf16(o1[2], o1[3]);
                        *(u32x4*)(PROJ + row * NCOL + colt) = pk;
                        asm volatile("" ::: "memory");
                    }
            } else if (nt < 24) {
                const int kvh = nt - 22;
#pragma unroll
                for (int ai = 0; ai < 2; ++ai)
#pragma unroll
                    for (int m = 0; m < 4; ++m) {
                        const int row = u.pm * 256 + ai * 128 + wr * 64 + m * 16 + lv(fr);
#pragma unroll
                        for (int n = 0; n < 2; ++n) {
                            f32x4 v = acc[ai][bj][m][n];
                            const int d0 = 32 * wc + 8 * fq + 4 * n;
                            if (row < MLAT) { const int b = row >> 13, t = row & 8191;
#pragma unroll
                                for (int i = 0; i < 4; ++i) VT[((size_t)(b * 2 + kvh) * 128 + d0 + i) * SEQ + t] = f2bf(v[i]);
                            } else { const int rc = row - MLAT, b = rc >> 8, t = rc & 255;
#pragma unroll
                                for (int i = 0; i < 4; ++i) VTc[((size_t)(b * 2 + kvh) * 128 + d0 + i) * CTXL + t] = f2bf(v[i]);
                            }
                            asm volatile("" ::: "memory");
                        }
                    }
            } else {
                const int ri = (nt - 32) >> 2, jt = ((nt - 32) & 3) * 128;
#pragma unroll
                for (int ai = 0; ai < 2; ++ai)
#pragma unroll
                    for (int m = 0; m < 4; ++m) {
                        const int R = wr * 64 + m * 16 + lv(fr);
#pragma unroll
                        for (int n = 0; n < 2; ++n) {
                            f32x4 v = acc[ai][bj][m][n];
                            const int j0 = jt + 32 * wc + 8 * fq + 4 * n;
                            if (u.pm < 64) { const int b = u.pm >> 5, t2 = 2 * (u.pm & 31) + ai;
#pragma unroll
                                for (int i = 0; i < 4; ++i) ZT[(((size_t)(b * 512 + j0 + i) * 64 + t2) * 256) + ri * 128 + R] = f2bf(v[i]);
                            } else { const int rc = (u.pm - 64) * 256 + ai * 128 + R, b = rc >> 8, t = rc & 255;
#pragma unroll
                                for (int i = 0; i < 4; ++i) ZTc[((size_t)(b * 512 + j0 + i) * 512) + ri * 256 + t] = f2bf(v[i]);
                            }
                            asm volatile("" ::: "memory");
                        }
                    }
            }
        }
    }
};
struct EpiOut {
    bf16_t* Y;
    __device__ __forceinline__ void operator()(const f32x4 (&acc)[2][2][4][2], const Unit& u, int wr, int wc, int fr, int fq) const {
#pragma unroll
        for (int ai = 0; ai < 2; ++ai)
#pragma unroll
            for (int m = 0; m < 4; ++m) {
                const size_t row = (size_t)u.pm * 256 + ai * 128 + wr * 64 + m * 16 + fr;
#pragma unroll
                for (int bj = 0; bj < 2; ++bj) { const f32x4 v0 = acc[ai][bj][m][0], v1 = acc[ai][bj][m][1];
                    u32x4 pk; pk.x = cvt_pk_bf16(v0[0], v0[1]); pk.y = cvt_pk_bf16(v0[2], v0[3]); pk.z = cvt_pk_bf16(v1[0], v1[1]); pk.w = cvt_pk_bf16(v1[2], v1[3]);
                    *(u32x4*)(Y + row * DM + u.pn * 256 + bj * 128 + 32 * wc + 8 * fq) = pk; }
            }
    }
};
struct EpiFold {
    bf16_t* WinT;
    __device__ __forceinline__ void operator()(const f32x4 (&acc)[2][2][4][2], const Unit& u, int wr, int wc, int fr, int fq) const {
        const int l = u.pm >> 2;
#pragma unroll
        for (int ai = 0; ai < 2; ++ai)
#pragma unroll
            for (int m = 0; m < 4; ++m) {
                const size_t r = (size_t)(u.pm & 3) * 256 + ai * 128 + wr * 64 + m * 16 + fr;
#pragma unroll
                for (int bj = 0; bj < 2; ++bj) { const f32x4 v0 = acc[ai][bj][m][0], v1 = acc[ai][bj][m][1];
                    u32x4 pk; pk.x = cvt_pk_bf16(v0[0], v0[1]); pk.y = cvt_pk_bf16(v0[2], v0[3]); pk.z = cvt_pk_bf16(v1[0], v1[1]); pk.w = cvt_pk_bf16(v1[2], v1[3]);
                    *(u32x4*)(WinT + ((size_t)l * NCOL + C_ZR + r) * DM + (u.pn & 7) * 256 + bj * 128 + 32 * wc + 8 * fq) = pk; }
            }
    }
};
struct EpiS1 {
    bf16_t* Bint;
    __device__ __forceinline__ void operator()(const f32x4 (&acc)[2][2][4][2], const Unit& u, int wr, int wc, int fr, int fq) const {
#pragma unroll
        for (int m = 0; m < 4; ++m) {
            const int k1 = lv(wr * 64 + m * 16 + fr);
            const float revd = (float)k1 * (1.f / 8192.f); const float cd = __builtin_amdgcn_cosf(revd), sd = __builtin_amdgcn_sinf(revd);
#pragma unroll
            for (int bj = 0; bj < 2; ++bj) {
                const int c = u.pn * 256 + bj * 128 + 32 * wc + 8 * fq;
                const int t2 = c & 63, bjx = c >> 6, b = bjx >> 9, j = bjx & 511;
                float br[8], bi[8];
                const float rev0 = (float)(k1 * t2) * (1.f / 8192.f); float cw = __builtin_amdgcn_cosf(rev0), sw = __builtin_amdgcn_sinf(rev0);
#pragma unroll
                for (int n = 0; n < 2; ++n) {
                    const f32x4 ar = acc[0][bj][m][n], aim = acc[1][bj][m][n];
#pragma unroll
                    for (int i = 0; i < 4; ++i) {
                        br[4 * n + i] = ar[i] * cw - aim[i] * sw; bi[4 * n + i] = ar[i] * sw + aim[i] * cw;
                        const float cn = cw * cd - sw * sd; sw = sw * cd + cw * sd; cw = cn; }
                }
                const unsigned off = (unsigned)(((b * 128 + k1) * 512 + j) * 128 + t2);
                u32x4 p0, p1; p0.x = cvt_pk_bf16(br[0], br[1]); p0.y = cvt_pk_bf16(br[2], br[3]); p0.z = cvt_pk_bf16(br[4], br[5]); p0.w = cvt_pk_bf16(br[6], br[7]);
                p1.x = cvt_pk_bf16(bi[0], bi[1]); p1.y = cvt_pk_bf16(bi[2], bi[3]); p1.z = cvt_pk_bf16(bi[4], bi[5]); p1.w = cvt_pk_bf16(bi[6], bi[7]);
                *(u32x4*)(Bint + off) = p0; *(u32x4*)(Bint + off + 64) = p1;
            }
            asm volatile("" ::: "memory");
        }
    }
};
struct EpiCtxF {
    bf16_t* MIX; const bf16_t* PROJ; const float* bf;
    __device__ __forceinline__ void operator()(const f32x4 (&acc)[2][2][4][2], const Unit& u, int wr, int wc, int fr, int fq) const {
#pragma unroll
        for (int ai = 0; ai < 2; ++ai) {
            u32x4 gg[4][2];
#pragma unroll
            for (int m = 0; m < 4; ++m)
#pragma unroll
                for (int bj = 0; bj < 2; ++bj) { const int k = ai * 128 + wr * 64 + m * 16 + fr, col = u.pn * 256 + bj * 128 + 32 * wc + 8 * fq, b = col >> 9, j = col & 511;
                    gg[m][bj] = *(const u32x4*)(PROJ + ((size_t)MLAT + b * 256 + k) * NCOL + C_CG + j); }
#pragma unroll
            for (int m = 0; m < 4; ++m)
#pragma unroll
                for (int bj = 0; bj < 2; ++bj) { const int k = ai * 128 + wr * 64 + m * 16 + fr, col = u.pn * 256 + bj * 128 + 32 * wc + 8 * fq, b = col >> 9, j = col & 511;
                    const f32x4 v0 = acc[ai][bj][m][0], v1 = acc[ai][bj][m][1]; const f32x4 b0 = *(const f32x4*)(bf + j), b1 = *(const f32x4*)(bf + j + 4); const u32x4 g2 = gg[m][bj];
                    u32x4 pk; pk.x = cvt_pk_bf16((v0[0] + b0[0]) * bflo(g2.x), (v0[1] + b0[1]) * bfhi(g2.x)); pk.y = cvt_pk_bf16((v0[2] + b0[2]) * bflo(g2.y), (v0[3] + b0[3]) * bfhi(g2.y));
                    pk.z = cvt_pk_bf16((v1[0] + b1[0]) * bflo(g2.z), (v1[1] + b1[1]) * bfhi(g2.z)); pk.w = cvt_pk_bf16((v1[2] + b1[2]) * bflo(g2.w), (v1[3] + b1[3]) * bfhi(g2.w));
                    *(u32x4*)(MIX + ((size_t)MLAT + b * 256 + k) * DM + 1536 + j) = pk; }
            asm volatile("" ::: "memory");
        }
    }
};

__device__ __forceinline__ int qk_dperm(int p) {
    const int wc = p >> 5, fq = (p >> 3) & 3, n = (p >> 2) & 1, i = p & 3;
    return (wc >> 1) * 64 + n * 32 + (wc & 1) * 16 + fq * 4 + i;
}
struct TrTask { const float* src; bf16_t* dst; int sp, scol0, k0, nd0; bool perm; };
__device__ __forceinline__ TrTask tr_decode(const Params& P, bf16_t* WinT, bf16_t* WoutT, int task) {
    TrTask t;
    if (task < DEPTH * 18 * 32) {
        const int l = task / (18 * 32), r = task % (18 * 32), nb = r >> 5, kt = r & 31;
        t.nd0 = nb < 16 ? nb * 256 : (5120 + (nb - 16) * 256); t.scol0 = nb < 16 ? t.nd0 : t.nd0 - 512; t.perm = (t.nd0 >= C_Q && t.nd0 < C_V);
        t.src = P.w_in + (size_t)l * DM * 5120; t.sp = 5120; t.dst = WinT + (size_t)l * NCOL * DM; t.k0 = kt * 64;
    } else {
        const int q = task - DEPTH * 18 * 32, l = q >> 8, r = q & 255, nb = r >> 5, kt = r & 31;
        t.nd0 = nb * 256; t.scol0 = nb * 256; t.perm = false; t.src = P.w_out + (size_t)l * DM * DM; t.sp = DM; t.dst = WoutT + (size_t)l * DM * DM; t.k0 = kt * 64;
    }
    return t;
}
__device__ __forceinline__ void tr_load(const TrTask& t, int tid, f32x4 (&v)[8]) {
#pragma unroll
    for (int i = 0; i < 8; ++i) { const int k = (tid >> 6) + 8 * i, c4 = (tid & 63) * 4; v[i] = *(const f32x4*)(t.src + (size_t)(t.k0 + k) * t.sp + t.scol0 + c4); }
}
__device__ __forceinline__ void tr_store(const TrTask& t, int tid, const f32x4 (&v)[8], LAS float* scr) {
#pragma unroll
    for (int i = 0; i < 8; ++i) { const int k = (tid >> 6) + 8 * i, c4 = (tid & 63) * 4; LAS float* s = scr + k * 257 + c4; s[0] = v[i][0]; s[1] = v[i][1]; s[2] = v[i][2]; s[3] = v[i][3]; }
    __syncthreads();
#pragma unroll
    for (int i = 0; i < 4; ++i) { const int n = (tid >> 3) + 64 * i, kc = tid & 7;
      int sc = n;
      if (t.perm) { const int p = (t.nd0 + n) & 127; sc = (n & ~63) + (qk_dperm(p) & 63); }
      const LAS float* s = scr + (kc * 8) * 257 + sc;
      u32x4 o; o.x = cvt_pk_bf16(s[0], s[257]); o.y = cvt_pk_bf16(s[2 * 257], s[3 * 257]); o.z = cvt_pk_bf16(s[4 * 257], s[5 * 257]); o.w = cvt_pk_bf16(s[6 * 257], s[7 * 257]);
      *(u32x4*)(t.dst + (size_t)(t.nd0 + n) * DM + t.k0 + kc * 8) = o; }
    __syncthreads();
}

__device__ __forceinline__ void phase0a(const Params& P_unused, LAS unsigned char* lds, int G) {
    const Params P = load_params(); (void)P_unused;
    unsigned char* ws = ls(P.ws);
    bf16_t* WinT = (bf16_t*)(ws + O_WINT); bf16_t* WoutT = (bf16_t*)(ws + O_WOUTT); bf16_t* Wcx = (bf16_t*)(ws + O_WCX); bf16_t* MTf = (bf16_t*)(ws + O_MTF);
    float* modp = (float*)(ws + O_MODP); float2* rope = (float2*)(ws + O_ROPE); float2* twid = (float2*)(ws + O_TWID);
    bf16_t* F128 = (bf16_t*)(ws + O_F128); bf16_t* F64 = (bf16_t*)(ws + O_F64); bf16_t* Dctx = (bf16_t*)(ws + O_DCTX);
    LAS float* scr = (LAS float*)lds;
    const int tid = lv(threadIdx.x), bid = blockIdx.x;
    for (int task = bid; task < 384; task += G) {
        const int l = task / 96, s = (task / 3) & 31, nc = task % 3;
        __syncthreads();
        if (tid < 192) { const int r = tid >> 6, kk = tid & 63; const float v = (r < 2) ? P.c[r * DM + s * 64 + kk] : P.c_ctx[s * 64 + kk]; scr[r * 64 + kk] = silu_f(v); }
        __syncthreads();
        const int n = nc * 2048 + tid * 4;
        f32x4 a0 = {0, 0, 0, 0}, a1 = {0, 0, 0, 0}, a2 = {0, 0, 0, 0};
        const float* wp = P.w_mod + ((size_t)l * DM + s * 64) * 6144 + n;
#pragma unroll 16
        for (int kk = 0; kk < 64; ++kk) { const f32x4 w = *(const f32x4*)(wp + (size_t)kk * 6144); a0 += w * scr[kk]; a1 += w * scr[64 + kk]; a2 += w * scr[128 + kk]; }
        float* op = modp + ((size_t)(l * 32 + s) * 3) * 6144 + n;
        *(f32x4*)(op) = a0; *(f32x4*)(op + 6144) = a1; *(f32x4*)(op + 2 * 6144) = a2;
    }
    __syncthreads();
    {   constexpr int NTR = DEPTH * 18 * 32 + DEPTH * 8 * 32;
        const int tl = lv(tid);
        f32x4 va[8], vb[8];
        int task = bid;
        TrTask cur = tr_decode(P, WinT, WoutT, task < NTR ? task : 0);
        if (task < NTR) tr_load(cur, tl, va);
        for (; task < NTR; task += G) {
            const int nxt = task + G;
            TrTask nx = tr_decode(P, WinT, WoutT, nxt < NTR ? nxt : task);
            if (nxt < NTR) tr_load(nx, tl, vb);
            tr_store(cur, tl, va, scr);
#pragma unroll
            for (int i = 0; i < 8; ++i) va[i] = vb[i];
            cur = nx;
        }
    }
    if (tid < 128) { const float a = (float)tid * (1.f / 64.f); scr[tid] = cospif(a); scr[128 + tid] = sinpif(a); }
    __syncthreads();
    const size_t gt = (size_t)bid * 512 + tid, GT = (size_t)G * 512;
    for (size_t e = gt; e < (size_t)DEPTH * DM * 128; e += GT) {
        const size_t lk = e >> 7; const int j4 = (int)(e & 127) * 4;
        const f32x4 v = *(const f32x4*)(P.w_in + lk * 5120 + 4096 + j4);
        *(u32x2*)(Wcx + lk * 512 + j4) = pack4(v[0], v[1], v[2], v[3]);
    }
    for (size_t e = gt; e < (size_t)DEPTH * 1024 * 512; e += GT) {
        const int col = (int)(e & 511), row = (int)((e >> 9) & 1023), l = (int)(e >> 19);
        const int ri = row >> 9, g = (row >> 7) & 3, d = row & 127, g2 = col >> 7, c = col & 127;
        float v = 0.f;
        if (g == g2) {
            const float* wf = P.w_f + ((size_t)(l * 4 + g) * 128) * 128 + d;
            float s = 0.f;
            const LAS float* tb = scr + ri * 128;
#pragma unroll 8
            for (int c2 = 0; c2 < 128; ++c2) s += tb[(c * c2) & 127] * wf[(size_t)c2 * 128];
            v = s * (1.f / 1024.f);
        }
        MTf[e] = f2bf(v);
    }
    for (size_t e = gt; e < 128 * 32; e += GT) { const int pos = (int)(e >> 5), f = (int)(e & 31);
        const float fr = powf(10000.f, -(float)f / 32.f); const float ang = (float)pos * fr; float sn, cs; sincosf(ang, &sn, &cs); rope[e] = make_float2(cs, sn); }
    for (size_t e = gt; e < 8192; e += GT) { const float a = (float)e * (1.f / 4096.f); twid[e] = make_float2(cospif(a), sinpif(a)); }
    for (size_t e = gt; e < 256 * 256; e += GT) { const int n = (int)(e >> 8), kk = (int)(e & 255); const int ro = n >> 7, k1 = n & 127, rin = kk >> 7, t1 = kk & 127;
        const float a = (float)((k1 * t1) & 127) * (1.f / 64.f); const float cs = cospif(a), sn = sinpif(a);
        const float v = ro == 0 ? (rin == 0 ? cs : -sn) : (rin == 0 ? sn : cs); F128[e] = f2bf(v); }
    for (size_t e = gt; e < 64 * 128; e += GT) { const int k2 = (int)(e >> 7), kk = (int)(e & 127); const int rin = kk >> 6, t2 = kk & 63;
        const float a = (float)((k2 * t2) & 63) * (1.f / 32.f); F64[e] = f2bf(rin == 0 ? cospif(a) : -sinpif(a)); }
    for (size_t e = gt; e < 256 * 512; e += GT) { const int k = (int)(e >> 9), kk = (int)(e & 511); const int rin = kk >> 8, t = kk & 255;
        const float a = (float)((k * t) & 255) * (1.f / 128.f); Dctx[e] = f2bf((rin == 0 ? cospif(a) : -sinpif(a)) * 5.656854249492381f); }
}

__device__ __forceinline__ void row_phase(const Params& P_unused, int layer, int G) {
    const Params P = load_params(); (void)P_unused;
    unsigned char* ws = ls(P.ws);
    const float* mod = (const float*)(ws + O_MOD);
    float* XC = (float*)(ws + O_XC);
    bf16_t* XB = (bf16_t*)(ws + O_XB);
    bf16_t* H = (bf16_t*)(ws + O_HMIX);
    const bf16_t* Y = (const bf16_t*)(ws + O_PROJ); const bf16_t* Yc = (const bf16_t*)(ws + O_YC);
    const int tid = lv(threadIdx.x);
    const int lane = tid & 63, gw = blockIdx.x * 8 + (tid >> 6), NGW = G * 8;
    const int nrows = layer == DEPTH ? MLAT : MROWS;
    const bool xb_src = layer >= 2;
    const float* xctx = layer <= 1 ? P.ctx : XC;
    f32x4 vn[8]; u32x2 yn[8], xn[8];
#define ROW_LOAD(r) do { const int _r = (r); \
        if (_r < MLAT && xb_src) { _Pragma("unroll") for (int j = 0; j < 8; ++j) xn[j] = *(const u32x2*)(XB + (size_t)_r * DM + lane * 4 + 256 * j); } \
        else { const float* _x = _r < MLAT ? P.x + (size_t)_r * DM : xctx + (size_t)(_r - MLAT) * DM; _Pragma("unroll") for (int j = 0; j < 8; ++j) vn[j] = *(const f32x4*)(_x + lane * 4 + 256 * j); } \
        if (layer >= 1) { const bf16_t* _y = _r < MLAT ? Y + (size_t)_r * DM : Yc + (size_t)(_r - MLAT) * DM; _Pragma("unroll") for (int j = 0; j < 8; ++j) yn[j] = *(const u32x2*)(_y + lane * 4 + 256 * j); } } while (0)
    if (gw < nrows) ROW_LOAD(gw);
    for (int row = gw; row < nrows; row += NGW) {
        const bool lat = row < MLAT; const int mr = lat ? (row >> 13) : 2;
        f32x4 v[8]; u32x2 yw[8];
        if (lat && xb_src) {
#pragma unroll
            for (int j = 0; j < 8; ++j) v[j] = (f32x4){bflo(xn[j].x), bfhi(xn[j].x), bflo(xn[j].y), bfhi(xn[j].y)};
        } else {
#pragma unroll
            for (int j = 0; j < 8; ++j) v[j] = vn[j];
        }
#pragma unroll
        for (int j = 0; j < 8; ++j) yw[j] = yn[j];
        const int nr = row + NGW;
        if (nr < nrows) ROW_LOAD(nr);
        if (layer >= 1) {
            const float* mg = mod + ((size_t)(layer - 1) * 3 + mr) * 6144 + 4096;
            const float* gp = P.g_post + (size_t)(layer - 1) * DM;
            f32x4 y[8]; float ss = 0.f;
#pragma unroll
            for (int j = 0; j < 8; ++j) { const u32x2 w = yw[j];
                y[j] = (f32x4){bflo(w.x), bfhi(w.x), bflo(w.y), bfhi(w.y)}; ss += y[j][0] * y[j][0] + y[j][1] * y[j][1] + y[j][2] * y[j][2] + y[j][3] * y[j][3]; }
            const float rinv = rsqrtf(wave_sum(ss) * (1.f / DM) + EPS);
#pragma unroll
            for (int j = 0; j < 8; ++j) { const f32x4 g4 = *(const f32x4*)(mg + lane * 4 + 256 * j), p4 = *(const f32x4*)(gp + lane * 4 + 256 * j);
                v[j] = v[j] + g4 * (y[j] * rinv * p4); }
            if (!lat) {
#pragma unroll
                for (int j = 0; j < 8; ++j) *(f32x4*)(XC + (size_t)(row - MLAT) * DM + lane * 4 + 256 * j) = v[j];
            } else if (layer == DEPTH) {
#pragma unroll
                for (int j = 0; j < 8; ++j) *(f32x4*)(P.out + (size_t)row * DM + lane * 4 + 256 * j) = v[j];
            } else {
#pragma unroll
                for (int j = 0; j < 8; ++j) *(u32x2*)(XB + (size_t)row * DM + lane * 4 + 256 * j) = pack4(v[j][0], v[j][1], v[j][2], v[j][3]);
            }
        }
        if (layer < DEPTH) {
            float ss = 0.f;
#pragma unroll
            for (int j = 0; j < 8; ++j) ss += v[j][0] * v[j][0] + v[j][1] * v[j][1] + v[j][2] * v[j][2] + v[j][3] * v[j][3];
            const float rinv = rsqrtf(wave_sum(ss) * (1.f / DM) + EPS);
            const float* msh = mod + ((size_t)layer * 3 + mr) * 6144; const float* msc = msh + 2048;
            const float* gp = P.g_pre + (size_t)layer * DM;
#pragma unroll
            for (int j = 0; j < 8; ++j) { const f32x4 sh = *(const f32x4*)(msh + lane * 4 + 256 * j), sc = *(const f32x4*)(msc + lane * 4 + 256 * j), g4 = *(const f32x4*)(gp + lane * 4 + 256 * j);
                const f32x4 h = (v[j] * rinv * g4) * (sc + 1.f) + sh;
                *(u32x2*)(H + (size_t)row * DM + lane * 4 + 256 * j) = pack4(h[0], h[1], h[2], h[3]); }
        }
    }
#undef ROW_LOAD
}

__device__ __forceinline__ void attn_task(const Params& P_unused, int layer, int task, LAS unsigned char* lds) {
    const Params P = load_params(); (void)P_unused;
    unsigned char* ws = ls(P.ws);
    const bf16_t* PROJ = (const bf16_t*)(ws + O_PROJ);
    const bf16_t* VT = (const bf16_t*)(ws + O_VT); const bf16_t* VTc = (const bf16_t*)(ws + O_VTC);
    bf16_t* MIX = (bf16_t*)(ws + O_HMIX);
    const int tid = lv(threadIdx.x);
    const int lane = tid & 63, w = __builtin_amdgcn_readfirstlane(tid >> 6), fr = lane & 15, fq = lane >> 4;
    int b, blk, kvh, pair; bool isctx;
    if (task < 512) { isctx = false; b = task >> 8; const int rem = task & 255; blk = rem >> 2; kvh = (rem >> 1) & 1; pair = rem & 1; }
    else { isctx = true; const int t = task - 512; b = t >> 3; blk = (t >> 2) & 1; kvh = (t >> 1) & 1; pair = t & 1; }
    const int head = kvh * 4 + pair * 2 + (w >> 2);
    const int a0 = (w & 3) * 32;
    const size_t qrow0 = (isctx ? (size_t)MLAT + b * CTXL : (size_t)b * SEQ) + blk * 128 + a0;
    bf16x8 qf[2][4];
#pragma unroll
    for (int u = 0; u < 2; ++u)
#pragma unroll
        for (int c = 0; c < 4; ++c) qf[u][c] = *(const bf16x8*)(PROJ + (qrow0 + u * 16 + fr) * NCOL + C_Q + head * 128 + c * 32 + fq * 8);
    u32x2 gws[2][8];
#pragma unroll
    for (int u = 0; u < 2; ++u)
#pragma unroll
        for (int dt = 0; dt < 8; ++dt) gws[u][dt] = *(const u32x2*)(PROJ + (qrow0 + u * 16 + fr) * NCOL + C_BG + head * 128 + dt * 16 + 4 * fq);
    float mrun[2], lrun[2];
    const float sk = P.sink[layer * 8 + head] * LOG2E;
    mrun[0] = mrun[1] = sk; lrun[0] = lrun[1] = 1.f;
    f32x4 o[8][2];
#pragma unroll
    for (int dt = 0; dt < 8; ++dt) { o[dt][0] = (f32x4){0, 0, 0, 0}; o[dt][1] = (f32x4){0, 0, 0, 0}; }
    const int nprev = (!isctx && blk > 0) ? 4 : 0, nnext = (!isctx && blk < 63) ? 4 : 0;
    const int T = isctx ? 8 : 12 + nprev + nnext;
    const int lkey = tid >> 4, lkc = (tid & 15) ^ (((lkey >> 3) << 2) | (lkey & 3));
    const unsigned koff = (unsigned)(lkey * NCOL + lkc * 8) * 2u;
    const int ld = tid >> 2, lvc = (tid & 3) ^ ((ld >> 2) & 3);
    const unsigned voff_c = (unsigned)(ld * CTXL + lvc * 8) * 2u, voff_s = (unsigned)(ld * SEQ + lvc * 8) * 2u;
    const char* kctx = (const char*)(PROJ + ((size_t)MLAT + b * CTXL) * NCOL + C_K + kvh * 128);
    const char* klat = (const char*)(PROJ + ((size_t)b * SEQ) * NCOL + C_K + kvh * 128);
    const char* vctx = (const char*)(VTc + (size_t)(b * 2 + kvh) * 128 * CTXL);
    const char* vlat = (const char*)(VT + (size_t)(b * 2 + kvh) * 128 * SEQ);
#define ATT_ISSUE(tt) do { int _t = (tt) < T ? (tt) : T - 1; const char* _kp; const char* _vp; unsigned _vo; \
        if (_t < 8) { _kp = kctx + (size_t)(_t * 32) * NCOL * 2; _vp = vctx + _t * 64; _vo = voff_c; } \
        else { const int _r = _t - 8, _seg = _r < nprev ? 0 : (_r < nprev + 4 ? 1 : 2), _st = _seg == 0 ? _r : (_seg == 1 ? _r - nprev : _r - nprev - 4); \
               const int _kb = (blk - 1 + _seg) * 128 + _st * 32; _kp = klat + (size_t)_kb * NCOL * 2; _vp = vlat + _kb * 2; _vo = voff_s; } \
        LAS unsigned char* _dst = lds + ((tt) & 7) * 16384 + w * 1024; \
        __builtin_amdgcn_global_load_lds((const unsigned*)(_kp + koff), (LAS unsigned*)(_dst), 16, 0, 0); \
        __builtin_amdgcn_global_load_lds((const unsigned*)(_vp + _vo), (LAS unsigned*)(_dst + 8192), 16, 0, 0); } while (0)
    ATT_ISSUE(0); ATT_ISSUE(1); ATT_ISSUE(2); ATT_ISSUE(3); ATT_ISSUE(4); ATT_ISSUE(5);
    const int kfo = (8 * (fr >> 2) + (fr & 3)) * 256, vfo = fr * 64 + ((fq ^ ((fr >> 2) & 3)) * 16);
    int kofs[4];
#pragma unroll
    for (int c = 0; c < 4; ++c) kofs[c] = kfo + (((c * 4 + fq) ^ fr) * 16);
    const f32x4 zero4 = {0.f, 0.f, 0.f, 0.f};
    for (int tp = 0; tp < T; tp += 2) {
        asm volatile("s_waitcnt vmcnt(8) lgkmcnt(0)" ::: "memory");
        __builtin_amdgcn_s_barrier();
        asm volatile("" ::: "memory");
        ATT_ISSUE(tp + 6); ATT_ISSUE(tp + 7);
        int mtype = 0, st = 0;
        if (tp >= 8) { const int r = tp - 8; if (r < nprev) { mtype = 1; st = r; } else if (r >= nprev + 4) { mtype = 2; st = r - nprev - 4; } }
        const int k0 = st * 32;
        if (mtype == 1 && k0 + 63 < a0) continue;
        if (mtype == 2 && k0 > a0 + 31) continue;
        f32x4 s[2][2][2];
#pragma unroll
        for (int tl = 0; tl < 2; ++tl) {
            const LAS unsigned char* kb = lds + ((tp + tl) & 7) * 16384;
#pragma unroll
            for (int v = 0; v < 2; ++v)
#pragma unroll
                for (int c = 0; c < 4; ++c) {
                    const bf16x8 ka = *(const LAS bf16x8*)(kb + kofs[c] + v * 1024);
                    s[0][tl][v] = __builtin_amdgcn_mfma_f32_16x16x32_bf16(ka, qf[0][c], c == 0 ? zero4 : s[0][tl][v], 0, 0, 0);
                    s[1][tl][v] = __builtin_amdgcn_mfma_f32_16x16x32_bf16(ka, qf[1][c], c == 0 ? zero4 : s[1][tl][v], 0, 0, 0);
                }
        }
        bf16x8 pb[2][2];
#pragma unroll
        for (int u = 0; u < 2; ++u) {
            if (mtype == 1) {
                asm volatile("" ::: "memory");
                const int a = a0 + u * 16 + fr - k0 - 8 * fq;
#pragma unroll
                for (int tl = 0; tl < 2; ++tl)
#pragma unroll
                    for (int v = 0; v < 2; ++v)
#pragma unroll
                        for (int r = 0; r < 4; ++r) { if (32 * tl + 4 * v + r < a) s[u][tl][v][r] = -1e30f; }
            } else if (mtype == 2) {
                asm volatile("" ::: "memory");
                const int a = a0 + u * 16 + fr - k0 - 8 * fq;
#pragma unroll
                for (int tl = 0; tl < 2; ++tl)
#pragma unroll
                    for (int v = 0; v < 2; ++v)
#pragma unroll
                        for (int r = 0; r < 4; ++r) { if (32 * tl + 4 * v + r > a) s[u][tl][v][r] = -1e30f; }
            }
            float mx = -3e38f;
#pragma unroll
            for (int tl = 0; tl < 2; ++tl)
#pragma unroll
                for (int v = 0; v < 2; ++v) mx = fmaxf(mx, fmaxf(fmaxf(s[u][tl][v][0], s[u][tl][v][1]), fmaxf(s[u][tl][v][2], s[u][tl][v][3])));
            mx = xor16_max(mx); mx = xor32_max(mx);
            float mn = mrun[u], alpha = 1.f;
            const bool grow = __any(mx > mrun[u] + 8.f);
            if (grow) { mn = fmaxf(mrun[u], mx); alpha = __builtin_amdgcn_exp2f(mrun[u] - mn); }
            float p[16]; float ps = 0.f;
#pragma unroll
            for (int tl = 0; tl < 2; ++tl)
#pragma unroll
                for (int v = 0; v < 2; ++v)
#pragma unroll
                    for (int r = 0; r < 4; ++r) { const float e = __builtin_amdgcn_exp2f(s[u][tl][v][r] - mn); p[tl * 8 + v * 4 + r] = e; ps += e; }
            ps = xor16_sum(ps); ps = xor32_sum(ps);
            lrun[u] = lrun[u] * alpha + ps;
            if (grow) {
#pragma unroll
                for (int dt = 0; dt < 8; ++dt) o[dt][u] = o[dt][u] * alpha;
            }
            mrun[u] = mn;
#pragma unroll
            for (int tl = 0; tl < 2; ++tl) {
                u32x4 pk; pk.x = cvt_pk_bf16(p[tl * 8 + 0], p[tl * 8 + 1]); pk.y = cvt_pk_bf16(p[tl * 8 + 2], p[tl * 8 + 3]); pk.z = cvt_pk_bf16(p[tl * 8 + 4], p[tl * 8 + 5]); pk.w = cvt_pk_bf16(p[tl * 8 + 6], p[tl * 8 + 7]);
                pb[u][tl] = __builtin_bit_cast(bf16x8, pk);
            }
        }
#pragma unroll
        for (int tl = 0; tl < 2; ++tl) {
            const LAS unsigned char* vb = lds + ((tp + tl) & 7) * 16384 + 8192;
#pragma unroll
            for (int dt = 0; dt < 8; ++dt) {
                const bf16x8 va = *(const LAS bf16x8*)(vb + dt * 1024 + vfo);
                o[dt][0] = __builtin_amdgcn_mfma_f32_16x16x32_bf16(va, pb[0][tl], o[dt][0], 0, 0, 0);
                o[dt][1] = __builtin_amdgcn_mfma_f32_16x16x32_bf16(va, pb[1][tl], o[dt][1], 0, 0, 0);
            }
        }
    }
    asm volatile("s_waitcnt vmcnt(0) lgkmcnt(0)" ::: "memory");
    __builtin_amdgcn_s_barrier();
    asm volatile("" ::: "memory");
#undef ATT_ISSUE
#pragma unroll
    for (int u = 0; u < 2; ++u) {
        const float inv = 1.f / lrun[u];
        const size_t row = qrow0 + u * 16 + fr;
#pragma unroll
        for (int dt = 0; dt < 8; ++dt) {
            const int d0 = head * 128 + dt * 16 + 4 * fq;
            const u32x2 gw = gws[u][dt];
            const f32x4 ov = o[dt][u] * inv;
            *(u32x2*)(MIX + row * DM + 512 + d0) = pack4(ov[0] * bflo(gw.x), ov[1] * bfhi(gw.x), ov[2] * bflo(gw.y), ov[3] * bfhi(gw.y));
        }
    }
}

constexpr int GM_PART = 131072, GM_RQ = GM_PART + 32 * 128 * 4, GM_G = GM_RQ + 512, GM_B = GM_G + 2048, LDS_TOTAL = GM_B + 2048;
__device__ __forceinline__ void gmlp_task(const Params& P_unused, int layer, int chunk, LAS unsigned char* lds) {
    const Params P = load_params(); (void)P_unused;
    unsigned char* ws = ls(P.ws);
    const bf16_t* PROJ = (const bf16_t*)(ws + O_PROJ); const bf16_t* avT = (const bf16_t*)(ws + O_AVT) + (size_t)chunk * 512 * 128;
    bf16_t* MIX = (bf16_t*)(ws + O_HMIX);
    LAS float* part = (LAS float*)(lds + GM_PART);
    LAS float* rq = (LAS float*)(lds + GM_RQ);
    LAS float* gl = (LAS float*)(lds + GM_G);
    LAS float* bl = (LAS float*)(lds + GM_B);
    const int tid = lv(threadIdx.x), lane = tid & 63, w = __builtin_amdgcn_readfirstlane(tid >> 6), fr = lane & 15, fq = lane >> 4;
    __syncthreads();
    const int myc = (tid & 15) ^ ((tid >> 4) & 15);
    { const char* src = (const char*)avT + (size_t)(tid >> 4) * 256 + myc * 16;
#pragma unroll
      for (int i = 0; i < 16; ++i) __builtin_amdgcn_global_load_lds((const unsigned*)(src + (size_t)i * 32 * 256), (LAS unsigned*)(lds + i * 8192 + w * 1024), 16, 0, 0); }
    const int p = 16 * w + fr; const size_t row = (size_t)chunk * 128 + p;
    f32x4 wsn[8]; u32x2 uun[8], ggn[8];
#define GM_LOAD(h) do { const float* _wsr = P.w_sgu + (((size_t)layer * 4 + (h)) * 128 + p) * 128; \
        _Pragma("unroll") for (int c = 0; c < 4; ++c) { wsn[2 * c] = *(const f32x4*)(_wsr + c * 32 + 8 * fq); wsn[2 * c + 1] = *(const f32x4*)(_wsr + c * 32 + 8 * fq + 4); } \
        _Pragma("unroll") for (int dt = 0; dt < 8; ++dt) { const int _col = (h) * 128 + dt * 16 + 4 * fq; uun[dt] = *(const u32x2*)(PROJ + row * NCOL + C_AU + _col); ggn[dt] = *(const u32x2*)(PROJ + row * NCOL + C_AG + _col); } } while (0)
    GM_LOAD(0);
    if (tid < 128) *(LAS f32x4*)(gl + tid * 4) = *(const f32x4*)(P.g_sgu + (size_t)layer * 512 + tid * 4);
    else if (tid < 256) *(LAS f32x4*)(bl + (tid - 128) * 4) = *(const f32x4*)(P.b_sgu + (size_t)layer * 512 + (tid - 128) * 4);
    asm volatile("s_waitcnt vmcnt(0)" ::: "memory");
    __builtin_amdgcn_s_barrier();
    asm volatile("" ::: "memory");
    { float s8[8] = {0, 0, 0, 0, 0, 0, 0, 0};
#pragma unroll
      for (int i = 0; i < 16; ++i) { const u32x4 v = *(const LAS u32x4*)(lds + i * 8192 + tid * 16);
          float f; f = bflo(v.x); s8[0] += f * f; f = bfhi(v.x); s8[1] += f * f; f = bflo(v.y); s8[2] += f * f; f = bfhi(v.y); s8[3] += f * f;
          f = bflo(v.z); s8[4] += f * f; f = bfhi(v.z); s8[5] += f * f; f = bflo(v.w); s8[6] += f * f; f = bfhi(v.w); s8[7] += f * f; }
#pragma unroll
      for (int e = 0; e < 8; ++e) part[(tid >> 4) * 128 + myc * 8 + e] = s8[e]; }
    __syncthreads();
    if (tid < 128) { float s = 0.f; for (int i = 0; i < 32; ++i) s += part[i * 128 + tid]; rq[tid] = rsqrtf(s * (1.f / 512.f) + EPS); }
    __syncthreads();
    for (int h = 0; h < 4; ++h) {
        f32x4 wsc[8]; u32x2 uu[8], gg[8];
#pragma unroll
        for (int i = 0; i < 8; ++i) { wsc[i] = wsn[i]; uu[i] = uun[i]; gg[i] = ggn[i]; }
        if (h < 3) GM_LOAD(h + 1);
        bf16x8 bfr[4];
#pragma unroll
        for (int c = 0; c < 4; ++c) { const int q0 = c * 32 + 8 * fq; const f32x4 w0 = wsc[2 * c], w1 = wsc[2 * c + 1];
            u32x4 pk; pk.x = cvt_pk_bf16(w0[0] * rq[q0], w0[1] * rq[q0 + 1]); pk.y = cvt_pk_bf16(w0[2] * rq[q0 + 2], w0[3] * rq[q0 + 3]);
            pk.z = cvt_pk_bf16(w1[0] * rq[q0 + 4], w1[1] * rq[q0 + 5]); pk.w = cvt_pk_bf16(w1[2] * rq[q0 + 6], w1[3] * rq[q0 + 7]); bfr[c] = __builtin_bit_cast(bf16x8, pk); }
        f32x4 acc[8];
#pragma unroll
        for (int dt = 0; dt < 8; ++dt) { acc[dt] = (f32x4){0, 0, 0, 0};
#pragma unroll
            for (int c = 0; c < 4; ++c) { const bf16x8 a = *(const LAS bf16x8*)(lds + (h * 128 + dt * 16 + fr) * 256 + (((c * 4 + fq) ^ fr) * 16));
                acc[dt] = __builtin_amdgcn_mfma_f32_16x16x32_bf16(a, bfr[c], acc[dt], 0, 0, 0); } }
        const float bs = bl[h * 128 + p];
#pragma unroll
        for (int dt = 0; dt < 8; ++dt) { const int col = h * 128 + dt * 16 + 4 * fq;
            const f32x4 g4 = *(const LAS f32x4*)(gl + col);
            const u32x2 u2 = uu[dt], g2 = gg[dt];
            const float y0 = bflo(u2.x) * (acc[dt][0] * g4[0] + bs) * bflo(g2.x), y1 = bfhi(u2.x) * (acc[dt][1] * g4[1] + bs) * bfhi(g2.x);
            const float y2 = bflo(u2.y) * (acc[dt][2] * g4[2] + bs) * bflo(g2.y), y3 = bfhi(u2.y) * (acc[dt][3] * g4[3] + bs) * bfhi(g2.y);
            *(u32x2*)(MIX + row * DM + col) = pack4(y0, y1, y2, y3); }
    }
#undef GM_LOAD
    __syncthreads();
}

__device__ __forceinline__ void stage2_phase(const Params& P_unused, int layer, int G) {
    const Params P = load_params(); (void)P_unused;
    unsigned char* ws = ls(P.ws);
    const bf16_t* Bint = (const bf16_t*)(ws + O_BINT); const bf16_t* F64 = (const bf16_t*)(ws + O_F64); const bf16_t* PROJ = (const bf16_t*)(ws + O_PROJ);
    bf16_t* MIX = (bf16_t*)(ws + O_HMIX);
    const int tid = lv(threadIdx.x);
    const int lane = tid & 63, w = __builtin_amdgcn_readfirstlane(tid >> 6), fr = lane & 15, fq = lane >> 4;
    bf16x8 ff[4][4];
#pragma unroll
    for (int nt = 0; nt < 4; ++nt)
#pragma unroll
        for (int c = 0; c < 4; ++c) ff[nt][c] = *(const bf16x8*)(F64 + (size_t)(nt * 16 + fr) * 128 + c * 32 + fq * 8);
    for (int task = blockIdx.x; task < 256; task += G) {
        const int b = task >> 7, k1 = task & 127;
        bf16x8 af[4][4]; u32x2 gg[4][4]; f32x4 bias[4];
#pragma unroll
        for (int mi = 0; mi < 4; ++mi) {
            const int j0 = (w * 4 + mi) * 16, jc = j0 + 4 * fq;
#pragma unroll
            for (int c = 0; c < 4; ++c) af[mi][c] = *(const bf16x8*)(Bint + (((size_t)(b * 128 + k1) * 512 + j0 + fr) * 128) + c * 32 + fq * 8);
            bias[mi] = *(const f32x4*)(P.b_f + (size_t)layer * 512 + jc);
#pragma unroll
            for (int nt = 0; nt < 4; ++nt) gg[mi][nt] = *(const u32x2*)(PROJ + ((size_t)b * SEQ + k1 + 128 * (nt * 16 + fr)) * NCOL + C_CG + jc);
        }
#pragma unroll
        for (int mi = 0; mi < 4; ++mi) {
            const int jc = (w * 4 + mi) * 16 + 4 * fq;
#pragma unroll
            for (int nt = 0; nt < 4; ++nt) {
                f32x4 acc = {0, 0, 0, 0};
#pragma unroll
                for (int c = 0; c < 4; ++c) acc = __builtin_amdgcn_mfma_f32_16x16x32_bf16(af[mi][c], ff[nt][c], acc, 0, 0, 0);
                const int k2 = nt * 16 + fr; const size_t row = (size_t)b * SEQ + k1 + 128 * k2;
                const u32x2 g2 = gg[mi][nt];
                *(u32x2*)(MIX + row * DM + 1536 + jc) = pack4((acc[0] + bias[mi][0]) * bflo(g2.x), (acc[1] + bias[mi][1]) * bfhi(g2.x), (acc[2] + bias[mi][2]) * bflo(g2.y), (acc[3] + bias[mi][3]) * bfhi(g2.y));
            }
        }
    }
}

__device__ __forceinline__ void ctx_outproj_tile(const Params& P_unused, int layer, int tile, LAS unsigned char* lds) {
    const Params P = load_params(); (void)P_unused;
    unsigned char* ws = ls(P.ws);
    const bf16_t* A = (const bf16_t*)(ws + O_HMIX) + (size_t)MLAT * DM;
    const bf16_t* Bt = (const bf16_t*)(ws + O_WOUTT) + (size_t)layer * DM * DM;
    bf16_t* Yc = (bf16_t*)(ws + O_YC);
    const int tid = lv(threadIdx.x);
    const int lane = tid & 63, w = __builtin_amdgcn_readfirstlane(tid >> 6), fr = lane & 15, fq = lane >> 4;
    const int m0 = (tile >> 5) * 64, n0 = (tile & 31) * 64;
    f32x4 acc[4][4];
#pragma unroll
    for (int i = 0; i < 4; ++i)
#pragma unroll
        for (int j = 0; j < 4; ++j) acc[i][j] = (f32x4){0, 0, 0, 0};
    const bf16_t* ap = A + (size_t)(m0 + fr) * DM + w * 256 + fq * 8;
    const bf16_t* bp = Bt + (size_t)(n0 + fr) * DM + w * 256 + fq * 8;
#pragma unroll 4
    for (int ks = 0; ks < 8; ++ks) {
        bf16x8 af[4], bv[4];
#pragma unroll
        for (int i = 0; i < 4; ++i) { af[i] = *(const bf16x8*)(ap + (size_t)i * 16 * DM + ks * 32); bv[i] = *(const bf16x8*)(bp + (size_t)i * 16 * DM + ks * 32); }
#pragma unroll
        for (int i = 0; i < 4; ++i)
#pragma unroll
            for (int j = 0; j < 4; ++j) acc[i][j] = __builtin_amdgcn_mfma_f32_16x16x32_bf16(af[i], bv[j], acc[i][j], 0, 0, 0);
    }
    __syncthreads();
    LAS float* red = (LAS float*)lds + w * 4096;
#pragma unroll
    for (int i = 0; i < 4; ++i)
#pragma unroll
        for (int j = 0; j < 4; ++j)
#pragma unroll
            for (int r = 0; r < 4; ++r) red[(i * 16 + 4 * fq + r) * 64 + j * 16 + fr] = acc[i][j][r];
    __syncthreads();
    { const int e0 = tid * 8, row = e0 >> 6, col = e0 & 63;
      f32x4 s0 = {0, 0, 0, 0}, s1 = {0, 0, 0, 0};
#pragma unroll
      for (int wv = 0; wv < 8; ++wv) { const LAS f32x4* p = (const LAS f32x4*)((LAS float*)lds + wv * 4096 + e0); s0 += p[0]; s1 += p[1]; }
      u32x4 o; o.x = cvt_pk_bf16(s0[0], s0[1]); o.y = cvt_pk_bf16(s0[2], s0[3]); o.z = cvt_pk_bf16(s1[0], s1[1]); o.w = cvt_pk_bf16(s1[2], s1[3]);
      *(u32x4*)(Yc + (size_t)(m0 + row) * DM + n0 + col) = o; }
    __syncthreads();
}

#define XB_TMO      128
#define XB_XCNT(j)  (256  + 64 * (j))
#define XB_XSUB(j)  (1280 + 64 * (j))
#define XB_XGEN(j)  (2304 + 64 * (j))
#define XB_TOP      3328
#define XB_TOPGEN   3392
#define XCD_BAR_WORDS 3456
#define XB_SPIN_CAP (1u << 18)
__device__ __forceinline__ unsigned xb_ld(unsigned* p)              { return __hip_atomic_load(p, __ATOMIC_RELAXED, __HIP_MEMORY_SCOPE_AGENT); }
__device__ __forceinline__ unsigned xb_add(unsigned* p, unsigned v) { return __hip_atomic_fetch_add(p, v, __ATOMIC_RELAXED, __HIP_MEMORY_SCOPE_AGENT); }
__device__ __forceinline__ unsigned xb_xcc_id() { return (unsigned)__builtin_amdgcn_s_getreg((3 << 11) | 20) & 0xFu; }
#define XB_SPIN(cond, bar) do { unsigned _sp = 0; while (cond) { __builtin_amdgcn_s_sleep(1); \
    if ((++_sp & 255u) == 0u) { if (xb_ld(&(bar)[XB_TMO])) break; if (_sp > XB_SPIN_CAP) { atomicAdd(&(bar)[XB_TMO], 1u); break; } } } } while (0)
struct XcdBarrier { unsigned* bar; unsigned x; volatile LAS unsigned* st; };
__device__ __forceinline__ XcdBarrier xcd_barrier_post(unsigned* bar, volatile LAS unsigned* st) {
    XcdBarrier b; b.bar = bar; b.x = xb_xcc_id(); b.st = st;
    if (threadIdx.x == 0) (void)xb_add(&bar[XB_XCNT(b.x)], 1u);
    return b;
}
__device__ __forceinline__ void xcd_barrier_complete(unsigned* bar, unsigned x, unsigned& nloc, unsigned& nx) {
    const unsigned G = gridDim.x * gridDim.y * gridDim.z;
    unsigned sum, cnt, mine, sp = 0u;
    for (;;) {
        sum = 0u; cnt = 0u; mine = 0u;
#pragma unroll
        for (unsigned j = 0; j < 16; ++j) { const unsigned c = xb_ld(&bar[XB_XCNT(j)]); sum += c; cnt += (c > 0u) ? 1u : 0u; mine = (j == x) ? c : mine; }
        if (sum == G) break;
        __builtin_amdgcn_s_sleep(1);
        if ((++sp & 255u) == 0u) { if (xb_ld(&bar[XB_TMO])) break; if (sp > XB_SPIN_CAP) { atomicAdd(&bar[XB_TMO], 1u); break; } }
    }
    nloc = mine > 0u ? mine : 1u; nx = cnt > 0u ? cnt : 1u;
}
__device__ __forceinline__ void xcd_barrier(const XcdBarrier& b) {
    asm volatile("s_waitcnt vmcnt(0)" ::: "memory");
    __syncthreads();
    if (threadIdx.x == 0) {
        unsigned* bar = b.bar;
        __builtin_amdgcn_s_waitcnt(0);
        unsigned nloc = b.st[0], nx = b.st[1];
        if (nloc == 0u) { xcd_barrier_complete(bar, b.x, nloc, nx); b.st[0] = nloc; b.st[1] = nx; }
        const unsigned old = xb_add(&bar[XB_XSUB(b.x)], 1u);
        const unsigned gen = old / nloc;
        if (old + 1u == (gen + 1u) * nloc) {
            __builtin_amdgcn_fence(__ATOMIC_RELEASE, "agent");
            asm volatile("s_waitcnt vmcnt(0)" ::: "memory");
            const unsigned og = xb_add(&bar[XB_TOP], 1u);
            const unsigned tg = og / nx;
            if (og + 1u == (tg + 1u) * nx) xb_add(&bar[XB_TOPGEN], 1u);
            else XB_SPIN(xb_ld(&bar[XB_TOPGEN]) == tg, bar);
            __builtin_amdgcn_fence(__ATOMIC_ACQUIRE, "agent");
            xb_add(&bar[XB_XGEN(b.x)], 1u);
            asm volatile("s_waitcnt vmcnt(0)" ::: "memory");
        } else {
            XB_SPIN(xb_ld(&bar[XB_XGEN(b.x)]) == gen, bar);
            __builtin_amdgcn_fence(__ATOMIC_ACQUIRE, "agent");
            asm volatile("s_waitcnt vmcnt(0)" ::: "memory");
        }
    }
    __syncthreads();
}

__global__ void __launch_bounds__(512) fwd_megakernel(Params P_arg) {
    const Params& P = P_arg;
    extern __shared__ __attribute__((aligned(16))) unsigned char shm[];
    LAS unsigned char* lds = (LAS unsigned char*)shm;
    cg::grid_group grid = cg::this_grid();
    const int G = gridDim.x, bid = blockIdx.x;
    __shared__ uint4 xb_words;
    if (threadIdx.x == 0) xb_words = make_uint4(0u, 0u, 0u, 0u);
    __syncthreads();
    const XcdBarrier xb = xcd_barrier_post((unsigned*)(P.ws + O_BAR), (volatile LAS unsigned*)&xb_words);
#define WSP() const Params P = load_params(); unsigned char* ws = ls(P.ws); bf16_t* WinT = (bf16_t*)(ws + O_WINT); bf16_t* WoutT = (bf16_t*)(ws + O_WOUTT); bf16_t* HMIX = (bf16_t*)(ws + O_HMIX); bf16_t* PROJ = (bf16_t*)(ws + O_PROJ); (void)WinT; (void)WoutT; (void)HMIX; (void)PROJ

    phase0a(P, lds, G);
    grid.sync();
    {
        WSP();
        SchedFold S; S.G = G; S.c = bid;
        EpiFold E; E.WinT = WinT;
        Gemm g; g.A = (const bf16_t*)(ws + O_MTF); g.Bt = (const bf16_t*)(ws + O_WCX); g.K = 512;
        pg8::gemm_phase(lds, g, S, E);
        const float* modp = (const float*)(ws + O_MODP); float* mod = (float*)(ws + O_MOD);
        for (int e = bid * 512 + threadIdx.x; e < DEPTH * 3 * 1536; e += G * 512) {
            const int n4 = (e % 1536) * 4, lr = e / 1536, l = lr / 3, r = lr % 3;
            f32x4 a = *(const f32x4*)(P.b_mod + (size_t)l * 6144 + n4);
            for (int s = 0; s < 32; ++s) a += *(const f32x4*)(modp + ((size_t)(l * 32 + s) * 3 + r) * 6144 + n4);
            *(f32x4*)(mod + (size_t)lr * 6144 + n4) = a;
        }
    }
    xcd_barrier(xb);
#pragma unroll 1
    for (int layer = 0; layer < DEPTH; ++layer) {
        const bool lastl = layer == DEPTH - 1;
        row_phase(P, layer, G);
        xcd_barrier(xb);
        {
            WSP();
            SchedIn S; S.init(66, 22, G, bid);
            EpiIn E; E.PROJ = PROJ; E.avT = (bf16_t*)(ws + O_AVT); E.VT = (bf16_t*)(ws + O_VT); E.VTc = (bf16_t*)(ws + O_VTC); E.ZT = (bf16_t*)(ws + O_ZT); E.ZTc = (bf16_t*)(ws + O_ZTC); E.rope = (const float2*)(ws + O_ROPE);
            Gemm g; g.A = HMIX; g.Bt = WinT + (size_t)layer * NCOL * DM; g.K = DM;
            pg8::gemm_phase(lds, g, S, E);
        }
        xcd_barrier(xb);
        {
            WSP();
            for (int task = bid; task < 512; task += G) attn_task(P, layer, task, lds);
            {   SchedFew S; S.n = 256; S.G = G; S.c = bid;
                EpiS1 E; E.Bint = (bf16_t*)(ws + O_BINT);
                Gemm g; g.A = (const bf16_t*)(ws + O_F128); g.Bt = (const bf16_t*)(ws + O_ZT); g.K = 256;
                pg8::gemm_phase(lds, g, S, E); }
            const int nch = lastl ? 128 : 132;
            for (int ch = bid; ch < nch; ch += G) gmlp_task(P, layer, ch, lds);
            if (!lastl) {
                const int c2 = (bid - 132 + G) % G;
                for (int t = c2; t < 16; t += G) attn_task(P, layer, 512 + t, lds);
                __syncthreads();
                SchedFew S; S.n = 4; S.G = G; S.c = (bid - 148 + G) % G;
                EpiCtxF E; E.MIX = HMIX; E.PROJ = PROJ; E.bf = P.b_f + (size_t)layer * 512;
                Gemm g; g.A = (const bf16_t*)(ws + O_DCTX); g.Bt = (const bf16_t*)(ws + O_ZTC); g.K = 512;
                pg8::gemm_phase(lds, g, S, E);
            }
        }
        xcd_barrier(xb);
        stage2_phase(P, layer, G);
        if (!lastl) for (int tile = bid; tile < 256; tile += G) ctx_outproj_tile(P, layer, tile, lds);
        xcd_barrier(xb);
        {
            WSP();
            pg8::StaticOrder S; S.init(64, 8, G, bid);
            EpiOut E; E.Y = PROJ;
            Gemm g; g.A = HMIX; g.Bt = WoutT + (size_t)layer * DM * DM; g.K = DM;
            pg8::gemm_phase(lds, g, S, E);
        }
        xcd_barrier(xb);
    }
    row_phase(P, DEPTH, G);
}

extern "C" void kernel_launch(void* const* d_in, const int* in_sizes, int n_in, void* d_out, int out_size, void* d_ws, size_t ws_size, hipStream_t stream) {
    constexpr size_t kDynLds = LDS_TOTAL;
    static int grid_blocks = 0;
    if (!grid_blocks) {
        if (ws_size < WS_END) { fprintf(stderr, "kernel_launch: workspace too small: %zu < %zu\n", ws_size, (size_t)WS_END); grid_blocks = -1; return; }
        int dev = 0, cus = 0, per_cu = 0;
        hipGetDevice(&dev);
        hipDeviceGetAttribute(&cus, hipDeviceAttributeMultiprocessorCount, dev);
        hipFuncSetAttribute((const void*)fwd_megakernel, hipFuncAttributeMaxDynamicSharedMemorySize, (int)kDynLds);
        hipOccupancyMaxActiveBlocksPerMultiprocessor(&per_cu, (const void*)fwd_megakernel, 512, kDynLds);
        if (per_cu < 1) { fprintf(stderr, "kernel_launch: occupancy query says %d blocks/CU\n", per_cu); per_cu = 1; }
        grid_blocks = cus * 1;
    }
    if (grid_blocks < 0) return;
    Params p{};
    p.x = (const float*)d_in[0]; p.c = (const float*)d_in[1]; p.ctx = (const float*)d_in[2]; p.c_ctx = (const float*)d_in[3];
    p.w_mod = (const float*)d_in[4]; p.b_mod = (const float*)d_in[5]; p.g_pre = (const float*)d_in[6]; p.g_post = (const float*)d_in[7];
    p.w_in = (const float*)d_in[8]; p.w_out = (const float*)d_in[9]; p.g_sgu = (const float*)d_in[10]; p.w_sgu = (const float*)d_in[11];
    p.b_sgu = (const float*)d_in[12]; p.sink = (const float*)d_in[13]; p.w_f = (const float*)d_in[14]; p.b_f = (const float*)d_in[15];
    p.out = (float*)d_out; p.ws = (unsigned char*)d_ws;
    (void)hipMemsetAsync((unsigned char*)d_ws + O_BAR, 0, XCD_BAR_WORDS * 4, stream);
    void* args[] = {&p};
    hipError_t e = hipLaunchCooperativeKernel((const void*)fwd_megakernel, dim3(grid_blocks), dim3(512), args, kDynLds, stream);
    if (e != hipSuccess) fprintf(stderr, "cooperative launch failed: %s (grid %d)\n", hipGetErrorString(e), grid_blocks);
}
```

```cpp
#include <hip/hip_runtime.h>
#include <hip/hip_cooperative_groups.h>
#include <cstdio>
#include <cstdint>
namespace cg = cooperative_groups;

#define LAS __attribute__((address_space(3)))
typedef unsigned short bf16_t;
typedef short bf16x8 __attribute__((ext_vector_type(8)));
typedef short bf16x4 __attribute__((ext_vector_type(4)));
typedef float f32x4 __attribute__((ext_vector_type(4)));
typedef unsigned u32x2 __attribute__((ext_vector_type(2)));
typedef unsigned u32x4 __attribute__((ext_vector_type(4)));

constexpr int DM = 2048, SEQ = 8192, NB = 2, DEPTH = 4, CTXL = 256;
constexpr int MLAT = NB * SEQ;
constexpr int MROWS = MLAT + NB * CTXL;
constexpr int NCOL = 5632;
constexpr int C_AU = 0, C_AV = 512, C_AG = 1024, C_Q = 1536, C_K = 2560, C_V = 2816, C_BG = 3072, C_ZR = 4096, C_CG = 5120;
constexpr float EPS = 1e-6f;
constexpr float QSCALE = 0.08838834764831845f * 1.4426950408889634f;
constexpr float LOG2E = 1.4426950408889634f;

constexpr size_t AL(size_t x) { return (x + 255) & ~(size_t)255; }
constexpr size_t O_WINT = 0;
constexpr size_t O_WOUTT = O_WINT + AL((size_t)DEPTH * NCOL * DM * 2);
constexpr size_t O_MOD = O_WOUTT + AL((size_t)DEPTH * DM * DM * 2);
constexpr size_t O_ROPE = O_MOD + AL((size_t)DEPTH * 3 * 6144 * 4);
constexpr size_t O_TWID = O_ROPE + AL((size_t)128 * 32 * 8);
constexpr size_t O_F128 = O_TWID + AL((size_t)8192 * 8);
constexpr size_t O_F64 = O_F128 + AL((size_t)256 * 256 * 2);
constexpr size_t O_DCTX = O_F64 + AL((size_t)64 * 128 * 2);
constexpr size_t O_XC = O_DCTX + AL((size_t)256 * 512 * 2);
constexpr size_t O_HMIX = O_XC + AL((size_t)512 * DM * 4);
constexpr size_t O_PROJ = O_HMIX + AL((size_t)MROWS * DM * 2);
constexpr size_t O_AVT = O_PROJ + AL((size_t)MROWS * NCOL * 2);
constexpr size_t O_VT = O_AVT + AL((size_t)132 * 512 * 128 * 2);
constexpr size_t O_VTC = O_VT + AL((size_t)NB * 2 * 128 * SEQ * 2);
constexpr size_t O_ZT = O_VTC + AL((size_t)NB * 2 * 128 * CTXL * 2);
constexpr size_t O_ZTC = O_ZT + AL((size_t)NB * 512 * 64 * 256 * 2);
constexpr size_t O_BINT = O_ZTC + AL((size_t)NB * 512 * 512 * 2);
constexpr size_t O_YC = O_BINT + AL((size_t)NB * 128 * 512 * 128 * 2);
constexpr size_t O_BAR = O_YC + AL((size_t)512 * DM * 2);
constexpr size_t O_WCX = O_BAR + 16384;
constexpr size_t O_MTF = O_WCX + AL((size_t)DEPTH * DM * 512 * 2);
constexpr size_t O_MODP = O_MTF + AL((size_t)DEPTH * 1024 * 512 * 2);
constexpr size_t O_P0END = O_MODP + AL((size_t)DEPTH * 32 * 3 * 6144 * 4);
constexpr size_t O_XB = O_WCX;
constexpr size_t WS_END = (O_XB + (size_t)MLAT * DM * 2 > O_P0END) ? O_XB + (size_t)MLAT * DM * 2 : O_P0END;

struct Params {
    const float *x, *c, *ctx, *c_ctx, *w_mod, *b_mod, *g_pre, *g_post, *w_in, *w_out, *g_sgu, *w_sgu, *b_sgu, *sink, *w_f, *b_f;
    float* out;
    unsigned char* ws;
};

__device__ __forceinline__ Params load_params() {
#if defined(__HIP_DEVICE_COMPILE__)
    auto p = __builtin_amdgcn_kernarg_segment_ptr(); asm volatile("" : "+s"(p));
    return *(const __attribute__((address_space(4))) Params*)p;
#else
    return Params{};
#endif
}
__device__ __forceinline__ int lv(int x) { asm volatile("" : "+v"(x)); return x; }
template <class T> __device__ __forceinline__ T* ls(T* p) { asm volatile("" : "+s"(p)); return p; }
__device__ __forceinline__ unsigned cvt_pk_bf16(float lo, float hi) { unsigned r; asm volatile("v_cvt_pk_bf16_f32 %0, %1, %2" : "=v"(r) : "v"(lo), "v"(hi)); return r; }
__device__ __forceinline__ bf16_t f2bf(float v) { return (bf16_t)(cvt_pk_bf16(v, 0.f) & 0xffffu); }
__device__ __forceinline__ float bf2f(unsigned b) { return __uint_as_float(b << 16); }
__device__ __forceinline__ float bflo(unsigned w) { return __uint_as_float(w << 16); }
__device__ __forceinline__ float bfhi(unsigned w) { return __uint_as_float(w & 0xffff0000u); }
__device__ __forceinline__ float gelu_t(float x) { const float u2 = x * (x * x * (-2.f * 0.7978845608028654f * 0.044715f * 1.4426950408889634f) + (-2.f * 0.7978845608028654f * 1.4426950408889634f)); return x * __builtin_amdgcn_rcpf(1.f + __builtin_amdgcn_exp2f(u2)); }
__device__ __forceinline__ float silu_f(float x) { return x * __builtin_amdgcn_rcpf(1.f + __builtin_amdgcn_exp2f(x * -1.4426950408889634f)); }
__device__ __forceinline__ float wave_sum(float v) {
#pragma unroll
    for (int o = 1; o < 64; o <<= 1) v += __shfl_xor(v, o);
    return v;
}
__device__ __forceinline__ float xor16_max(float x) { auto r = __builtin_amdgcn_permlane16_swap(__float_as_uint(x), __float_as_uint(x), false, false); return fmaxf(__uint_as_float(r[0]), __uint_as_float(r[1])); }
__device__ __forceinline__ float xor32_max(float x) { auto r = __builtin_amdgcn_permlane32_swap(__float_as_uint(x), __float_as_uint(x), false, false); return fmaxf(__uint_as_float(r[0]), __uint_as_float(r[1])); }
__device__ __forceinline__ float xor16_sum(float x) { auto r = __builtin_amdgcn_permlane16_swap(__float_as_uint(x), __float_as_uint(x), false, false); return __uint_as_float(r[0]) + __uint_as_float(r[1]); }
__device__ __forceinline__ float xor32_sum(float x) { auto r = __builtin_amdgcn_permlane32_swap(__float_as_uint(x), __float_as_uint(x), false, false); return __uint_as_float(r[0]) + __uint_as_float(r[1]); }
__device__ __forceinline__ u32x2 pack4(float a, float b, float c, float d) { u32x2 r; r.x = cvt_pk_bf16(a, b); r.y = cvt_pk_bf16(c, d); return r; }

namespace pg8 {
constexpr int BM = 256, BK = 64, HALF = 128, HTB = HALF * BK * 2, STAGE_BYTES = 8 * HTB, NXCD = 8, WGM = 8;
__host__ __device__ __forceinline__ int lds_byte(int r, int c) { const int st = (r >> 4) * 2 + (c >> 5), rr = r & 15, cc = c & 31, ob = rr * 64 + cc * 2; return st * 1024 + (ob ^ (((ob >> 9) & 1) << 5)); }
__host__ __device__ __forceinline__ void stage_rc(int b, int& R, int& C) { const int st = b / 1024, sb = b % 1024, swz = sb ^ (((sb >> 9) & 1) << 5); R = (st >> 1) * 16 + swz / 64; C = (st & 1) * 32 + (swz % 64) / 2; }
__host__ __device__ __forceinline__ int perm32(int rho) { const int n = rho >> 4, i = rho & 15; return 8 * (i >> 2) + 4 * n + (i & 3); }
struct Unit { int pm, pn; };
struct Gemm { const bf16_t* A; const bf16_t* Bt; int K; };

struct SchedBase {
    __device__ __forceinline__ void amap(const Unit& u, const Gemm& g, const char*& base, unsigned& rs, unsigned& hs) const {
        rs = (unsigned)g.K * 2u; hs = (unsigned)HALF * g.K * 2u; base = (const char*)g.A + (size_t)u.pm * BM * g.K * 2;
    }
    __device__ __forceinline__ void bmap(const Unit& u, const Gemm& g, const char*& base, unsigned& rs, unsigned& hs) const {
        rs = (unsigned)g.K * 2u; hs = (unsigned)HALF * g.K * 2u; base = (const char*)g.Bt + (size_t)u.pn * BM * g.K * 2;
    }
};
struct StaticOrder : SchedBase {
    int nM, nN, nwg, G, c;
    __device__ void init(int nM_, int nN_, int G_, int c_) { nM = nM_; nN = nN_; nwg = nM * nN; G = G_; c = c_; }
    __device__ bool next(int i, Unit& u) const {
        const long L = (long)i * G + c; if (L >= nwg) return false;
        int wgid = (int)L; { const int q = nwg / NXCD, r = nwg % NXCD, xcd = wgid % NXCD, off = wgid / NXCD; wgid = (xcd < r ? xcd * (q + 1) : r * (q + 1) + (xcd - r) * q) + off; }
        const int nig = WGM * nN, gid = wgid / nig, fm = gid * WGM, gsz = (nM - fm) < WGM ? (nM - fm) : WGM;
        u.pm = fm + ((wgid % nig) % gsz); u.pn = (wgid % nig) / gsz; return true;
    }
};

template <class Epi, class Sched>
__device__ __forceinline__ void gemm_phase(LAS unsigned char* lds, const Gemm g, const Sched& S, const Epi& E) {
    const int tid = lv(threadIdx.x), wid = __builtin_amdgcn_readfirstlane(tid >> 6), lane = tid & 63, wr = wid >> 2, wc = wid & 3, fr = lane & 15, fq = lane >> 4;
    int K = g.K; asm volatile("" : "+s"(K));
    const int nt = K / BK;
#define PG8_VOFFB(dst, rs) do { const int _t = lv(tid); _Pragma("unroll") for (int _i = 0; _i < 2; ++_i) { int _R, _C; stage_rc(_t * 16 + _i * 8192, _R, _C); const int _Rb = (_R & ~31) + perm32(_R & 31); dst[_i] = (unsigned)_Rb * (rs) + (unsigned)_C * 2u; } } while (0)
#define PG8_VOFFA(dst, rs) do { const int _t = lv(tid); _Pragma("unroll") for (int _i = 0; _i < 2; ++_i) { int _R, _C; stage_rc(_t * 16 + _i * 8192, _R, _C); dst[_i] = (unsigned)_R * (rs) + (unsigned)_C * 2u; } } while (0)
    const size_t kstep = (size_t)(BK * 2);
    const unsigned ldsw = (unsigned)wid * 1024u;
    const int aoff = lds_byte(wr * 64 + fr, fq * 8), boff = lds_byte(wc * 32 + fr, fq * 8);
#define PG8_SA(b, h) (((b) * 2 + (h)) * HTB)
#define PG8_SB(b, h) ((4 + (b) * 2 + (h)) * HTB)
#define PG8_STAGE(bufoff, gbase, voff) do { _Pragma("unroll") for (int _i = 0; _i < 2; ++_i) \
        __builtin_amdgcn_global_load_lds((const unsigned*)((const char*)(gbase) + (voff)[_i]), (LAS unsigned*)(lds + (bufoff) + ldsw + _i * 8192), 16, 0, 0); } while (0)
#define PG8_LDA(dst, b, h) do { _Pragma("unroll") for (int m = 0; m < 4; ++m) _Pragma("unroll") for (int k = 0; k < 2; ++k) dst[m][k] = *(const LAS bf16x8*)(lds + PG8_SA(b, h) + aoff + m * 2048 + k * 1024); } while (0)
#define PG8_LDB(dst, b, h) do { _Pragma("unroll") for (int n = 0; n < 2; ++n) _Pragma("unroll") for (int k = 0; k < 2; ++k) dst[n][k] = *(const LAS bf16x8*)(lds + PG8_SB(b, h) + boff + n * 2048 + k * 1024); } while (0)
#define PG8_MMA(ai, bj, At, Bt) do { _Pragma("unroll") for (int m = 0; m < 4; ++m) _Pragma("unroll") for (int n = 0; n < 2; ++n) _Pragma("unroll") for (int k = 0; k < 2; ++k) \
        acc[ai][bj][m][n] = __builtin_amdgcn_mfma_f32_16x16x32_bf16(Bt[n][k], At[m][k], acc[ai][bj][m][n], 0, 0, 0); } while (0)
#define PG8_WAIT_V(n) asm volatile("s_waitcnt vmcnt(" #n ")" ::: "memory")
#define PG8_WAIT_L(n) asm volatile("s_waitcnt lgkmcnt(" #n ")" ::: "memory")
#define PG8_BAR __builtin_amdgcn_s_barrier()
#define PG8_SCHED __builtin_amdgcn_sched_barrier(0)
    Unit cur, nxt; int ui = 0;
    if (!S.next(0, cur)) return;
    f32x4 acc[2][2][4][2];
#pragma unroll
    for (int a = 0; a < 2; ++a)
#pragma unroll
        for (int b = 0; b < 2; ++b)
#pragma unroll
            for (int m = 0; m < 4; ++m)
#pragma unroll
                for (int n = 0; n < 2; ++n) acc[a][b][m][n] = (f32x4){0.f, 0.f, 0.f, 0.f};
    bf16x8 At[4][2], B0[2][2], B1[2][2];
    const char* cA; unsigned cRS, cHS; S.amap(cur, g, cA, cRS, cHS);
    unsigned vAc[2]; PG8_VOFFA(vAc, cRS);
    const char* cB; unsigned cRSB, cHSB; S.bmap(cur, g, cB, cRSB, cHSB);
    unsigned vBc[2]; PG8_VOFFB(vBc, cRSB);
    PG8_STAGE(PG8_SB(0, 0), cB, vBc); PG8_STAGE(PG8_SB(0, 1), cB + cHSB, vBc); PG8_STAGE(PG8_SA(0, 0), cA, vAc); PG8_STAGE(PG8_SA(0, 1), cA + cHS, vAc);
    if (wr == 1) PG8_BAR;
    PG8_WAIT_V(2); PG8_BAR;
    PG8_STAGE(PG8_SB(1, 0), cB + kstep, vBc); PG8_STAGE(PG8_SA(1, 0), cA + kstep, vAc); PG8_STAGE(PG8_SB(1, 1), cB + cHSB + kstep, vBc);
    PG8_WAIT_V(6); PG8_BAR;
    for (;;) {
        const bool has_next = S.next(ui + 1, nxt);
        const char* nA = cA; unsigned nRS = cRS, nHS = cHS; const char* nB = cB; unsigned nRSB = cRSB, nHSB = cHSB;
        if (has_next) { S.amap(nxt, g, nA, nRS, nHS); S.bmap(nxt, g, nB, nRSB, nHSB); }
        for (int t = 0; t < nt; t += 2) {
            const bool last = (t == nt - 2);
            const char* a1 = cA + (size_t)(t + 1) * kstep;
            const char* a2 = last ? nA : cA + (size_t)(t + 2) * kstep; const char* b2 = last ? nB : cB + (size_t)(t + 2) * kstep;
            const char* a3 = a2 + kstep; const char* b3 = b2 + kstep;
            const unsigned hs2 = last ? nHS : cHS;
            unsigned v2[2] = {vAc[0], vAc[1]}; if (last) PG8_VOFFA(v2, nRS);
            const unsigned hsB2 = last ? nHSB : cHSB;
            unsigned vB2[2] = {vBc[0], vBc[1]}; if (last) PG8_VOFFB(vB2, nRSB);
            PG8_LDB(B0, 0, 0); PG8_LDB(B1, 0, 1); PG8_SCHED; PG8_LDA(At, 0, 0); PG8_STAGE(PG8_SA(1, 1), a1 + cHS, vAc);
            PG8_WAIT_V(8); PG8_WAIT_L(0); PG8_BAR; __builtin_amdgcn_s_setprio(1); PG8_MMA(0, 0, At, B0); PG8_MMA(0, 1, At, B1); __builtin_amdgcn_s_setprio(0); PG8_BAR; PG8_SCHED;
            PG8_LDA(At, 0, 1); PG8_STAGE(PG8_SB(0, 0), b2, vB2); PG8_STAGE(PG8_SB(0, 1), b2 + hsB2, vB2); PG8_STAGE(PG8_SA(0, 0), a2, v2);
            PG8_WAIT_V(8); PG8_WAIT_L(0); PG8_BAR; __builtin_amdgcn_s_setprio(1); PG8_MMA(1, 0, At, B0); PG8_MMA(1, 1, At, B1); __builtin_amdgcn_s_setprio(0); PG8_BAR; PG8_SCHED;
            PG8_LDB(B0, 1, 0); PG8_LDB(B1, 1, 1); PG8_SCHED; PG8_LDA(At, 1, 0); PG8_STAGE(PG8_SA(0, 1), a2 + hs2, v2);
            PG8_WAIT_V(8); PG8_WAIT_L(0); PG8_BAR; __builtin_amdgcn_s_setprio(1); PG8_MMA(0, 0, At, B0); PG8_MMA(0, 1, At, B1); __builtin_amdgcn_s_setprio(0); PG8_BAR; PG8_SCHED;
            PG8_LDA(At, 1, 1); PG8_STAGE(PG8_SB(1, 0), b3, vB2); PG8_STAGE(PG8_SB(1, 1), b3 + hsB2, vB2); PG8_STAGE(PG8_SA(1, 0), a3, v2);
            PG8_WAIT_V(8); PG8_WAIT_L(0); PG8_BAR; __builtin_amdgcn_s_setprio(1); PG8_MMA(1, 0, At, B0); PG8_MMA(1, 1, At, B1); __builtin_amdgcn_s_setprio(0); PG8_BAR; PG8_SCHED;
        }
        if (wr == 0) PG8_BAR;
        { const int l2 = lv(threadIdx.x) & 63; E(acc, cur, wr, wc, l2 & 15, l2 >> 4); }
        if (!has_next) break;
#pragma unroll
        for (int a = 0; a < 2; ++a)
#pragma unroll
            for (int b = 0; b < 2; ++b)
#pragma unroll
                for (int m = 0; m < 4; ++m)
#pragma unroll
                    for (int n = 0; n < 2; ++n) acc[a][b][m][n] = (f32x4){0.f, 0.f, 0.f, 0.f};
        cur = nxt; cA = nA; cRS = nRS; cHS = nHS; PG8_VOFFA(vAc, cRS); cB = nB; cRSB = nRSB; cHSB = nHSB; PG8_VOFFB(vBc, cRSB); ++ui;
        if (wr == 1) PG8_BAR;
    }
    PG8_WAIT_V(0);
    PG8_BAR;
#undef PG8_VOFFA
#undef PG8_VOFFB
#undef PG8_SA
#undef PG8_SB
#undef PG8_STAGE
#undef PG8_LDA
#undef PG8_LDB
#undef PG8_MMA
#undef PG8_WAIT_V
#undef PG8_WAIT_L
#undef PG8_BAR
#undef PG8_SCHED
}
}
using pg8::Unit;
using pg8::Gemm;

__device__ __forceinline__ bool in_swapped(int pn) { return pn == 2 || pn == 3 || pn == 11 || (pn >= 16 && pn < 20); }
struct SchedIn : pg8::StaticOrder {
    __device__ __forceinline__ void tokmap(const Unit& u, bool gather, const Gemm& g, const char*& base, unsigned& rs, unsigned& hs) const {
        if (gather && u.pm < 64) { const int b = u.pm >> 5, t20 = 2 * (u.pm & 31); rs = 64u * DM * 2u; hs = DM * 2u; base = (const char*)g.A + ((size_t)b * SEQ + t20) * DM * 2; }
        else { rs = DM * 2u; hs = 128u * DM * 2u; base = (const char*)g.A + (size_t)u.pm * 256 * DM * 2; }
    }
    __device__ __forceinline__ void wmap(const Unit& u, const Gemm& g, const char*& base, unsigned& rs, unsigned& hs) const {
        rs = DM * 2u; hs = 128u * DM * 2u; base = (const char*)g.Bt + (size_t)u.pn * 256 * DM * 2;
    }
    __device__ __forceinline__ void amap(const Unit& u, const Gemm& g, const char*& base, unsigned& rs, unsigned& hs) const {
        if (in_swapped(u.pn)) wmap(u, g, base, rs, hs); else tokmap(u, false, g, base, rs, hs);
    }
    __device__ __forceinline__ void bmap(const Unit& u, const Gemm& g, const char*& base, unsigned& rs, unsigned& hs) const {
        if (in_swapped(u.pn)) tokmap(u, u.pn >= 16, g, base, rs, hs); else wmap(u, g, base, rs, hs);
    }
};
struct SchedFold : pg8::SchedBase {
    int G, c;
    __device__ bool next(int i, Unit& u) const { const int L = i * G + c; if (L >= 128) return false; const int l = L >> 5, r = L & 31; u.pm = l * 4 + (r >> 3); u.pn = l * 8 + (r & 7); return true; }
};
struct SchedFew : pg8::SchedBase {
    int n, G, c;
    __device__ bool next(int i, Unit& u) const { const int L = i * G + c; if (c < 0 || L >= n) return false; u.pm = 0; u.pn = L; return true; }
};

struct EpiIn {
    bf16_t *PROJ, *avT, *VT, *VTc, *ZT, *ZTc; const float2* rope;
    __device__ __forceinline__ void operator()(const f32x4 (&acc)[2][2][4][2], const Unit& u, int wr, int wc, int fr, int fq) const {
        if (in_swapped(u.pn)) {
#pragma unroll
            for (int ai = 0; ai < 2; ++ai) {
                const int nt = 2 * u.pn + ai;
#pragma unroll
                for (int m = 0; m < 4; ++m) {
                    const int ch = wr * 64 + m * 16 + lv(fr);
#pragma unroll
                    for (int bj = 0; bj < 2; ++bj) {
                        const f32x4 v0 = acc[ai][bj][m][0], v1 = acc[ai][bj][m][1];
                        const int tk = 32 * wc + 8 * fq;
                        bf16_t* dst;
                        u32x4 pk;
                        if (nt < 8) {
                            const int chunk = u.pm * 2 + bj;
                            dst = avT + ((size_t)chunk * 512 + (nt - 4) * 128 + ch) * 128 + tk;
                            pk.x = cvt_pk_bf16(gelu_t(v0[0]), gelu_t(v0[1])); pk.y = cvt_pk_bf16(gelu_t(v0[2]), gelu_t(v0[3])); pk.z = cvt_pk_bf16(gelu_t(v1[0]), gelu_t(v1[1])); pk.w = cvt_pk_bf16(gelu_t(v1[2]), gelu_t(v1[3]));
                        } else {
                            pk.x = cvt_pk_bf16(v0[0], v0[1]); pk.y = cvt_pk_bf16(v0[2], v0[3]); pk.z = cvt_pk_bf16(v1[0], v1[1]); pk.w = cvt_pk_bf16(v1[2], v1[3]);
                            if (nt < 24) {
                                const int kvh = nt - 22, row = u.pm * 256 + bj * 128 + tk;
                                if (row < MLAT) dst = VT + ((size_t)((row >> 13) * 2 + kvh) * 128 + ch) * SEQ + (row & 8191);
                                else { const int rc = row - MLAT; dst = VTc + ((size_t)((rc >> 8) * 2 + kvh) * 128 + ch) * CTXL + (rc & 255); }
                            } else {
                                const int ri = (nt - 32) >> 2, j = ((nt - 32) & 3) * 128 + ch;
                                if (u.pm < 64) { const int b = u.pm >> 5, t2 = 2 * (u.pm & 31) + bj; dst = ZT + (((size_t)(b * 512 + j) * 64 + t2) * 256) + ri * 128 + tk; }
                                else { const int rc = (u.pm - 64) * 256 + bj * 128 + tk; dst = ZTc + ((size_t)((rc >> 8) * 512 + j) * 512) + ri * 256 + (rc & 255); }
                            }
                        }
                        *(u32x4*)dst = pk;
                    }
                    asm volatile("" ::: "memory");
                }
            }
            return;
        }
#pragma unroll
        for (int bj = 0; bj < 2; ++bj) {
            const int nt = 2 * u.pn + bj;
            const int colt = nt * 128 + 32 * wc + 8 * fq;
            if (nt < 4 || (nt >= 8 && nt < 12) || (nt >= 24 && nt < 32) || nt >= 40) {
                const bool is_gelu = nt < 4;
#pragma unroll
                for (int ai = 0; ai < 2; ++ai)
#pragma unroll
                    for (int m = 0; m < 4; ++m) {
                        const size_t row = (size_t)u.pm * 256 + ai * 128 + wr * 64 + m * 16 + lv(fr);
                        const f32x4 v0 = acc[ai][bj][m][0], v1 = acc[ai][bj][m][1]; float o[8];
#pragma unroll
                        for (int i = 0; i < 4; ++i) { o[i] = is_gelu ? gelu_t(v0[i]) : silu_f(v0[i]); o[4 + i] = is_gelu ? gelu_t(v1[i]) : silu_f(v1[i]); }
                        u32x4 pk; pk.x = cvt_pk_bf16(o[0], o[1]); pk.y = cvt_pk_bf16(o[2], o[3]); pk.z = cvt_pk_bf16(o[4], o[5]); pk.w = cvt_pk_bf16(o[6], o[7]);
                        *(u32x4*)(PROJ + row * NCOL + colt) = pk;
                        asm volatile("" ::: "memory");
                    }
            } else if (nt < 8) {
#pragma unroll
                for (int ai = 0; ai < 2; ++ai)
#pragma unroll
                    for (int m = 0; m < 4; ++m) {
                        const int row = u.pm * 256 + ai * 128 + wr * 64 + m * 16 + lv(fr);
                        const int chunk = row >> 7, q = row & 127;
#pragma unroll
                        for (int n = 0; n < 2; ++n) {
                            f32x4 v = acc[ai][bj][m][n];
                            const int c0 = (nt - 4) * 128 + 32 * wc + 8 * fq + 4 * n;
#pragma unroll
                            for (int i = 0; i < 4; ++i) avT[((size_t)chunk * 512 + c0 + i) * 128 + q] = f2bf(gelu_t(v[i]));
                            asm volatile("" ::: "memory");
                        }
                    }
            } else if (nt < 22) {
                const bool isq = nt < 20; const float sc = isq ? QSCALE : 1.f;
                const bool lat = u.pm < 64;
                float frev[4];
#pragma unroll
                for (int i = 0; i < 4; ++i) frev[i] = __builtin_amdgcn_exp2f(-(float)((wc & 1) * 16 + fq * 4 + i) * (13.287712379549449f / 32.f)) * 0.15915494309189535f;
#pragma unroll
                for (int ai = 0; ai < 2; ++ai)
#pragma unroll
                    for (int m = 0; m < 4; ++m) {
                        const size_t row = (size_t)u.pm * 256 + ai * 128 + wr * 64 + m * 16 + lv(fr);
                        const int tpos = (int)(row & 8191);
                        const int pos = (wc < 2) ? (tpos >> 6) : (tpos & 63);
                        const f32x4 x0 = acc[ai][bj][m][0], x1 = acc[ai][bj][m][1];
                        float o0[4], o1[4];
                        if (lat) {
#pragma unroll
                            for (int i = 0; i < 4; ++i) { const float rev = (float)pos * frev[i]; const float cx = __builtin_amdgcn_cosf(rev), sx = __builtin_amdgcn_sinf(rev);
                                o0[i] = (x0[i] * cx - x1[i] * sx) * sc; o1[i] = (x1[i] * cx + x0[i] * sx) * sc; }
                        } else {
#pragma unroll
                            for (int i = 0; i < 4; ++i) { o0[i] = x0[i] * sc; o1[i] = x1[i] * sc; }
                        }
                        u32x4 pk; pk.x = cvt_pk_bf16(o0[0], o0[1]); pk.y = cvt_pk_bf16(o0[2], o0[3]); pk.z = cvt_pk_bf16(o1[0], o1[1]); pk.w = cvt_pk_bf16(o1[2], o1[3]);
                        *(u32x4*)(PROJ + row * NCOL + colt) = pk;
                        asm volatile("" ::: "memory");
                    }
            } else if (nt < 24) {
                const int kvh = nt - 22;
#pragma unroll
                for (int ai = 0; ai < 2; ++ai)
#pragma unroll
                    for (int m = 0; m < 4; ++m) {
                        const int row = u.pm * 256 + ai * 128 + wr * 64 + m * 16 + lv(fr);
#pragma unroll
                        for (int n = 0; n < 2; ++n) {
                            f32x4 v = acc[ai][bj][m][n];
                            const int d0 = 32 * wc + 8 * fq + 4 * n;
                            if (row < MLAT) { const int b = row >> 13, t = row & 8191;
#pragma unroll
                                for (int i = 0; i < 4; ++i) VT[((size_t)(b * 2 + kvh) * 128 + d0 + i) * SEQ + t] = f2bf(v[i]);
                            } else { const int rc = row - MLAT, b = rc >> 8, t = rc & 255;
#pragma unroll
                                for (int i = 0; i < 4; ++i) VTc[((size_t)(b * 2 + kvh) * 128 + d0 + i) * CTXL + t] = f2bf(v[i]);
                            }
                            asm volatile("" ::: "memory");
                        }
                    }
            } else {
                const int ri = (nt - 32) >> 2, jt = ((nt - 32) & 3) * 128;
#pragma unroll
                for (int ai = 0; ai < 2; ++ai)
#pragma unroll
                    for (int m = 0; m < 4; ++m) {
                        const int R = wr * 64 + m * 16 + lv(fr);
#pragma unroll
                        for (int n = 0; n < 2; ++n) {
                            f32x4 v = acc[ai][bj][m][n];
                            const int j0 = jt + 32 * wc + 8 * fq + 4 * n;
                            if (u.pm < 64) { const int b = u.pm >> 5, t2 = 2 * (u.pm & 31) + ai;
#pragma unroll
                                for (int i = 0; i < 4; ++i) ZT[(((size_t)(b * 512 + j0 + i) * 64 + t2) * 256) + ri * 128 + R] = f2bf(v[i]);
                            } else { const int rc = (u.pm - 64) * 256 + ai * 128 + R, b = rc >> 8, t = rc & 255;
#pragma unroll
                                for (int i = 0; i < 4; ++i) ZTc[((size_t)(b * 512 + j0 + i) * 512) + ri * 256 + t] = f2bf(v[i]);
                            }
                            asm volatile("" ::: "memory");
                        }
                    }
            }
        }
    }
};
struct EpiOut {
    bf16_t* Y;
    __device__ __forceinline__ void operator()(const f32x4 (&acc)[2][2][4][2], const Unit& u, int wr, int wc, int fr, int fq) const {
#pragma unroll
        for (int ai = 0; ai < 2; ++ai)
#pragma unroll
            for (int m = 0; m < 4; ++m) {
                const size_t row = (size_t)u.pm * 256 + ai * 128 + wr * 64 + m * 16 + fr;
#pragma unroll
                for (int bj = 0; bj < 2; ++bj) { const f32x4 v0 = acc[ai][bj][m][0], v1 = acc[ai][bj][m][1];
                    u32x4 pk; pk.x = cvt_pk_bf16(v0[0], v0[1]); pk.y = cvt_pk_bf16(v0[2], v0[3]); pk.z = cvt_pk_bf16(v1[0], v1[1]); pk.w = cvt_pk_bf16(v1[2], v1[3]);
                    *(u32x4*)(Y + row * DM + u.pn * 256 + bj * 128 + 32 * wc + 8 * fq) = pk; }
            }
    }
};
struct EpiFold {
    bf16_t* WinT;
    __device__ __forceinline__ void operator()(const f32x4 (&acc)[2][2][4][2], const Unit& u, int wr, int wc, int fr, int fq) const {
        const int l = u.pm >> 2;
#pragma unroll
        for (int ai = 0; ai < 2; ++ai)
#pragma unroll
            for (int m = 0; m < 4; ++m) {
                const size_t r = (size_t)(u.pm & 3) * 256 + ai * 128 + wr * 64 + m * 16 + fr;
#pragma unroll
                for (int bj = 0; bj < 2; ++bj) { const f32x4 v0 = acc[ai][bj][m][0], v1 = acc[ai][bj][m][1];
                    u32x4 pk; pk.x = cvt_pk_bf16(v0[0], v0[1]); pk.y = cvt_pk_bf16(v0[2], v0[3]); pk.z = cvt_pk_bf16(v1[0], v1[1]); pk.w = cvt_pk_bf16(v1[2], v1[3]);
                    *(u32x4*)(WinT + ((size_t)l * NCOL + C_ZR + r) * DM + (u.pn & 7) * 256 + bj * 128 + 32 * wc + 8 * fq) = pk; }
            }
    }
};
struct EpiS1 {
    bf16_t* Bint;
    __device__ __forceinline__ void operator()(const f32x4 (&acc)[2][2][4][2], const Unit& u, int wr, int wc, int fr, int fq) const {
#pragma unroll
        for (int m = 0; m < 4; ++m) {
            const int k1 = lv(wr * 64 + m * 16 + fr);
            const float revd = (float)k1 * (1.f / 8192.f); const float cd = __builtin_amdgcn_cosf(revd), sd = __builtin_amdgcn_sinf(revd);
#pragma unroll
            for (int bj = 0; bj < 2; ++bj) {
                const int c = u.pn * 256 + bj * 128 + 32 * wc + 8 * fq;
                const int t2 = c & 63, bjx = c >> 6, b = bjx >> 9, j = bjx & 511;
                float br[8], bi[8];
                const float rev0 = (float)(k1 * t2) * (1.f / 8192.f); float cw = __builtin_amdgcn_cosf(rev0), sw = __builtin_amdgcn_sinf(rev0);
#pragma unroll
                for (int n = 0; n < 2; ++n) {
                    const f32x4 ar = acc[0][bj][m][n], aim = acc[1][bj][m][n];
#pragma unroll
                    for (int i = 0; i < 4; ++i) {
                        br[4 * n + i] = ar[i] * cw - aim[i] * sw; bi[4 * n + i] = ar[i] * sw + aim[i] * cw;
                        const float cn = cw * cd - sw * sd; sw = sw * cd + cw * sd; cw = cn; }
                }
                const unsigned off = (unsigned)(((b * 128 + k1) * 512 + j) * 128 + t2);
                u32x4 p0, p1; p0.x = cvt_pk_bf16(br[0], br[1]); p0.y = cvt_pk_bf16(br[2], br[3]); p0.z = cvt_pk_bf16(br[4], br[5]); p0.w = cvt_pk_bf16(br[6], br[7]);
                p1.x = cvt_pk_bf16(bi[0], bi[1]); p1.y = cvt_pk_bf16(bi[2], bi[3]); p1.z = cvt_pk_bf16(bi[4], bi[5]); p1.w = cvt_pk_bf16(bi[6], bi[7]);
                *(u32x4*)(Bint + off) = p0; *(u32x4*)(Bint + off + 64) = p1;
            }
            asm volatile("" ::: "memory");
        }
    }
};
struct EpiCtxF {
    bf16_t* MIX; const bf16_t* PROJ; const float* bf;
    __device__ __forceinline__ void operator()(const f32x4 (&acc)[2][2][4][2], const Unit& u, int wr, int wc, int fr, int fq) const {
#pragma unroll
        for (int ai = 0; ai < 2; ++ai) {
            u32x4 gg[4][2];
#pragma unroll
            for (int m = 0; m < 4; ++m)
#pragma unroll
                for (int bj = 0; bj < 2; ++bj) { const int k = ai * 128 + wr * 64 + m * 16 + fr, col = u.pn * 256 + bj * 128 + 32 * wc + 8 * fq, b = col >> 9, j = col & 511;
                    gg[m][bj] = *(const u32x4*)(PROJ + ((size_t)MLAT + b * 256 + k) * NCOL + C_CG + j); }
#pragma unroll
            for (int m = 0; m < 4; ++m)
#pragma unroll
                for (int bj = 0; bj < 2; ++bj) { const int k = ai * 128 + wr * 64 + m * 16 + fr, col = u.pn * 256 + bj * 128 + 32 * wc + 8 * fq, b = col >> 9, j = col & 511;
                    const f32x4 v0 = acc[ai][bj][m][0], v1 = acc[ai][bj][m][1]; const f32x4 b0 = *(const f32x4*)(bf + j), b1 = *(const f32x4*)(bf + j + 4); const u32x4 g2 = gg[m][bj];
                    u32x4 pk; pk.x = cvt_pk_bf16((v0[0] + b0[0]) * bflo(g2.x), (v0[1] + b0[1]) * bfhi(g2.x)); pk.y = cvt_pk_bf16((v0[2] + b0[2]) * bflo(g2.y), (v0[3] + b0[3]) * bfhi(g2.y));
                    pk.z = cvt_pk_bf16((v1[0] + b1[0]) * bflo(g2.z), (v1[1] + b1[1]) * bfhi(g2.z)); pk.w = cvt_pk_bf16((v1[2] + b1[2]) * bflo(g2.w), (v1[3] + b1[3]) * bfhi(g2.w));
                    *(u32x4*)(MIX + ((size_t)MLAT + b * 256 + k) * DM + 1536 + j) = pk; }
            asm volatile("" ::: "memory");
        }
    }
};

__device__ __forceinline__ int qk_dperm(int p) {
    const int wc = p >> 5, fq = (p >> 3) & 3, n = (p >> 2) & 1, i = p & 3;
    return (wc >> 1) * 64 + n * 32 + (wc & 1) * 16 + fq * 4 + i;
}
struct TrTask { const float* src; bf16_t* dst; int sp, scol0, k0, nd0; bool perm; };
__device__ __forceinline__ TrTask tr_decode(const Params& P, bf16_t* WinT, bf16_t* WoutT, int task) {
    TrTask t;
    if (task < DEPTH * 18 * 32) {
        const int l = task / (18 * 32), r = task % (18 * 32), nb = r >> 5, kt = r & 31;
        t.nd0 = nb < 16 ? nb * 256 : (5120 + (nb - 16) * 256); t.scol0 = nb < 16 ? t.nd0 : t.nd0 - 512; t.perm = (t.nd0 >= C_Q && t.nd0 < C_V);
        t.src = P.w_in + (size_t)l * DM * 5120; t.sp = 5120; t.dst = WinT + (size_t)l * NCOL * DM; t.k0 = kt * 64;
    } else {
        const int q = task - DEPTH * 18 * 32, l = q >> 8, r = q & 255, nb = r >> 5, kt = r & 31;
        t.nd0 = nb * 256; t.scol0 = nb * 256; t.perm = false; t.src = P.w_out + (size_t)l * DM * DM; t.sp = DM; t.dst = WoutT + (size_t)l * DM * DM; t.k0 = kt * 64;
    }
    return t;
}
__device__ __forceinline__ void tr_load(const TrTask& t, int tid, f32x4 (&v)[8]) {
#pragma unroll
    for (int i = 0; i < 8; ++i) { const int k = (tid >> 6) + 8 * i, c4 = (tid & 63) * 4; v[i] = *(const f32x4*)(t.src + (size_t)(t.k0 + k) * t.sp + t.scol0 + c4); }
}
__device__ __forceinline__ void tr_store(const TrTask& t, int tid, const f32x4 (&v)[8], LAS float* scr) {
#pragma unroll
    for (int i = 0; i < 8; ++i) { const int k = (tid >> 6) + 8 * i, c4 = (tid & 63) * 4; LAS float* s = scr + k * 257 + c4; s[0] = v[i][0]; s[1] = v[i][1]; s[2] = v[i][2]; s[3] = v[i][3]; }
    __syncthreads();
#pragma unroll
    for (int i = 0; i < 4; ++i) { const int n = (tid >> 3) + 64 * i, kc = tid & 7;
      int sc = n;
      if (t.perm) { const int p = (t.nd0 + n) & 127; sc = (n & ~63) + (qk_dperm(p) & 63); }
      const LAS float* s = scr + (kc * 8) * 257 + sc;
      u32x4 o; o.x = cvt_pk_bf16(s[0], s[257]); o.y = cvt_pk_bf16(s[2 * 257], s[3 * 257]); o.z = cvt_pk_bf16(s[4 * 257], s[5 * 257]); o.w = cvt_pk_bf16(s[6 * 257], s[7 * 257]);
      *(u32x4*)(t.dst + (size_t)(t.nd0 + n) * DM + t.k0 + kc * 8) = o; }
    __syncthreads();
}

__device__ __forceinline__ void phase0a(const Params& P_unused, LAS unsigned char* lds, int G) {
    const Params P = load_params(); (void)P_unused;
    unsigned char* ws = ls(P.ws);
    bf16_t* WinT = (bf16_t*)(ws + O_WINT); bf16_t* WoutT = (bf16_t*)(ws + O_WOUTT); bf16_t* Wcx = (bf16_t*)(ws + O_WCX); bf16_t* MTf = (bf16_t*)(ws + O_MTF);
    float* modp = (float*)(ws + O_MODP); float2* rope = (float2*)(ws + O_ROPE); float2* twid = (float2*)(ws + O_TWID);
    bf16_t* F128 = (bf16_t*)(ws + O_F128); bf16_t* F64 = (bf16_t*)(ws + O_F64); bf16_t* Dctx = (bf16_t*)(ws + O_DCTX);
    LAS float* scr = (LAS float*)lds;
    const int tid = lv(threadIdx.x), bid = blockIdx.x;
    for (int task = bid; task < 384; task += G) {
        const int l = task / 96, s = (task / 3) & 31, nc = task % 3;
        __syncthreads();
        if (tid < 192) { const int r = tid >> 6, kk = tid & 63; const float v = (r < 2) ? P.c[r * DM + s * 64 + kk] : P.c_ctx[s * 64 + kk]; scr[r * 64 + kk] = silu_f(v); }
        __syncthreads();
        const int n = nc * 2048 + tid * 4;
        f32x4 a0 = {0, 0, 0, 0}, a1 = {0, 0, 0, 0}, a2 = {0, 0, 0, 0};
        const float* wp = P.w_mod + ((size_t)l * DM + s * 64) * 6144 + n;
#pragma unroll 16
        for (int kk = 0; kk < 64; ++kk) { const f32x4 w = *(const f32x4*)(wp + (size_t)kk * 6144); a0 += w * scr[kk]; a1 += w * scr[64 + kk]; a2 += w * scr[128 + kk]; }
        float* op = modp + ((size_t)(l * 32 + s) * 3) * 6144 + n;
        *(f32x4*)(op) = a0; *(f32x4*)(op + 6144) = a1; *(f32x4*)(op + 2 * 6144) = a2;
    }
    __syncthreads();
    {   constexpr int NTR = DEPTH * 18 * 32 + DEPTH * 8 * 32;
        const int tl = lv(tid);
        f32x4 va[8], vb[8];
        int task = bid;
        TrTask cur = tr_decode(P, WinT, WoutT, task < NTR ? task : 0);
        if (task < NTR) tr_load(cur, tl, va);
        for (; task < NTR; task += G) {
            const int nxt = task + G;
            TrTask nx = tr_decode(P, WinT, WoutT, nxt < NTR ? nxt : task);
            if (nxt < NTR) tr_load(nx, tl, vb);
            tr_store(cur, tl, va, scr);
#pragma unroll
            for (int i = 0; i < 8; ++i) va[i] = vb[i];
            cur = nx;
        }
    }
    if (tid < 128) { const float a = (float)tid * (1.f / 64.f); scr[tid] = cospif(a); scr[128 + tid] = sinpif(a); }
    __syncthreads();
    const size_t gt = (size_t)bid * 512 + tid, GT = (size_t)G * 512;
    for (size_t e = gt; e < (size_t)DEPTH * DM * 128; e += GT) {
        const size_t lk = e >> 7; const int j4 = (int)(e & 127) * 4;
        const f32x4 v = *(const f32x4*)(P.w_in + lk * 5120 + 4096 + j4);
        *(u32x2*)(Wcx + lk * 512 + j4) = pack4(v[0], v[1], v[2], v[3]);
    }
    for (size_t e = gt; e < (size_t)DEPTH * 1024 * 512; e += GT) {
        const int col = (int)(e & 511), row = (int)((e >> 9) & 1023), l = (int)(e >> 19);
        const int ri = row >> 9, g = (row >> 7) & 3, d = row & 127, g2 = col >> 7, c = col & 127;
        float v = 0.f;
        if (g == g2) {
            const float* wf = P.w_f + ((size_t)(l * 4 + g) * 128) * 128 + d;
            float s = 0.f;
            const LAS float* tb = scr + ri * 128;
#pragma unroll 8
            for (int c2 = 0; c2 < 128; ++c2) s += tb[(c * c2) & 127] * wf[(size_t)c2 * 128];
            v = s * (1.f / 1024.f);
        }
        MTf[e] = f2bf(v);
    }
    for (size_t e = gt; e < 128 * 32; e += GT) { const int pos = (int)(e >> 5), f = (int)(e & 31);
        const float fr = powf(10000.f, -(float)f / 32.f); const float ang = (float)pos * fr; float sn, cs; sincosf(ang, &sn, &cs); rope[e] = make_float2(cs, sn); }
    for (size_t e = gt; e < 8192; e += GT) { const float a = (float)e * (1.f / 4096.f); twid[e] = make_float2(cospif(a), sinpif(a)); }
    for (size_t e = gt; e < 256 * 256; e += GT) { const int n = (int)(e >> 8), kk = (int)(e & 255); const int ro = n >> 7, k1 = n & 127, rin = kk >> 7, t1 = kk & 127;
        const float a = (float)((k1 * t1) & 127) * (1.f / 64.f); const float cs = cospif(a), sn = sinpif(a);
        const float v = ro == 0 ? (rin == 0 ? cs : -sn) : (rin == 0 ? sn : cs); F128[e] = f2bf(v); }
    for (size_t e = gt; e < 64 * 128; e += GT) { const int k2 = (int)(e >> 7), kk = (int)(e & 127); const int rin = kk >> 6, t2 = kk & 63;
        const float a = (float)((k2 * t2) & 63) * (1.f / 32.f); F64[e] = f2bf(rin == 0 ? cospif(a) : -sinpif(a)); }
    for (size_t e = gt; e < 256 * 512; e += GT) { const int k = (int)(e >> 9), kk = (int)(e & 511); const int rin = kk >> 8, t = kk & 255;
        const float a = (float)((k * t) & 255) * (1.f / 128.f); Dctx[e] = f2bf((rin == 0 ? cospif(a) : -sinpif(a)) * 5.656854249492381f); }
}

__device__ __forceinline__ void row_phase(const Params& P_unused, int layer, int G) {
    const Params P = load_params(); (void)P_unused;
    unsigned char* ws = ls(P.ws);
    const float* mod = (const float*)(ws + O_MOD);
    float* XC = (float*)(ws + O_XC);
    bf16_t* XB = (bf16_t*)(ws + O_XB);
    bf16_t* H = (bf16_t*)(ws + O_HMIX);
    const bf16_t* Y = (const bf16_t*)(ws + O_PROJ); const bf16_t* Yc = (const bf16_t*)(ws + O_YC);
    const int tid = lv(threadIdx.x);
    const int lane = tid & 63, gw = blockIdx.x * 8 + (tid >> 6), NGW = G * 8;
    const int nrows = layer == DEPTH ? MLAT : MROWS;
    const bool xb_src = layer >= 2;
    const float* xctx = layer <= 1 ? P.ctx : XC;
    f32x4 vn[8]; u32x2 yn[8], xn[8];
#define ROW_LOAD(r) do { const int _r = (r); \
        if (_r < MLAT && xb_src) { _Pragma("unroll") for (int j = 0; j < 8; ++j) xn[j] = *(const u32x2*)(XB + (size_t)_r * DM + lane * 4 + 256 * j); } \
        else { const float* _x = _r < MLAT ? P.x + (size_t)_r * DM : xctx + (size_t)(_r - MLAT) * DM; _Pragma("unroll") for (int j = 0; j < 8; ++j) vn[j] = *(const f32x4*)(_x + lane * 4 + 256 * j); } \
        if (layer >= 1) { const bf16_t* _y = _r < MLAT ? Y + (size_t)_r * DM : Yc + (size_t)(_r - MLAT) * DM; _Pragma("unroll") for (int j = 0; j < 8; ++j) yn[j] = *(const u32x2*)(_y + lane * 4 + 256 * j); } } while (0)
    if (gw < nrows) ROW_LOAD(gw);
    for (int row = gw; row < nrows; row += NGW) {
        const bool lat = row < MLAT; const int mr = lat ? (row >> 13) : 2;
        f32x4 v[8]; u32x2 yw[8];
        if (lat && xb_src) {
#pragma unroll
            for (int j = 0; j < 8; ++j) v[j] = (f32x4){bflo(xn[j].x), bfhi(xn[j].x), bflo(xn[j].y), bfhi(xn[j].y)};
        } else {
#pragma unroll
            for (int j = 0; j < 8; ++j) v[j] = vn[j];
        }
#pragma unroll
        for (int j = 0; j < 8; ++j) yw[j] = yn[j];
        const int nr = row + NGW;
        if (nr < nrows) ROW_LOAD(nr);
        if (layer >= 1) {
            const float* mg = mod + ((size_t)(layer - 1) * 3 + mr) * 6144 + 4096;
            const float* gp = P.g_post + (size_t)(layer - 1) * DM;
            f32x4 y[8]; float ss = 0.f;
#pragma unroll
            for (int j = 0; j < 8; ++j) { const u32x2 w = yw[j];
                y[j] = (f32x4){bflo(w.x), bfhi(w.x), bflo(w.y), bfhi(w.y)}; ss += y[j][0] * y[j][0] + y[j][1] * y[j][1] + y[j][2] * y[j][2] + y[j][3] * y[j][3]; }
            const float rinv = rsqrtf(wave_sum(ss) * (1.f / DM) + EPS);
#pragma unroll
            for (int j = 0; j < 8; ++j) { const f32x4 g4 = *(const f32x4*)(mg + lane * 4 + 256 * j), p4 = *(const f32x4*)(gp + lane * 4 + 256 * j);
                v[j] = v[j] + g4 * (y[j] * rinv * p4); }
            if (!lat) {
#pragma unroll
                for (int j = 0; j < 8; ++j) *(f32x4*)(XC + (size_t)(row - MLAT) * DM + lane * 4 + 256 * j) = v[j];
            } else if (layer == DEPTH) {
#pragma unroll
                for (int j = 0; j < 8; ++j) *(f32x4*)(P.out + (size_t)row * DM + lane * 4 + 256 * j) = v[j];
            } else {
#pragma unroll
                for (int j = 0; j < 8; ++j) *(u32x2*)(XB + (size_t)row * DM + lane * 4 + 256 * j) = pack4(v[j][0], v[j][1], v[j][2], v[j][3]);
            }
        }
        if (layer < DEPTH) {
            float ss = 0.f;
#pragma unroll
            for (int j = 0; j < 8; ++j) ss += v[j][0] * v[j][0] + v[j][1] * v[j][1] + v[j][2] * v[j][2] + v[j][3] * v[j][3];
            const float rinv = rsqrtf(wave_sum(ss) * (1.f / DM) + EPS);
            const float* msh = mod + ((size_t)layer * 3 + mr) * 6144; const float* msc = msh + 2048;
            const float* gp = P.g_pre + (size_t)layer * DM;
#pragma unroll
            for (int j = 0; j < 8; ++j) { const f32x4 sh = *(const f32x4*)(msh + lane * 4 + 256 * j), sc = *(const f32x4*)(msc + lane * 4 + 256 * j), g4 = *(const f32x4*)(gp + lane * 4 + 256 * j);
                const f32x4 h = (v[j] * rinv * g4) * (sc + 1.f) + sh;
                *(u32x2*)(H + (size_t)row * DM + lane * 4 + 256 * j) = pack4(h[0], h[1], h[2], h[3]); }
        }
    }
#undef ROW_LOAD
}

__device__ __forceinline__ void attn_task(const Params& P_unused, int layer, int task, LAS unsigned char* lds) {
    const Params P = load_params(); (void)P_unused;
    unsigned char* ws = ls(P.ws);
    const bf16_t* PROJ = (const bf16_t*)(ws + O_PROJ);
    const bf16_t* VT = (const bf16_t*)(ws + O_VT); const bf16_t* VTc = (const bf16_t*)(ws + O_VTC);
    bf16_t* MIX = (bf16_t*)(ws + O_HMIX);
    const int tid = lv(threadIdx.x);
    const int lane = tid & 63, w = __builtin_amdgcn_readfirstlane(tid >> 6), fr = lane & 15, fq = lane >> 4;
    int b, blk, kvh, pair; bool isctx;
    if (task < 512) { isctx = false; b = task >> 8; const int rem = task & 255; blk = rem >> 2; kvh = (rem >> 1) & 1; pair = rem & 1; }
    else { isctx = true; const int t = task - 512; b = t >> 3; blk = (t >> 2) & 1; kvh = (t >> 1) & 1; pair = t & 1; }
    const int head = kvh * 4 + pair * 2 + (w >> 2);
    const int a0 = (w & 3) * 32;
    const size_t qrow0 = (isctx ? (size_t)MLAT + b * CTXL : (size_t)b * SEQ) + blk * 128 + a0;
    bf16x8 qf[2][4];
#pragma unroll
    for (int u = 0; u < 2; ++u)
#pragma unroll
        for (int c = 0; c < 4; ++c) qf[u][c] = *(const bf16x8*)(PROJ + (qrow0 + u * 16 + fr) * NCOL + C_Q + head * 128 + c * 32 + fq * 8);
    u32x2 gws[2][8];
#pragma unroll
    for (int u = 0; u < 2; ++u)
#pragma unroll
        for (int dt = 0; dt < 8; ++dt) gws[u][dt] = *(const u32x2*)(PROJ + (qrow0 + u * 16 + fr) * NCOL + C_BG + head * 128 + dt * 16 + 4 * fq);
    float mrun[2], lrun[2];
    const float sk = P.sink[layer * 8 + head] * LOG2E;
    mrun[0] = mrun[1] = sk; lrun[0] = lrun[1] = 1.f;
    f32x4 o[8][2];
#pragma unroll
    for (int dt = 0; dt < 8; ++dt) { o[dt][0] = (f32x4){0, 0, 0, 0}; o[dt][1] = (f32x4){0, 0, 0, 0}; }
    const int nprev = (!isctx && blk > 0) ? 4 : 0, nnext = (!isctx && blk < 63) ? 4 : 0;
    const int T = isctx ? 8 : 12 + nprev + nnext;
    const int lkey = tid >> 4, lkc = (tid & 15) ^ (((lkey >> 3) << 2) | (lkey & 3));
    const unsigned koff = (unsigned)(lkey * NCOL + lkc * 8) * 2u;
    const int ld = tid >> 2, lvc = (tid & 3) ^ ((ld >> 2) & 3);
    const unsigned voff_c = (unsigned)(ld * CTXL + lvc * 8) * 2u, voff_s = (unsigned)(ld * SEQ + lvc * 8) * 2u;
    const char* kctx = (const char*)(PROJ + ((size_t)MLAT + b * CTXL) * NCOL + C_K + kvh * 128);
    const char* klat = (const char*)(PROJ + ((size_t)b * SEQ) * NCOL + C_K + kvh * 128);
    const char* vctx = (const char*)(VTc + (size_t)(b * 2 + kvh) * 128 * CTXL);
    const char* vlat = (const char*)(VT + (size_t)(b * 2 + kvh) * 128 * SEQ);
#define ATT_ISSUE(tt) do { int _t = (tt) < T ? (tt) : T - 1; const char* _kp; const char* _vp; unsigned _vo; \
        if (_t < 8) { _kp = kctx + (size_t)(_t * 32) * NCOL * 2; _vp = vctx + _t * 64; _vo = voff_c; } \
        else { const int _r = _t - 8, _seg = _r < nprev ? 0 : (_r < nprev + 4 ? 1 : 2), _st = _seg == 0 ? _r : (_seg == 1 ? _r - nprev : _r - nprev - 4); \
               const int _kb = (blk - 1 + _seg) * 128 + _st * 32; _kp = klat + (size_t)_kb * NCOL * 2; _vp = vlat + _kb * 2; _vo = voff_s; } \
        LAS unsigned char* _dst = lds + ((tt) & 7) * 16384 + w * 1024; \
        __builtin_amdgcn_global_load_lds((const unsigned*)(_kp + koff), (LAS unsigned*)(_dst), 16, 0, 0); \
        __builtin_amdgcn_global_load_lds((const unsigned*)(_vp + _vo), (LAS unsigned*)(_dst + 8192), 16, 0, 0); } while (0)
    ATT_ISSUE(0); ATT_ISSUE(1); ATT_ISSUE(2); ATT_ISSUE(3); ATT_ISSUE(4); ATT_ISSUE(5);
    const int kfo = (8 * (fr >> 2) + (fr & 3)) * 256, vfo = fr * 64 + ((fq ^ ((fr >> 2) & 3)) * 16);
    int kofs[4];
#pragma unroll
    for (int c = 0; c < 4; ++c) kofs[c] = kfo + (((c * 4 + fq) ^ fr) * 16);
    const f32x4 zero4 = {0.f, 0.f, 0.f, 0.f};
    for (int tp = 0; tp < T; tp += 2) {
        asm volatile("s_waitcnt vmcnt(8) lgkmcnt(0)" ::: "memory");
        __builtin_amdgcn_s_barrier();
        asm volatile("" ::: "memory");
        ATT_ISSUE(tp + 6); ATT_ISSUE(tp + 7);
        int mtype = 0, st = 0;
        if (tp >= 8) { const int r = tp - 8; if (r < nprev) { mtype = 1; st = r; } else if (r >= nprev + 4) { mtype = 2; st = r - nprev - 4; } }
        const int k0 = st * 32;
        if (mtype == 1 && k0 + 63 < a0) continue;
        if (mtype == 2 && k0 > a0 + 31) continue;
        f32x4 s[2][2][2];
#pragma unroll
        for (int tl = 0; tl < 2; ++tl) {
            const LAS unsigned char* kb = lds + ((tp + tl) & 7) * 16384;
#pragma unroll
            for (int v = 0; v < 2; ++v)
#pragma unroll
                for (int c = 0; c < 4; ++c) {
                    const bf16x8 ka = *(const LAS bf16x8*)(kb + kofs[c] + v * 1024);
                    s[0][tl][v] = __builtin_amdgcn_mfma_f32_16x16x32_bf16(ka, qf[0][c], c == 0 ? zero4 : s[0][tl][v], 0, 0, 0);
                    s[1][tl][v] = __builtin_amdgcn_mfma_f32_16x16x32_bf16(ka, qf[1][c], c == 0 ? zero4 : s[1][tl][v], 0, 0, 0);
                }
        }
        bf16x8 pb[2][2];
#pragma unroll
        for (int u = 0; u < 2; ++u) {
            if (mtype == 1) {
                asm volatile("" ::: "memory");
                const int a = a0 + u * 16 + fr - k0 - 8 * fq;
#pragma unroll
                for (int tl = 0; tl < 2; ++tl)
#pragma unroll
                    for (int v = 0; v < 2; ++v)
#pragma unroll
                        for (int r = 0; r < 4; ++r) { if (32 * tl + 4 * v + r < a) s[u][tl][v][r] = -1e30f; }
            } else if (mtype == 2) {
                asm volatile("" ::: "memory");
                const int a = a0 + u * 16 + fr - k0 - 8 * fq;
#pragma unroll
                for (int tl = 0; tl < 2; ++tl)
#pragma unroll
                    for (int v = 0; v < 2; ++v)
#pragma unroll
                        for (int r = 0; r < 4; ++r) { if (32 * tl + 4 * v + r > a) s[u][tl][v][r] = -1e30f; }
            }
            float mx = -3e38f;
#pragma unroll
            for (int tl = 0; tl < 2; ++tl)
#pragma unroll
                for (int v = 0; v < 2; ++v) mx = fmaxf(mx, fmaxf(fmaxf(s[u][tl][v][0], s[u][tl][v][1]), fmaxf(s[u][tl][v][2], s[u][tl][v][3])));
            mx = xor16_max(mx); mx = xor32_max(mx);
            float mn = mrun[u], alpha = 1.f;
            const bool grow = __any(mx > mrun[u] + 8.f);
            if (grow) { mn = fmaxf(mrun[u], mx); alpha = __builtin_amdgcn_exp2f(mrun[u] - mn); }
            float p[16]; float ps = 0.f;
#pragma unroll
            for (int tl = 0; tl < 2; ++tl)
#pragma unroll
                for (int v = 0; v < 2; ++v)
#pragma unroll
                    for (int r = 0; r < 4; ++r) { const float e = __builtin_amdgcn_exp2f(s[u][tl][v][r] - mn); p[tl * 8 + v * 4 + r] = e; ps += e; }
            ps = xor16_sum(ps); ps = xor32_sum(ps);
            lrun[u] = lrun[u] * alpha + ps;
            if (grow) {
#pragma unroll
                for (int dt = 0; dt < 8; ++dt) o[dt][u] = o[dt][u] * alpha;
            }
            mrun[u] = mn;
#pragma unroll
            for (int tl = 0; tl < 2; ++tl) {
                u32x4 pk; pk.x = cvt_pk_bf16(p[tl * 8 + 0], p[tl * 8 + 1]); pk.y = cvt_pk_bf16(p[tl * 8 + 2], p[tl * 8 + 3]); pk.z = cvt_pk_bf16(p[tl * 8 + 4], p[tl * 8 + 5]); pk.w = cvt_pk_bf16(p[tl * 8 + 6], p[tl * 8 + 7]);
                pb[u][tl] = __builtin_bit_cast(bf16x8, pk);
            }
        }
#pragma unroll
        for (int tl = 0; tl < 2; ++tl) {
            const LAS unsigned char* vb = lds + ((tp + tl) & 7) * 16384 + 8192;
#pragma unroll
            for (int dt = 0; dt < 8; ++dt) {
                const bf16x8 va = *(const LAS bf16x8*)(vb + dt * 1024 + vfo);
                o[dt][0] = __builtin_amdgcn_mfma_f32_16x16x32_bf16(va, pb[0][tl], o[dt][0], 0, 0, 0);
                o[dt][1] = __builtin_amdgcn_mfma_f32_16x16x32_bf16(va, pb[1][tl], o[dt][1], 0, 0, 0);
            }
        }
    }
    asm volatile("s_waitcnt vmcnt(0) lgkmcnt(0)" ::: "memory");
    __builtin_amdgcn_s_barrier();
    asm volatile("" ::: "memory");
#undef ATT_ISSUE
#pragma unroll
    for (int u = 0; u < 2; ++u) {
        const float inv = 1.f / lrun[u];
        const size_t row = qrow0 + u * 16 + fr;
#pragma unroll
        for (int dt = 0; dt < 8; ++dt) {
            const int d0 = head * 128 + dt * 16 + 4 * fq;
            const u32x2 gw = gws[u][dt];
            const f32x4 ov = o[dt][u] * inv;
            *(u32x2*)(MIX + row * DM + 512 + d0) = pack4(ov[0] * bflo(gw.x), ov[1] * bfhi(gw.x), ov[2] * bflo(gw.y), ov[3] * bfhi(gw.y));
        }
    }
}

constexpr int GM_PART = 131072, GM_RQ = GM_PART + 32 * 128 * 4, GM_G = GM_RQ + 512, GM_B = GM_G + 2048, LDS_TOTAL = GM_B + 2048;
__device__ __forceinline__ void gmlp_task(const Params& P_unused, int layer, int chunk, LAS unsigned char* lds) {
    const Params P = load_params(); (void)P_unused;
    unsigned char* ws = ls(P.ws);
    const bf16_t* PROJ = (const bf16_t*)(ws + O_PROJ); const bf16_t* avT = (const bf16_t*)(ws + O_AVT) + (size_t)chunk * 512 * 128;
    bf16_t* MIX = (bf16_t*)(ws + O_HMIX);
    LAS float* part = (LAS float*)(lds + GM_PART);
    LAS float* rq = (LAS float*)(lds + GM_RQ);
    LAS float* gl = (LAS float*)(lds + GM_G);
    LAS float* bl = (LAS float*)(lds + GM_B);
    const int tid = lv(threadIdx.x), lane = tid & 63, w = __builtin_amdgcn_readfirstlane(tid >> 6), fr = lane & 15, fq = lane >> 4;
    __syncthreads();
    const int myc = (tid & 15) ^ ((tid >> 4) & 15);
    { const char* src = (const char*)avT + (size_t)(tid >> 4) * 256 + myc * 16;
#pragma unroll
      for (int i = 0; i < 16; ++i) __builtin_amdgcn_global_load_lds((const unsigned*)(src + (size_t)i * 32 * 256), (LAS unsigned*)(lds + i * 8192 + w * 1024), 16, 0, 0); }
    const int p = 16 * w + fr; const size_t row = (size_t)chunk * 128 + p;
    f32x4 wsn[8]; u32x2 uun[8], ggn[8];
#define GM_LOAD(h) do { const float* _wsr = P.w_sgu + (((size_t)layer * 4 + (h)) * 128 + p) * 128; \
        _Pragma("unroll") for (int c = 0; c < 4; ++c) { wsn[2 * c] = *(const f32x4*)(_wsr + c * 32 + 8 * fq); wsn[2 * c + 1] = *(const f32x4*)(_wsr + c * 32 + 8 * fq + 4); } \
        _Pragma("unroll") for (int dt = 0; dt < 8; ++dt) { const int _col = (h) * 128 + dt * 16 + 4 * fq; uun[dt] = *(const u32x2*)(PROJ + row * NCOL + C_AU + _col); ggn[dt] = *(const u32x2*)(PROJ + row * NCOL + C_AG + _col); } } while (0)
    GM_LOAD(0);
    if (tid < 128) *(LAS f32x4*)(gl + tid * 4) = *(const f32x4*)(P.g_sgu + (size_t)layer * 512 + tid * 4);
    else if (tid < 256) *(LAS f32x4*)(bl + (tid - 128) * 4) = *(const f32x4*)(P.b_sgu + (size_t)layer * 512 + (tid - 128) * 4);
    asm volatile("s_waitcnt vmcnt(0)" ::: "memory");
    __builtin_amdgcn_s_barrier();
    asm volatile("" ::: "memory");
    { float s8[8] = {0, 0, 0, 0, 0, 0, 0, 0};
#pragma unroll
      for (int i = 0; i < 16; ++i) { const u32x4 v = *(const LAS u32x4*)(lds + i * 8192 + tid * 16);
          float f; f = bflo(v.x); s8[0] += f * f; f = bfhi(v.x); s8[1] += f * f; f = bflo(v.y); s8[2] += f * f; f = bfhi(v.y); s8[3] += f * f;
          f = bflo(v.z); s8[4] += f * f; f = bfhi(v.z); s8[5] += f * f; f = bflo(v.w); s8[6] += f * f; f = bfhi(v.w); s8[7] += f * f; }
#pragma unroll
      for (int e = 0; e < 8; ++e) part[(tid >> 4) * 128 + myc * 8 + e] = s8[e]; }
    __syncthreads();
    if (tid < 128) { float s = 0.f; for (int i = 0; i < 32; ++i) s += part[i * 128 + tid]; rq[tid] = rsqrtf(s * (1.f / 512.f) + EPS); }
    __syncthreads();
    for (int h = 0; h < 4; ++h) {
        f32x4 wsc[8]; u32x2 uu[8], gg[8];
#pragma unroll
        for (int i = 0; i < 8; ++i) { wsc[i] = wsn[i]; uu[i] = uun[i]; gg[i] = ggn[i]; }
        if (h < 3) GM_LOAD(h + 1);
        bf16x8 bfr[4];
#pragma unroll
        for (int c = 0; c < 4; ++c) { const int q0 = c * 32 + 8 * fq; const f32x4 w0 = wsc[2 * c], w1 = wsc[2 * c + 1];
            u32x4 pk; pk.x = cvt_pk_bf16(w0[0] * rq[q0], w0[1] * rq[q0 + 1]); pk.y = cvt_pk_bf16(w0[2] * rq[q0 + 2], w0[3] * rq[q0 + 3]);
            pk.z = cvt_pk_bf16(w1[0] * rq[q0 + 4], w1[1] * rq[q0 + 5]); pk.w = cvt_pk_bf16(w1[2] * rq[q0 + 6], w1[3] * rq[q0 + 7]); bfr[c] = __builtin_bit_cast(bf16x8, pk); }
        f32x4 acc[8];
#pragma unroll
        for (int dt = 0; dt < 8; ++dt) { acc[dt] = (f32x4){0, 0, 0, 0};
#pragma unroll
            for (int c = 0; c < 4; ++c) { const bf16x8 a = *(const LAS bf16x8*)(lds + (h * 128 + dt * 16 + fr) * 256 + (((c * 4 + fq) ^ fr) * 16));
                acc[dt] = __builtin_amdgcn_mfma_f32_16x16x32_bf16(a, bfr[c], acc[dt], 0, 0, 0); } }
        const float bs = bl[h * 128 + p];
#pragma unroll
        for (int dt = 0; dt < 8; ++dt) { const int col = h * 128 + dt * 16 + 4 * fq;
            const f32x4 g4 = *(const LAS f32x4*)(gl + col);
            const u32x2 u2 = uu[dt], g2 = gg[dt];
            const float y0 = bflo(u2.x) * (acc[dt][0] * g4[0] + bs) * bflo(g2.x), y1 = bfhi(u2.x) * (acc[dt][1] * g4[1] + bs) * bfhi(g2.x);
            const float y2 = bflo(u2.y) * (acc[dt][2] * g4[2] + bs) * bflo(g2.y), y3 = bfhi(u2.y) * (acc[dt][3] * g4[3] + bs) * bfhi(g2.y);
            *(u32x2*)(MIX + row * DM + col) = pack4(y0, y1, y2, y3); }
    }
#undef GM_LOAD
    __syncthreads();
}

__device__ __forceinline__ void stage2_phase(const Params& P_unused, int layer, int G) {
    const Params P = load_params(); (void)P_unused;
    unsigned char* ws = ls(P.ws);
    const bf16_t* Bint = (const bf16_t*)(ws + O_BINT); const bf16_t* F64 = (const bf16_t*)(ws + O_F64); const bf16_t* PROJ = (const bf16_t*)(ws + O_PROJ);
    bf16_t* MIX = (bf16_t*)(ws + O_HMIX);
    const int tid = lv(threadIdx.x);
    const int lane = tid & 63, w = __builtin_amdgcn_readfirstlane(tid >> 6), fr = lane & 15, fq = lane >> 4;
    bf16x8 ff[4][4];
#pragma unroll
    for (int nt = 0; nt < 4; ++nt)
#pragma unroll
        for (int c = 0; c < 4; ++c) ff[nt][c] = *(const bf16x8*)(F64 + (size_t)(nt * 16 + fr) * 128 + c * 32 + fq * 8);
    for (int task = blockIdx.x; task < 256; task += G) {
        const int b = task >> 7, k1 = task & 127;
        bf16x8 af[4][4]; u32x2 gg[4][4]; f32x4 bias[4];
#pragma unroll
        for (int mi = 0; mi < 4; ++mi) {
            const int j0 = (w * 4 + mi) * 16, jc = j0 + 4 * fq;
#pragma unroll
            for (int c = 0; c < 4; ++c) af[mi][c] = *(const bf16x8*)(Bint + (((size_t)(b * 128 + k1) * 512 + j0 + fr) * 128) + c * 32 + fq * 8);
            bias[mi] = *(const f32x4*)(P.b_f + (size_t)layer * 512 + jc);
#pragma unroll
            for (int nt = 0; nt < 4; ++nt) gg[mi][nt] = *(const u32x2*)(PROJ + ((size_t)b * SEQ + k1 + 128 * (nt * 16 + fr)) * NCOL + C_CG + jc);
        }
#pragma unroll
        for (int mi = 0; mi < 4; ++mi) {
            const int jc = (w * 4 + mi) * 16 + 4 * fq;
#pragma unroll
            for (int nt = 0; nt < 4; ++nt) {
                f32x4 acc = {0, 0, 0, 0};
#pragma unroll
                for (int c = 0; c < 4; ++c) acc = __builtin_amdgcn_mfma_f32_16x16x32_bf16(af[mi][c], ff[nt][c], acc, 0, 0, 0);
                const int k2 = nt * 16 + fr; const size_t row = (size_t)b * SEQ + k1 + 128 * k2;
                const u32x2 g2 = gg[mi][nt];
                *(u32x2*)(MIX + row * DM + 1536 + jc) = pack4((acc[0] + bias[mi][0]) * bflo(g2.x), (acc[1] + bias[mi][1]) * bfhi(g2.x), (acc[2] + bias[mi][2]) * bflo(g2.y), (acc[3] + bias[mi][3]) * bfhi(g2.y));
            }
        }
    }
}

__device__ __forceinline__ void ctx_outproj_tile(const Params& P_unused, int layer, int tile, LAS unsigned char* lds) {
    const Params P = load_params(); (void)P_unused;
    unsigned char* ws = ls(P.ws);
    const bf16_t* A = (const bf16_t*)(ws + O_HMIX) + (size_t)MLAT * DM;
    const bf16_t* Bt = (const bf16_t*)(ws + O_WOUTT) + (size_t)layer * DM * DM;
    bf16_t* Yc = (bf16_t*)(ws + O_YC);
    const int tid = lv(threadIdx.x);
    const int lane = tid & 63, w = __builtin_amdgcn_readfirstlane(tid >> 6), fr = lane & 15, fq = lane >> 4;
    const int m0 = (tile >> 5) * 64, n0 = (tile & 31) * 64;
    f32x4 acc[4][4];
#pragma unroll
    for (int i = 0; i < 4; ++i)
#pragma unroll
        for (int j = 0; j < 4; ++j) acc[i][j] = (f32x4){0, 0, 0, 0};
    const bf16_t* ap = A + (size_t)(m0 + fr) * DM + w * 256 + fq * 8;
    const bf16_t* bp = Bt + (size_t)(n0 + fr) * DM + w * 256 + fq * 8;
#pragma unroll 4
    for (int ks = 0; ks < 8; ++ks) {
        bf16x8 af[4], bv[4];
#pragma unroll
        for (int i = 0; i < 4; ++i) { af[i] = *(const bf16x8*)(ap + (size_t)i * 16 * DM + ks * 32); bv[i] = *(const bf16x8*)(bp + (size_t)i * 16 * DM + ks * 32); }
#pragma unroll
        for (int i = 0; i < 4; ++i)
#pragma unroll
            for (int j = 0; j < 4; ++j) acc[i][j] = __builtin_amdgcn_mfma_f32_16x16x32_bf16(af[i], bv[j], acc[i][j], 0, 0, 0);
    }
    __syncthreads();
    LAS float* red = (LAS float*)lds + w * 4096;
#pragma unroll
    for (int i = 0; i < 4; ++i)
#pragma unroll
        for (int j = 0; j < 4; ++j)
#pragma unroll
            for (int r = 0; r < 4; ++r) red[(i * 16 + 4 * fq + r) * 64 + j * 16 + fr] = acc[i][j][r];
    __syncthreads();
    { const int e0 = tid * 8, row = e0 >> 6, col = e0 & 63;
      f32x4 s0 = {0, 0, 0, 0}, s1 = {0, 0, 0, 0};
#pragma unroll
      for (int wv = 0; wv < 8; ++wv) { const LAS f32x4* p = (const LAS f32x4*)((LAS float*)lds + wv * 4096 + e0); s0 += p[0]; s1 += p[1]; }
      u32x4 o; o.x = cvt_pk_bf16(s0[0], s0[1]); o.y = cvt_pk_bf16(s0[2], s0[3]); o.z = cvt_pk_bf16(s1[0], s1[1]); o.w = cvt_pk_bf16(s1[2], s1[3]);
      *(u32x4*)(Yc + (size_t)(m0 + row) * DM + n0 + col) = o; }
    __syncthreads();
}

#define XB_TMO      128
#define XB_XCNT(j)  (256  + 64 * (j))
#define XB_XSUB(j)  (1280 + 64 * (j))
#define XB_XGEN(j)  (2304 + 64 * (j))
#define XB_TOP      3328
#define XB_TOPGEN   3392
#define XCD_BAR_WORDS 3456
#define XB_SPIN_CAP (1u << 18)
__device__ __forceinline__ unsigned xb_ld(unsigned* p)              { return __hip_atomic_load(p, __ATOMIC_RELAXED, __HIP_MEMORY_SCOPE_AGENT); }
__device__ __forceinline__ unsigned xb_add(unsigned* p, unsigned v) { return __hip_atomic_fetch_add(p, v, __ATOMIC_RELAXED, __HIP_MEMORY_SCOPE_AGENT); }
__device__ __forceinline__ unsigned xb_xcc_id() { return (unsigned)__builtin_amdgcn_s_getreg((3 << 11) | 20) & 0xFu; }
#define XB_SPIN(cond, bar) do { unsigned _sp = 0; while (cond) { __builtin_amdgcn_s_sleep(1); \
    if ((++_sp & 255u) == 0u) { if (xb_ld(&(bar)[XB_TMO])) break; if (_sp > XB_SPIN_CAP) { atomicAdd(&(bar)[XB_TMO], 1u); break; } } } } while (0)
struct XcdBarrier { unsigned* bar; unsigned x; volatile LAS unsigned* st; };
__device__ __forceinline__ XcdBarrier xcd_barrier_post(unsigned* bar, volatile LAS unsigned* st) {
    XcdBarrier b; b.bar = bar; b.x = xb_xcc_id(); b.st = st;
    if (threadIdx.x == 0) (void)xb_add(&bar[XB_XCNT(b.x)], 1u);
    return b;
}
__device__ __forceinline__ void xcd_barrier_complete(unsigned* bar, unsigned x, unsigned& nloc, unsigned& nx) {
    const unsigned G = gridDim.x * gridDim.y * gridDim.z;
    unsigned sum, cnt, mine, sp = 0u;
    for (;;) {
        sum = 0u; cnt = 0u; mine = 0u;
#pragma unroll
        for (unsigned j = 0; j < 16; ++j) { const unsigned c = xb_ld(&bar[XB_XCNT(j)]); sum += c; cnt += (c > 0u) ? 1u : 0u; mine = (j == x) ? c : mine; }
        if (sum == G) break;
        __builtin_amdgcn_s_sleep(1);
        if ((++sp & 255u) == 0u) { if (xb_ld(&bar[XB_TMO])) break; if (sp > XB_SPIN_CAP) { atomicAdd(&bar[XB_TMO], 1u); break; } }
    }
    nloc = mine > 0u ? mine : 1u; nx = cnt > 0u ? cnt : 1u;
}
__device__ __forceinline__ void xcd_barrier(const XcdBarrier& b) {
    asm volatile("s_waitcnt vmcnt(0)" ::: "memory");
    __syncthreads();
    if (threadIdx.x == 0) {
        unsigned* bar = b.bar;
        __builtin_amdgcn_s_waitcnt(0);
        unsigned nloc = b.st[0], nx = b.st[1];
        if (nloc == 0u) { xcd_barrier_complete(bar, b.x, nloc, nx); b.st[0] = nloc; b.st[1] = nx; }
        const unsigned old = xb_add(&bar[XB_XSUB(b.x)], 1u);
        const unsigned gen = old / nloc;
        if (old + 1u == (gen + 1u) * nloc) {
            __builtin_amdgcn_fence(__ATOMIC_RELEASE, "agent");
            asm volatile("s_waitcnt vmcnt(0)" ::: "memory");
            const unsigned og = xb_add(&bar[XB_TOP], 1u);
            const unsigned tg = og / nx;
            if (og + 1u == (tg + 1u) * nx) xb_add(&bar[XB_TOPGEN], 1u);
            else XB_SPIN(xb_ld(&bar[XB_TOPGEN]) == tg, bar);
            __builtin_amdgcn_fence(__ATOMIC_ACQUIRE, "agent");
            xb_add(&bar[XB_XGEN(b.x)], 1u);
            asm volatile("s_waitcnt vmcnt(0)" ::: "memory");
        } else {
            XB_SPIN(xb_ld(&bar[XB_XGEN(b.x)]) == gen, bar);
            __builtin_amdgcn_fence(__ATOMIC_ACQUIRE, "agent");
            asm volatile("s_waitcnt vmcnt(0)" ::: "memory");
        }
    }
    __syncthreads();
}

__global__ void __launch_bounds__(512) fwd_megakernel(Params P_arg) {
    const Params& P = P_arg;
    extern __shared__ __attribute__((aligned(16))) unsigned char shm[];
    LAS unsigned char* lds = (LAS unsigned char*)shm;
    cg::grid_group grid = cg::this_grid();
    const int G = gridDim.x, bid = blockIdx.x;
    __shared__ uint4 xb_words;
    if (threadIdx.x == 0) xb_words = make_uint4(0u, 0u, 0u, 0u);
    __syncthreads();
    const XcdBarrier xb = xcd_barrier_post((unsigned*)(P.ws + O_BAR), (volatile LAS unsigned*)&xb_words);
#define WSP() const Params P = load_params(); unsigned char* ws = ls(P.ws); bf16_t* WinT = (bf16_t*)(ws + O_WINT); bf16_t* WoutT = (bf16_t*)(ws + O_WOUTT); bf16_t* HMIX = (bf16_t*)(ws + O_HMIX); bf16_t* PROJ = (bf16_t*)(ws + O_PROJ); (void)WinT; (void)WoutT; (void)HMIX; (void)PROJ

    phase0a(P, lds, G);
    grid.sync();
    {
        WSP();
        SchedFold S; S.G = G; S.c = bid;
        EpiFold E; E.WinT = WinT;
        Gemm g; g.A = (const bf16_t*)(ws + O_MTF); g.Bt = (const bf16_t*)(ws + O_WCX); g.K = 512;
        pg8::gemm_phase(lds, g, S, E);
        const float* modp = (const float*)(ws + O_MODP); float* mod = (float*)(ws + O_MOD);
        for (int e = bid * 512 + threadIdx.x; e < DEPTH * 3 * 1536; e += G * 512) {
            const int n4 = (e % 1536) * 4, lr = e / 1536, l = lr / 3, r = lr % 3;
            f32x4 a = *(const f32x4*)(P.b_mod + (size_t)l * 6144 + n4);
            for (int s = 0; s < 32; ++s) a += *(const f32x4*)(modp + ((size_t)(l * 32 + s) * 3 + r) * 6144 + n4);
            *(f32x4*)(mod + (size_t)lr * 6144 + n4) = a;
        }
    }
    xcd_barrier(xb);
#pragma unroll 1
    for (int layer = 0; layer < DEPTH; ++layer) {
        const bool lastl = layer == DEPTH - 1;
        row_phase(P, layer, G);
        xcd_barrier(xb);
        {
            WSP();
            SchedIn S; S.init(66, 22, G, bid);
            EpiIn E; E.PROJ = PROJ; E.avT = (bf16_t*)(ws + O_AVT); E.VT = (bf16_t*)(ws + O_VT); E.VTc = (bf16_t*)(ws + O_VTC); E.ZT = (bf16_t*)(ws + O_ZT); E.ZTc = (bf16_t*)(ws + O_ZTC); E.rope = (const float2*)(ws + O_ROPE);
            Gemm g; g.A = HMIX; g.Bt = WinT + (size_t)layer * NCOL * DM; g.K = DM;
            pg8::gemm_phase(lds, g, S, E);
        }
        xcd_barrier(xb);
        {
            WSP();
            for (int task = bid; task < 512; task += G) attn_task(P, layer, task, lds);
            {   SchedFew S; S.n = 256; S.G = G; S.c = bid;
                EpiS1 E; E.Bint = (bf16_t*)(ws + O_BINT);
                Gemm g; g.A = (const bf16_t*)(ws + O_F128); g.Bt = (const bf16_t*)(ws + O_ZT); g.K = 256;
                pg8::gemm_phase(lds, g, S, E); }
            const int nch = lastl ? 128 : 132;
            for (int ch = bid; ch < nch; ch += G) gmlp_task(P, layer, ch, lds);
            if (!lastl) {
                const int c2 = (bid - 132 + G) % G;
                for (int t = c2; t < 16; t += G) attn_task(P, layer, 512 + t, lds);
                __syncthreads();
                SchedFew S; S.n = 4; S.G = G; S.c = (bid - 148 + G) % G;
                EpiCtxF E; E.MIX = HMIX; E.PROJ = PROJ; E.bf = P.b_f + (size_t)layer * 512;
                Gemm g; g.A = (const bf16_t*)(ws + O_DCTX); g.Bt = (const bf16_t*)(ws + O_ZTC); g.K = 512;
                pg8::gemm_phase(lds, g, S, E);
            }
        }
        xcd_barrier(xb);
        stage2_phase(P, layer, G);
        if (!lastl) for (int tile = bid; tile < 256; tile += G) ctx_outproj_tile(P, layer, tile, lds);
        xcd_barrier(xb);
        {
            WSP();
            pg8::StaticOrder S; S.init(64, 8, G, bid);
            EpiOut E; E.Y = PROJ;
            Gemm g; g.A = HMIX; g.Bt = WoutT + (size_t)layer * DM * DM; g.K = DM;
            pg8::gemm_phase(lds, g, S, E);
        }
        xcd_barrier(xb);
    }
    row_phase(P, DEPTH, G);
}

extern "C" void kernel_launch(void* const* d_in, const int* in_sizes, int n_in, void* d_out, int out_size, void* d_ws, size_t ws_size, hipStream_t stream) {
    constexpr size_t kDynLds = LDS_TOTAL;
    static int grid_blocks = 0;
    if (!grid_blocks) {
        if (ws_size < WS_END) { fprintf(stderr, "kernel_launch: workspace too small: %zu < %zu\n", ws_size, (size_t)WS_END); grid_blocks = -1; return; }
        int dev = 0, cus = 0, per_cu = 0;
        hipGetDevice(&dev);
        hipDeviceGetAttribute(&cus, hipDeviceAttributeMultiprocessorCount, dev);
        hipFuncSetAttribute((const void*)fwd_megakernel, hipFuncAttributeMaxDynamicSharedMemorySize, (int)kDynLds);
        hipOccupancyMaxActiveBlocksPerMultiprocessor(&per_cu, (const void*)fwd_megakernel, 512, kDynLds);
        if (per_cu < 1) { fprintf(stderr, "kernel_launch: occupancy query says %d blocks/CU\n", per_cu); per_cu = 1; }
        grid_blocks = cus * 1;
    }
    if (grid_blocks < 0) return;
    Params p{};
    p.x = (const float*)d_in[0]; p.c = (const float*)d_in[1]; p.ctx = (const float*)d_in[2]; p.c_ctx = (const float*)d_in[3];
    p.w_mod = (const float*)d_in[4]; p.b_mod = (const float*)d_in[5]; p.g_pre = (const float*)d_in[6]; p.g_post = (const float*)d_in[7];
    p.w_in = (const float*)d_in[8]; p.w_out = (const float*)d_in[9]; p.g_sgu = (const float*)d_in[10]; p.w_sgu = (const float*)d_in[11];
    p.b_sgu = (const float*)d_in[12]; p.sink = (const float*)d_in[13]; p.w_f = (const float*)d_in[14]; p.b_f = (const float*)d_in[15];
    p.out = (float*)d_out; p.ws = (unsigned char*)d_ws;
    (void)hipMemsetAsync((unsigned char*)d_ws + O_BAR, 0, XCD_BAR_WORDS * 4, stream);
    void* args[] = {&p};
    hipError_t e = hipLaunchCooperativeKernel((const void*)fwd_megakernel, dim3(grid_blocks), dim3(512), args, kDynLds, stream);
    if (e != hipSuccess) fprintf(stderr, "cooperative launch failed: %s (grid %d)\n", hipGetErrorString(e), grid_blocks);
}
```
